# Optimizing an MI355X kernel written in HIP

```python
import math
import jax, jax.numpy as jnp
from jax import lax
import numpy as np

D_MODEL = 1024
BATCH = 16
SEQ = 2048
DEPTH = 1

CHUNK = 64
N_META = 16
Q_BLOCK = 128
EPS = 1e-6

MLA_HEADS = 8
MLA_Q_RANK = 384
MLA_KV_RANK = 256
MLA_NOPE = 128
MLA_ROPE = 64
MLA_V = 128
ROPE_HALF = MLA_ROPE // 2
ROPE_THETA = 10000.0

GLA_HEADS = 4
GLA_DK = D_MODEL // 2
GLA_DV = D_MODEL
GLA_HK = GLA_DK // GLA_HEADS
GLA_HV = GLA_DV // GLA_HEADS
GLA_GATE_RANK = 16
GLA_TAU = 16.0
GLA_CHUNK = 16

PEER_HEADS = 8
PEER_NKEYS = 128
PEER_EXPERTS = PEER_NKEYS * PEER_NKEYS
PEER_QDIM = 256
PEER_HALF = PEER_QDIM // 2
PEER_TOPK = 16
PEER_BLOCK = 16

SPLITS = (MLA_Q_RANK, MLA_KV_RANK, MLA_ROPE, GLA_DK, GLA_DK, GLA_DV, GLA_GATE_RANK, GLA_DV, D_MODEL, D_MODEL)
D_IN = MLA_Q_RANK + MLA_KV_RANK + MLA_ROPE + 2 * GLA_DK + GLA_DV + GLA_GATE_RANK + GLA_DV + 2 * D_MODEL

kernel_name = "hybrid_mla_gla_peer_meta_chunk_causal"


def rmsnorm(x, g):
    x32 = x.astype(jnp.float32)
    y = x32 * lax.rsqrt(jnp.mean(x32 * x32, axis=-1, keepdims=True) + EPS)
    return (y * g.astype(jnp.float32)).astype(x.dtype)


def rope_tables(n):
    inv_freq = ROPE_THETA ** (-jnp.arange(ROPE_HALF, dtype=jnp.float32) / ROPE_HALF)
    ang = jnp.arange(n, dtype=jnp.float32)[:, None] * inv_freq[None, :]
    return jnp.cos(ang), jnp.sin(ang)


def rope(x, cos, sin):
    x32 = x.astype(jnp.float32)
    x1, x2 = x32[..., :ROPE_HALF], x32[..., ROPE_HALF:]
    return jnp.concatenate([x1 * cos - x2 * sin, x2 * cos + x1 * sin], axis=-1).astype(x.dtype)


def mla_branch(c_q, c_kv, k_pe, q_norm, w_uq, kv_norm, w_ukv, qn_nope, qn_pe, kn_nope, kn_pe, cos, sin, cid):
    B, L, _ = c_q.shape
    q = (rmsnorm(c_q, q_norm) @ w_uq).reshape(B, L, MLA_HEADS, MLA_NOPE + MLA_ROPE)
    kv = (rmsnorm(c_kv, kv_norm) @ w_ukv).reshape(B, L, MLA_HEADS, MLA_NOPE + MLA_V)
    q_nope = rmsnorm(q[..., :MLA_NOPE], qn_nope)
    q_pe = rope(rmsnorm(q[..., MLA_NOPE:], qn_pe), cos[:, None, :], sin[:, None, :])
    k_nope = rmsnorm(kv[..., :MLA_NOPE], kn_nope)
    v = kv[..., MLA_NOPE:]
    k_pe = rope(rmsnorm(k_pe, kn_pe), cos, sin)
    scale = (MLA_NOPE + MLA_ROPE) ** -0.5
    lp = cid.shape[0]
    nb = lp // Q_BLOCK
    pad = ((0, 0), (0, lp - L), (0, 0), (0, 0))
    qn_b = jnp.pad(q_nope, pad).reshape(B, nb, Q_BLOCK, MLA_HEADS, MLA_NOPE).transpose(1, 0, 2, 3, 4)
    qp_b = jnp.pad(q_pe, pad).reshape(B, nb, Q_BLOCK, MLA_HEADS, MLA_ROPE).transpose(1, 0, 2, 3, 4)
    cq_b = cid.reshape(nb, Q_BLOCK)
    cid_k = cid[:L]

    def attend(blk):
        qn, qp, cq = blk
        s = (jnp.einsum('bqhd,bkhd->bhqk', qn, k_nope) + jnp.einsum('bqhd,bkd->bhqk', qp, k_pe)).astype(jnp.float32) * scale
        mask = cid_k[None, :] <= cq[:, None]
        s = jnp.where(mask, s, -jnp.inf)
        w = jax.nn.softmax(s, axis=-1).astype(v.dtype)
        return jnp.einsum('bhqk,bkhd->bqhd', w, v)

    out = lax.map(attend, (qn_b, qp_b, cq_b))
    out = out.transpose(1, 0, 2, 3, 4).reshape(B, lp, MLA_HEADS * MLA_V)
    return out[:, :L]


def gla_branch(gq, gk, gv, ga, gg, w_a2, b_a, g_norm):
    B, L, _ = gq.shape
    nc = L // GLA_CHUNK
    q = gq.reshape(B, L, GLA_HEADS, GLA_HK) * (GLA_HK ** -0.5)
    k = gk.reshape(B, L, GLA_HEADS, GLA_HK)
    v = gv.reshape(B, L, GLA_HEADS, GLA_HV)
    log_a = jax.nn.log_sigmoid((ga @ w_a2 + b_a).astype(jnp.float32)) / GLA_TAU
    log_a = log_a.reshape(B, L, GLA_HEADS, GLA_HK)

    def to_chunks(t):
        return t.reshape(B, nc, GLA_CHUNK, GLA_HEADS, t.shape[-1]).transpose(1, 0, 3, 2, 4).astype(jnp.float32)

    tri = jnp.tril(jnp.ones((GLA_CHUNK, GLA_CHUNK), dtype=bool))

    def step(S, inp):
        qc, kc, vc, lac = inp
        bcum = jnp.cumsum(lac, axis=2)
        o_inter = jnp.einsum('bhcd,bhde->bhce', qc * jnp.exp(bcum), S)
        diff = bcum[:, :, :, None, :] - bcum[:, :, None, :, :]
        decay = jnp.exp(jnp.where(tri[None, None, :, :, None], diff, -jnp.inf))
        A = jnp.einsum('bhid,bhjd,bhijd->bhij', qc, kc, decay)
        o_intra = jnp.einsum('bhij,bhje->bhie', A, vc)
        b_last = bcum[:, :, -1]
        k_dec = kc * jnp.exp(b_last[:, :, None, :] - bcum)
        S = jnp.exp(b_last)[..., None] * S + jnp.einsum('bhcd,bhce->bhde', k_dec, vc)
        return S, o_inter + o_intra

    S0 = jnp.zeros((B, GLA_HEADS, GLA_HK, GLA_HV), jnp.float32)
    _, o = lax.scan(step, S0, (to_chunks(q), to_chunks(k), to_chunks(v), to_chunks(log_a)))
    o = o.transpose(1, 0, 3, 2, 4).reshape(B, L, GLA_HEADS, GLA_HV).astype(gq.dtype)
    o = rmsnorm(o, g_norm).reshape(B, L, GLA_DV)
    return o * jax.nn.silu(gg)


def peer_ffn(h, w_q, sub_keys, u_tab, v_tab):
    B, L, D = h.shape
    q = (h @ w_q).reshape(B, L, PEER_HEADS, 2, PEER_HALF)
    s = jnp.einsum('blhpd,pnd->blhpn', q, sub_keys).astype(jnp.float32)
    top_s, top_i = lax.top_k(s, PEER_TOPK)
    cand_s = top_s[..., 0, :, None] + top_s[..., 1, None, :]
    cand_i = top_i[..., 0, :, None] * PEER_NKEYS + top_i[..., 1, None, :]
    best_s, best_pos = lax.top_k(cand_s.reshape(B, L, PEER_HEADS, PEER_TOPK * PEER_TOPK), PEER_TOPK)
    idx = jnp.take_along_axis(cand_i.reshape(B, L, PEER_HEADS, PEER_TOPK * PEER_TOPK), best_pos, axis=-1)
    gate = jax.nn.softmax(best_s, axis=-1)
    nb = L // PEER_BLOCK

    def blocks(t):
        return t.reshape((B, nb, PEER_BLOCK) + t.shape[2:]).swapaxes(0, 1)

    def expert_block(inp):
        hb, ib, gb = inp
        u = u_tab[ib]
        act = jax.nn.gelu(jnp.einsum('bpd,bphkd->bphk', hb, u).astype(jnp.float32), approximate=False)
        coef = (act * gb).astype(hb.dtype)
        return jnp.einsum('bphk,bphkd->bpd', coef, v_tab[ib])

    out = lax.map(expert_block, (blocks(h), blocks(idx), blocks(gate)))
    return out.swapaxes(0, 1).reshape(B, L, D)


def setup_inputs(seed: int = 0) -> dict:
    key = jax.random.key(seed)
    ks = jax.random.split(key, 24)
    f32 = jnp.float32

    def nrm(k, shape, fan_in):
        return jax.random.normal(k, shape, f32) * (fan_in ** -0.5)

    def gain(k, shape):
        return 1.0 + 0.02 * jax.random.normal(k, shape, f32)

    return {
        "x": jax.random.normal(ks[0], (BATCH, SEQ, D_MODEL), f32),
        "meta": jax.random.normal(ks[1], (N_META, D_MODEL), f32),
        "norm_mix": gain(ks[2], (DEPTH, D_MODEL)),
        "w_in": nrm(ks[3], (DEPTH, D_MODEL, D_IN), D_MODEL),
        "mla_q_norm": gain(ks[4], (DEPTH, MLA_Q_RANK)),
        "mla_w_uq": nrm(ks[5], (DEPTH, MLA_Q_RANK, MLA_HEADS * (MLA_NOPE + MLA_ROPE)), MLA_Q_RANK),
        "mla_kv_norm": gain(ks[6], (DEPTH, MLA_KV_RANK)),
        "mla_w_ukv": nrm(ks[7], (DEPTH, MLA_KV_RANK, MLA_HEADS * (MLA_NOPE + MLA_V)), MLA_KV_RANK),
        "qn_nope": gain(ks[8], (DEPTH, MLA_NOPE)),
        "qn_pe": gain(ks[9], (DEPTH, MLA_ROPE)),
        "kn_nope": gain(ks[10], (DEPTH, MLA_NOPE)),
        "kn_pe": gain(ks[11], (DEPTH, MLA_ROPE)),
        "gla_w_a2": nrm(ks[12], (DEPTH, GLA_GATE_RANK, GLA_DK), GLA_GATE_RANK),
        "gla_b_a": 0.1 * jax.random.normal(ks[13], (DEPTH, GLA_DK), f32),
        "gla_norm": gain(ks[14], (DEPTH, GLA_HV)),
        "w_o_mla": nrm(ks[15], (DEPTH, MLA_HEADS * MLA_V, D_MODEL), MLA_HEADS * MLA_V),
        "w_o_gla": nrm(ks[16], (DEPTH, GLA_DV, D_MODEL), GLA_DV),
        "w_out": nrm(ks[17], (DEPTH, D_MODEL, D_MODEL), D_MODEL),
        "norm_ffn": gain(ks[18], (DEPTH, D_MODEL)),
        "peer_w_q": nrm(ks[19], (DEPTH, D_MODEL, PEER_HEADS * PEER_QDIM), D_MODEL),
        "peer_keys": nrm(ks[20], (DEPTH, 2, PEER_NKEYS, PEER_HALF), PEER_HALF),
        "peer_u": nrm(ks[21], (DEPTH, PEER_EXPERTS, D_MODEL), D_MODEL),
        "peer_v": nrm(ks[22], (DEPTH, PEER_EXPERTS, D_MODEL), PEER_HEADS),
    }


def reference(x, meta, norm_mix, w_in, mla_q_norm, mla_w_uq, mla_kv_norm, mla_w_ukv, qn_nope, qn_pe, kn_nope, kn_pe, gla_w_a2, gla_b_a, gla_norm, w_o_mla, w_o_gla, w_out, norm_ffn, peer_w_q, peer_keys, peer_u, peer_v):
    B = x.shape[0]
    h = jnp.concatenate([jnp.broadcast_to(meta.astype(x.dtype)[None], (B, N_META, D_MODEL)), x], axis=1)
    L = h.shape[1]
    lp = -(-L // Q_BLOCK) * Q_BLOCK
    pos = jnp.arange(lp)
    cid = jnp.where(pos < N_META, 0, 1 + (pos - N_META) // CHUNK)
    cos, sin = rope_tables(L)
    offsets = [int(o) for o in np.cumsum(SPLITS)[:-1]]
    for l in range(DEPTH):
        n = rmsnorm(h, norm_mix[l])
        parts = jnp.split(n @ w_in[l], offsets, axis=-1)
        c_q, c_kv, k_pe, gq, gk, gv, ga, gg, gate_a, gate_b = parts
        y_a = mla_branch(c_q, c_kv, k_pe, mla_q_norm[l], mla_w_uq[l], mla_kv_norm[l], mla_w_ukv[l], qn_nope[l], qn_pe[l], kn_nope[l], kn_pe[l], cos, sin, cid)
        y_b = gla_branch(gq, gk, gv, ga, gg, gla_w_a2[l], gla_b_a[l], gla_norm[l])
        mix = jax.nn.sigmoid(gate_a) * (y_a @ w_o_mla[l]) + jax.nn.sigmoid(gate_b) * (y_b @ w_o_gla[l])
        h = h + mix @ w_out[l]
        h = h + peer_ffn(rmsnorm(h, norm_ffn[l]), peer_w_q[l], peer_keys[l], peer_u[l], peer_v[l])
    return h[:, N_META:]
```

```cpp
#include <hip/hip_runtime.h>
#include <cstdint>
#include <cstdio>

typedef unsigned short bf16_t;
typedef unsigned u32x4 __attribute__((ext_vector_type(4)));
typedef float f32x4 __attribute__((ext_vector_type(4)));

constexpr int D = 1024, NB = 16, SEQ = 2048, M = NB * SEQ, ME = M + 256, NMETA = 16;
constexpr float EPS = 1e-6f;
constexpr int QR = 384, KVR = 256, NOPE = 128, ROPE = 64, RH = 32, QKD = 192;
constexpr int GDK = 512, GDV = 1024, GHK = 128, GHV = 256, GR = 16;
constexpr int DIN = 5840;
constexpr int S_CQ = 0, S_CKV = 384, S_KPE = 640, S_GQ = 704, S_GK = 1216, S_GV = 1728, S_GA = 2752, S_GG = 2768, S_A = 3792, S_B = 4816;
constexpr int WIN_ROWS = 6400, WIN_NAT = 4864, P0W = 768;
constexpr float SCL2 = 0.07216878364870323f * 1.4426950408889634f;
constexpr float GLA_QS = 0.08838834764831845f;

constexpr size_t MiB = 1u << 20;
constexpr size_t al(size_t x) { return (x + 255) / 256 * 256; }
constexpr size_t O_WIN = 0;
constexpr size_t O_WUQ = O_WIN + al((size_t)WIN_ROWS * D * 2);
constexpr size_t O_WUKV = O_WUQ + al((size_t)1536 * QR * 2);
constexpr size_t O_WOM = O_WUKV + al((size_t)2048 * KVR * 2);
constexpr size_t O_WOG = O_WOM + al((size_t)D * D * 2);
constexpr size_t O_WOUT = O_WOG + al((size_t)D * D * 2);
constexpr size_t O_WS = O_WOUT + al((size_t)D * D * 2);
constexpr size_t O_ROPE = O_WS + al((size_t)2048 * D * 2);
constexpr size_t O_R1 = O_ROPE + al((size_t)2064 * RH * 2 * 4);
constexpr size_t O_RQ = O_R1 + al((size_t)ME * 4);
constexpr size_t O_RKV = O_RQ + al((size_t)ME * 4);
constexpr size_t O_KPE = O_RKV + al((size_t)ME * 4);
constexpr size_t O_XB = O_KPE + al((size_t)ME * ROPE * 2);
constexpr size_t O_P0 = O_XB + al((size_t)ME * D * 2);
constexpr size_t O_GKT = O_P0 + al((size_t)ME * P0W * 2);
constexpr size_t O_GQ = O_GKT + al((size_t)ME * GDK * 2);
constexpr size_t O_GK = O_GQ + al((size_t)ME * GDK * 2);
constexpr size_t O_GVT = O_GK + al((size_t)ME * GDK * 2);
constexpr size_t O_GG = O_GVT + al((size_t)ME * GDV * 2);
constexpr size_t O_QC = O_GG + al((size_t)M * D * 2);
constexpr size_t O_KN = O_QC + al((size_t)M * 768 * 2);
constexpr size_t O_V = O_KN + al((size_t)ME * 512 * 2);
constexpr size_t O_END = O_V + al((size_t)ME * 512 * 2);
constexpr size_t O_YA = O_XB;
constexpr size_t O_DEC = O_QC;
constexpr size_t O_YB = O_P0;
static_assert(O_YB + (size_t)M * D * 2 <= O_GQ, "YB overlay");
constexpr size_t O_MIX = O_GVT;
constexpr size_t O_HN2 = O_XB;
constexpr size_t O_S = O_P0;
constexpr size_t O_IDX = O_QC;
static_assert(O_S + (size_t)M * 2048 * 4 <= O_QC, "S overlay");
constexpr size_t O_GATE = O_IDX + al((size_t)M * 128 * 4);
constexpr size_t O_UB = O_GATE + al((size_t)M * 128 * 4);
constexpr size_t O_VB = O_UB + al((size_t)16384 * D * 2);
static_assert(O_VB + (size_t)16384 * D * 2 <= 512 * MiB, "ws");
static_assert(O_END <= 512 * MiB, "ws");
static_assert(O_DEC + (size_t)ME * 512 * 4 <= O_END, "dec");

__device__ __forceinline__ float bf2f(bf16_t u) { return __uint_as_float((unsigned)u << 16); }
__device__ __forceinline__ bf16_t f2bf(float f) { unsigned u = __float_as_uint(f); return (bf16_t)((u + 0x7fffu + ((u >> 16) & 1u)) >> 16); }
__device__ __forceinline__ unsigned pk2(float lo, float hi) { return (unsigned)f2bf(lo) | ((unsigned)f2bf(hi) << 16); }
__device__ __forceinline__ void unpack8(u32x4 w, float* f) {
#pragma unroll
    for (int i = 0; i < 4; ++i) { f[2 * i] = __uint_as_float(w[i] << 16); f[2 * i + 1] = __uint_as_float(w[i] & 0xffff0000u); }
}
__device__ __forceinline__ u32x4 pack8(const float* f) { u32x4 w; w.x = pk2(f[0], f[1]); w.y = pk2(f[2], f[3]); w.z = pk2(f[4], f[5]); w.w = pk2(f[6], f[7]); return w; }
__device__ __forceinline__ float wsum(float v) {
#pragma unroll
    for (int o = 32; o >= 1; o >>= 1) v += __shfl_xor(v, o);
    return v;
}
__device__ __forceinline__ float wmax(float v) {
#pragma unroll
    for (int o = 32; o >= 1; o >>= 1) v = fmaxf(v, __shfl_xor(v, o));
    return v;
}
__device__ __forceinline__ float sigmoidf_(float x) { return 1.f / (1.f + __expf(-x)); }
__device__ __forceinline__ int tok_pos(int row) { return row < M ? (row & (SEQ - 1)) + NMETA : row - M; }

__global__ __launch_bounds__(256) void k_prep_x(const float* __restrict__ x, const float* __restrict__ meta, bf16_t* __restrict__ XB, float* __restrict__ R1) {
    const int lane = threadIdx.x & 63, gw = (blockIdx.x * 256 + threadIdx.x) >> 6, nw = gridDim.x * 4;
    for (int r = gw; r < ME; r += nw) {
        const float* src = r < M ? x + (size_t)r * D : (r < M + NMETA ? meta + (size_t)(r - M) * D : nullptr);
        f32x4 v[4]; float ss = 0.f;
#pragma unroll
        for (int j = 0; j < 4; ++j) { v[j] = src ? *(const f32x4*)(src + 256 * j + 4 * lane) : (f32x4){0.f, 0.f, 0.f, 0.f}; ss += v[j].x * v[j].x + v[j].y * v[j].y + v[j].z * v[j].z + v[j].w * v[j].w; }
        ss = wsum(ss);
        if (lane == 0) R1[r] = rsqrtf(ss * (1.f / D) + EPS);
#pragma unroll
        for (int j = 0; j < 4; ++j) { unsigned long long o = (unsigned long long)pk2(v[j].x, v[j].y) | ((unsigned long long)pk2(v[j].z, v[j].w) << 32); *(unsigned long long*)(XB + (size_t)r * D + 256 * j + 4 * lane) = o; }
    }
}
enum { MAP_ID = 0, MAP_WIN = 1, MAP_UKV = 2 };
__device__ __forceinline__ int map_col(int mode, int n) {
    if (mode == MAP_ID) return n;
    if (mode == MAP_WIN) {
        if (n < 704) return n;
        if (n < 720) return S_GA + (n - 704);
        if (n < 768) return -1;
        if (n < 1280) return S_GQ + (n - 768);
        if (n < 1792) return S_GK + (n - 1280);
        if (n < 2816) return S_GG + (n - 1792);
        if (n < 3840) return S_A + (n - 2816);
        if (n < 4864) return S_B + (n - 3840);
        if (n < 5376) return S_GK + (n - 4864);
        return S_GV + (n - 5376);
    }
    const int r = n >> 10, j = n & 1023;
    if (j < 512) return (4 * r + (j >> 7)) * 256 + (j & 127);
    return (4 * r + ((j - 512) >> 7)) * 256 + 128 + ((j - 512) & 127);
}
__global__ __launch_bounds__(256) void k_prep_w(const float* __restrict__ src, int Nsrc, int K, bf16_t* __restrict__ dst, int Ndst, const float* __restrict__ gain, int gmod, int mode) {
    const size_t total = (size_t)K * Ndst;
    for (size_t i = (size_t)blockIdx.x * 256 + threadIdx.x; i < total; i += (size_t)gridDim.x * 256) {
        const int k = (int)(i / Ndst), n = (int)(i % Ndst), c = map_col(mode, n);
        float v = c < 0 ? 0.f : src[(size_t)k * Nsrc + c];
        if (gain) v *= gain[k % gmod];
        dst[(size_t)n * K + k] = f2bf(v);
    }
}
__global__ __launch_bounds__(256) void k_prep_ws(const float* __restrict__ wq, const float* __restrict__ keys, bf16_t* __restrict__ WsT) {
    const size_t total = (size_t)2048 * D;
    for (size_t i = (size_t)blockIdx.x * 256 + threadIdx.x; i < total; i += (size_t)gridDim.x * 256) {
        const int n = (int)(i / D), k = (int)(i % D), hp = n >> 7, nn = n & 127;
        const float* a = wq + (size_t)k * 2048 + hp * 128; const float* b = keys + ((size_t)(hp & 1) * 128 + nn) * 128;
        float s = 0.f;
        for (int d = 0; d < 128; ++d) s += a[d] * b[d];
        WsT[(size_t)n * D + k] = f2bf(s);
    }
}
__global__ __launch_bounds__(256) void k_prep_rope(float* __restrict__ RT) {
    const int i = blockIdx.x * 256 + threadIdx.x;
    if (i < 2064 * RH) { const int pos = i / RH, f = i % RH; const float inv = powf(10000.f, -(float)f / (float)RH); const float ang = (float)pos * inv; RT[2 * i] = cosf(ang); RT[2 * i + 1] = sinf(ang); }
}

template <class Epi>
__global__ __launch_bounds__(256) void k_gemm(const bf16_t* __restrict__ A, int lda, const bf16_t* __restrict__ Bt, int ldb, int K, Epi E) {
    __shared__ float As[32][132];
    __shared__ float Bs[32][132];
    const int tid = threadIdx.x, ty = tid >> 4, tx = tid & 15;
    const int row0 = blockIdx.y * 128, col0 = blockIdx.x * 128;
    float acc[8][8];
#pragma unroll
    for (int i = 0; i < 8; ++i)
#pragma unroll
        for (int j = 0; j < 8; ++j) acc[i][j] = 0.f;
    const int lr = tid >> 1, lk = (tid & 1) * 16;
    for (int k0 = 0; k0 < K; k0 += 32) {
        const u32x4 a0 = *(const u32x4*)(A + (size_t)(row0 + lr) * lda + k0 + lk), a1 = *(const u32x4*)(A + (size_t)(row0 + lr) * lda + k0 + lk + 8);
        const u32x4 b0 = *(const u32x4*)(Bt + (size_t)(col0 + lr) * ldb + k0 + lk), b1 = *(const u32x4*)(Bt + (size_t)(col0 + lr) * ldb + k0 + lk + 8);
        float fa[16], fb[16]; unpack8(a0, fa); unpack8(a1, fa + 8); unpack8(b0, fb); unpack8(b1, fb + 8);
        __syncthreads();
#pragma unroll
        for (int i = 0; i < 16; ++i) { As[lk + i][lr] = fa[i]; Bs[lk + i][lr] = fb[i]; }
        __syncthreads();
#pragma unroll 8
        for (int k = 0; k < 32; ++k) {
            const f32x4 x0 = *(const f32x4*)&As[k][8 * ty], x1 = *(const f32x4*)&As[k][8 * ty + 4];
            const f32x4 y0 = *(const f32x4*)&Bs[k][8 * tx], y1 = *(const f32x4*)&Bs[k][8 * tx + 4];
            const float a[8] = {x0.x, x0.y, x0.z, x0.w, x1.x, x1.y, x1.z, x1.w}, b[8] = {y0.x, y0.y, y0.z, y0.w, y1.x, y1.y, y1.z, y1.w};
#pragma unroll
            for (int i = 0; i < 8; ++i)
#pragma unroll
                for (int j = 0; j < 8; ++j) acc[i][j] = fmaf(a[i], b[j], acc[i][j]);
        }
    }
#pragma unroll
    for (int i = 0; i < 8; ++i) E(row0 + 8 * ty + i, col0 + 8 * tx, acc[i]);
}

struct EpiProjNat {
    const float* R1; bf16_t *P0, *GQ, *GK, *GG, *GA, *GB;
    __device__ __forceinline__ void operator()(int row, int col, const float* v) const {
        const float s = R1[row]; float o[8];
#pragma unroll
        for (int i = 0; i < 8; ++i) o[i] = v[i] * s;
        bf16_t* dst;
        if (col < 768) dst = P0 + (size_t)row * P0W + col;
        else if (col < 1280) dst = GQ + (size_t)row * GDK + (col - 768);
        else if (col < 1792) dst = GK + (size_t)row * GDK + (col - 1280);
        else { if (row >= M) return;
            if (col < 2816) dst = GG + (size_t)row * D + (col - 1792);
            else if (col < 3840) dst = GA + (size_t)row * D + (col - 2816);
            else dst = GB + (size_t)row * D + (col - 3840); }
        *(u32x4*)dst = pack8(o);
    }
};
struct EpiProjTr {
    const float* R1; bf16_t *GKT, *GVT;
    __device__ __forceinline__ void operator()(int row, int col, const float* v) const {
        float o[8];
#pragma unroll
        for (int i = 0; i < 8; ++i) o[i] = v[i] * R1[col + i];
        bf16_t* dst = row < 512 ? GKT + (size_t)row * ME + col : GVT + (size_t)(row - 512) * ME + col;
        *(u32x4*)dst = pack8(o);
    }
};
struct EpiUq {
    const float* RQ; bf16_t* QC;
    __device__ __forceinline__ void operator()(int row, int col, const float* v) const {
        if (row >= M) return;
        const float s = RQ[row]; float o[8];
#pragma unroll
        for (int i = 0; i < 8; ++i) o[i] = v[i] * s;
        *(u32x4*)(QC + (size_t)row * 768 + col) = pack8(o);
    }
};
struct EpiUkv {
    const float* RKV; bf16_t *KN, *V;
    __device__ __forceinline__ void operator()(int row, int col, const float* v) const {
        const float s = RKV[row]; float o[8];
#pragma unroll
        for (int i = 0; i < 8; ++i) o[i] = v[i] * s;
        bf16_t* dst = col < 512 ? KN + (size_t)row * 512 + col : V + (size_t)row * 512 + (col - 512);
        *(u32x4*)dst = pack8(o);
    }
};
struct EpiMix1 { const bf16_t* GA; bf16_t* MIX;
    __device__ __forceinline__ void operator()(int row, int col, const float* v) const {
        float g[8], o[8]; unpack8(*(const u32x4*)(GA + (size_t)row * D + col), g);
#pragma unroll
        for (int i = 0; i < 8; ++i) o[i] = v[i] * sigmoidf_(g[i]);
        *(u32x4*)(MIX + (size_t)row * D + col) = pack8(o);
    }
};
struct EpiMix2 { const bf16_t* GB; bf16_t* MIX;
    __device__ __forceinline__ void operator()(int row, int col, const float* v) const {
        float g[8], o[8], p[8]; unpack8(*(const u32x4*)(GB + (size_t)row * D + col), g); unpack8(*(const u32x4*)(MIX + (size_t)row * D + col), p);
#pragma unroll
        for (int i = 0; i < 8; ++i) o[i] = p[i] + v[i] * sigmoidf_(g[i]);
        *(u32x4*)(MIX + (size_t)row * D + col) = pack8(o);
    }
};
struct EpiOut { const float* x; float* out;
    __device__ __forceinline__ void operator()(int row, int col, const float* v) const {
        const f32x4 a = *(const f32x4*)(x + (size_t)row * D + col), b = *(const f32x4*)(x + (size_t)row * D + col + 4);
        *(f32x4*)(out + (size_t)row * D + col) = (f32x4){a.x + v[0], a.y + v[1], a.z + v[2], a.w + v[3]};
        *(f32x4*)(out + (size_t)row * D + col + 4) = (f32x4){b.x + v[4], b.y + v[5], b.z + v[6], b.w + v[7]};
    }
};
struct EpiScore { float* S;
    __device__ __forceinline__ void operator()(int row, int col, const float* v) const {
        *(f32x4*)(S + (size_t)row * 2048 + col) = (f32x4){v[0], v[1], v[2], v[3]};
        *(f32x4*)(S + (size_t)row * 2048 + col + 4) = (f32x4){v[4], v[5], v[6], v[7]};
    }
};

__global__ __launch_bounds__(256) void k_p0stats(const bf16_t* __restrict__ P0, const float* __restrict__ kn_pe, const float* __restrict__ RT, float* __restrict__ RQ, float* __restrict__ RKV, bf16_t* __restrict__ KPE) {
    const int lane = threadIdx.x & 63, gw = (blockIdx.x * 256 + threadIdx.x) >> 6, nw = gridDim.x * 4;
    for (int r = gw; r < ME; r += nw) {
        const bf16_t* p = P0 + (size_t)r * P0W;
        float sq = 0.f, skv = 0.f;
#pragma unroll
        for (int j = 0; j < 6; ++j) { const float v = bf2f(p[lane + 64 * j]); sq += v * v; }
#pragma unroll
        for (int j = 0; j < 4; ++j) { const float v = bf2f(p[384 + lane + 64 * j]); skv += v * v; }
        const float kp = bf2f(p[640 + lane]);
        sq = wsum(sq); skv = wsum(skv); const float sk = wsum(kp * kp);
        if (lane == 0) { RQ[r] = rsqrtf(sq * (1.f / QR) + EPS); RKV[r] = rsqrtf(skv * (1.f / KVR) + EPS); }
        const float y = kp * rsqrtf(sk * (1.f / ROPE) + EPS) * kn_pe[lane];
        const float yo = __shfl_xor(y, 32);
        const int pos = tok_pos(r) < 2064 ? tok_pos(r) : 0, f = lane & 31;
        const float c = RT[(pos * RH + f) * 2], s = RT[(pos * RH + f) * 2 + 1];
        const float o = lane < 32 ? y * c - yo * s : y * c + yo * s;
        KPE[(size_t)r * ROPE + lane] = f2bf(o);
    }
}
__global__ __launch_bounds__(256) void k_qknorm(bf16_t* __restrict__ QC, bf16_t* __restrict__ KN, const float* __restrict__ qn_nope, const float* __restrict__ qn_pe, const float* __restrict__ kn_nope, const float* __restrict__ RT) {
    const int lane = threadIdx.x & 63, gw = (blockIdx.x * 256 + threadIdx.x) >> 6, nw = gridDim.x * 4;
    for (int it = gw; it < M * 4; it += nw) {
        const int row = it >> 2, hh = it & 3; bf16_t* p = QC + (size_t)row * 768 + hh * QKD;
        const float a = bf2f(p[lane]), b = bf2f(p[lane + 64]), e = bf2f(p[128 + lane]);
        const float rn = rsqrtf(wsum(a * a + b * b) * (1.f / NOPE) + EPS), rp = rsqrtf(wsum(e * e) * (1.f / ROPE) + EPS);
        p[lane] = f2bf(a * rn * qn_nope[lane] * SCL2); p[lane + 64] = f2bf(b * rn * qn_nope[lane + 64] * SCL2);
        const float y = e * rp * qn_pe[lane], yo = __shfl_xor(y, 32);
        const int pos = tok_pos(row), f = lane & 31; const float c = RT[(pos * RH + f) * 2], s = RT[(pos * RH + f) * 2 + 1];
        p[128 + lane] = f2bf((lane < 32 ? y * c - yo * s : y * c + yo * s) * SCL2);
    }
    for (int it = gw; it < ME * 4; it += nw) {
        const int row = it >> 2, hh = it & 3; bf16_t* p = KN + (size_t)row * 512 + hh * NOPE;
        const float a = bf2f(p[lane]), b = bf2f(p[lane + 64]);
        const float rn = rsqrtf(wsum(a * a + b * b) * (1.f / NOPE) + EPS);
        p[lane] = f2bf(a * rn * kn_nope[lane]); p[lane + 64] = f2bf(b * rn * kn_nope[lane + 64]);
    }
}
__global__ __launch_bounds__(256) void k_attn(const bf16_t* __restrict__ QC, const bf16_t* __restrict__ KN, const bf16_t* __restrict__ KPE, const bf16_t* __restrict__ V, bf16_t* __restrict__ YA, int round) {
    __shared__ float qs[4][QKD];
    const int lane = threadIdx.x & 63, wv = threadIdx.x >> 6, gw = (blockIdx.x * 256 + threadIdx.x) >> 6, nw = gridDim.x * 4;
    for (int it = gw; it < M * 4; it += nw) {
        const int m = it >> 2, hh = it & 3, b = m >> 11, t = m & (SEQ - 1), c = t >> 6;
        const bf16_t* q = QC + (size_t)m * 768 + hh * QKD;
        qs[wv][lane] = bf2f(q[lane]); qs[wv][lane + 64] = bf2f(q[lane + 64]); qs[wv][lane + 128] = bf2f(q[lane + 128]);
        float mrun = -1e30f, l = 0.f, o0 = 0.f, o1 = 0.f;
        for (int kb = -1; kb <= c; ++kb) {
            const int kbase = kb < 0 ? M : b * SEQ + 64 * kb, krow = kbase + lane;
            const bool valid = kb >= 0 || lane < NMETA;
            float s = 0.f;
            const bf16_t* kr = KN + (size_t)krow * 512 + hh * NOPE; const bf16_t* kp = KPE + (size_t)krow * ROPE;
#pragma unroll 4
            for (int d = 0; d < NOPE; d += 8) { float f[8]; unpack8(*(const u32x4*)(kr + d), f);
#pragma unroll
                for (int i = 0; i < 8; ++i) s += qs[wv][d + i] * f[i]; }
#pragma unroll 4
            for (int d = 0; d < ROPE; d += 8) { float f[8]; unpack8(*(const u32x4*)(kp + d), f);
#pragma unroll
                for (int i = 0; i < 8; ++i) s += qs[wv][NOPE + d + i] * f[i]; }
            if (!valid) s = -INFINITY;
            const float bm = wmax(s), mn = fmaxf(mrun, bm), alpha = exp2f(mrun - mn), p = valid ? exp2f(s - mn) : 0.f;
            l = l * alpha + wsum(p); o0 *= alpha; o1 *= alpha; mrun = mn;
            const int nk = kb < 0 ? NMETA : 64;
            for (int j = 0; j < nk; ++j) { const float pj = __shfl(p, j); const bf16_t* vr = V + (size_t)(kbase + j) * 512 + hh * 128;
                o0 += pj * bf2f(vr[lane]); o1 += pj * bf2f(vr[lane + 64]); }
        }
        const float il = 1.f / l;
        bf16_t* y = YA + (size_t)m * D + (round * 4 + hh) * 128;
        y[lane] = f2bf(o0 * il); y[lane + 64] = f2bf(o1 * il);
    }
}

__global__ __launch_bounds__(256) void k_gla_dec(const bf16_t* __restrict__ P0, const float* __restrict__ w_a2, const float* __restrict__ b_a, float* __restrict__ DEC) {
    const size_t total = (size_t)ME * GDK;
    for (size_t i = (size_t)blockIdx.x * 256 + threadIdx.x; i < total; i += (size_t)gridDim.x * 256) {
        const int row = (int)(i / GDK), c = (int)(i % GDK);
        float x = b_a[c];
#pragma unroll
        for (int r = 0; r < GR; ++r) x += bf2f(P0[(size_t)row * P0W + 704 + r]) * w_a2[r * GDK + c];
        const float ls = fminf(x, 0.f) - log1pf(__expf(-fabsf(x)));
        DEC[i] = __expf(ls * (1.f / 16.f));
    }
}
__global__ __launch_bounds__(256) void k_gla_naive(const bf16_t* __restrict__ GQ, const bf16_t* __restrict__ GK, const bf16_t* __restrict__ GVT, const float* __restrict__ DEC, bf16_t* __restrict__ OG) {
    const int b = blockIdx.x >> 2, h = blockIdx.x & 3, e = threadIdx.x;
    float S[GHK];
#pragma unroll
    for (int d = 0; d < GHK; ++d) S[d] = 0.f;
    const bf16_t* vt = GVT + (size_t)(h * GHV + e) * ME;
    for (int tk = 0; tk < NMETA + SEQ; ++tk) {
        const int row = tk < NMETA ? M + tk : b * SEQ + (tk - NMETA);
        const float v = bf2f(vt[row]);
        const bf16_t* qp = GQ + (size_t)row * GDK + h * GHK; const bf16_t* kp = GK + (size_t)row * GDK + h * GHK; const float* ap = DEC + (size_t)row * GDK + h * GHK;
        float o = 0.f;
#pragma unroll
        for (int d = 0; d < GHK; ++d) { S[d] = ap[d] * S[d] + bf2f(kp[d]) * v; o += bf2f(qp[d]) * S[d]; }
        if (tk >= NMETA) OG[(size_t)row * D + h * GHV + e] = f2bf(o * GLA_QS);
    }
}
__global__ __launch_bounds__(256) void k_gla_post(bf16_t* __restrict__ OG, const bf16_t* __restrict__ GG) {
    const int lane = threadIdx.x & 63, gw = (blockIdx.x * 256 + threadIdx.x) >> 6, nw = gridDim.x * 4;
    for (int it = gw; it < M * 4; it += nw) {
        const size_t off = (size_t)(it >> 2) * D + (it & 3) * GHV + 4 * lane;
        const unsigned long long w = *(const unsigned long long*)(OG + off), g = *(const unsigned long long*)(GG + off);
        float o[4], gg[4];
#pragma unroll
        for (int i = 0; i < 4; ++i) { o[i] = bf2f((bf16_t)(w >> (16 * i))); gg[i] = bf2f((bf16_t)(g >> (16 * i))); }
        const float rn = rsqrtf(wsum(o[0] * o[0] + o[1] * o[1] + o[2] * o[2] + o[3] * o[3]) * (1.f / GHV) + EPS);
#pragma unroll
        for (int i = 0; i < 4; ++i) o[i] = o[i] * rn * gg[i] * sigmoidf_(gg[i]);
        *(unsigned long long*)(OG + off) = (unsigned long long)pk2(o[0], o[1]) | ((unsigned long long)pk2(o[2], o[3]) << 32);
    }
}

__global__ __launch_bounds__(256) void k_rms2(const float* __restrict__ H2, const float* __restrict__ g, bf16_t* __restrict__ HN) {
    const int lane = threadIdx.x & 63, gw = (blockIdx.x * 256 + threadIdx.x) >> 6, nw = gridDim.x * 4;
    for (int r = gw; r < M; r += nw) {
        f32x4 v[4]; float ss = 0.f;
#pragma unroll
        for (int j = 0; j < 4; ++j) { v[j] = *(const f32x4*)(H2 + (size_t)r * D + 256 * j + 4 * lane); ss += v[j].x * v[j].x + v[j].y * v[j].y + v[j].z * v[j].z + v[j].w * v[j].w; }
        const float rn = rsqrtf(wsum(ss) * (1.f / D) + EPS);
#pragma unroll
        for (int j = 0; j < 4; ++j) { const f32x4 gg = *(const f32x4*)(g + 256 * j + 4 * lane);
            *(unsigned long long*)(HN + (size_t)r * D + 256 * j + 4 * lane) = (unsigned long long)pk2(v[j].x * rn * gg.x, v[j].y * rn * gg.y) | ((unsigned long long)pk2(v[j].z * rn * gg.z, v[j].w * rn * gg.w) << 32); }
    }
}
__global__ __launch_bounds__(64) void k_topk(const float* __restrict__ S, int* __restrict__ IDX, float* __restrict__ GATE) {
    __shared__ float tv[64][33];
    __shared__ int ti[64][33];
    const int tid = threadIdx.x; const int it = blockIdx.x * 64 + tid;
    const float* s = S + (size_t)it * 256;
    for (int p = 0; p < 2; ++p) {
        float pv = INFINITY; int pi = -1;
        for (int k = 0; k < 16; ++k) {
            float bv = -INFINITY; int bi = 1 << 30;
            for (int n = 0; n < 128; ++n) { const float x = s[p * 128 + n];
                const bool after = x < pv || (x == pv && n > pi);
                if (after && (x > bv || (x == bv && n < bi))) { bv = x; bi = n; } }
            tv[tid][p * 16 + k] = bv; ti[tid][p * 16 + k] = bi; pv = bv; pi = bi;
        }
    }
    float pv = INFINITY; int pi = -1; float bs[16]; float mx = 0.f;
#pragma unroll
    for (int k = 0; k < 16; ++k) {
        float bv = -INFINITY; int bi = 1 << 30;
        for (int c = 0; c < 256; ++c) { const float x = tv[tid][c >> 4] + tv[tid][16 + (c & 15)];
            const bool after = x < pv || (x == pv && c > pi);
            if (after && (x > bv || (x == bv && c < bi))) { bv = x; bi = c; } }
        bs[k] = bv; pv = bv; pi = bi; if (k == 0) mx = bv;
        IDX[(size_t)it * 16 + k] = ti[tid][bi >> 4] * 128 + ti[tid][16 + (bi & 15)];
    }
    float sum = 0.f;
#pragma unroll
    for (int k = 0; k < 16; ++k) { bs[k] = __expf(bs[k] - mx); sum += bs[k]; }
    const float inv = 1.f / sum;
#pragma unroll
    for (int k = 0; k < 16; ++k) GATE[(size_t)it * 16 + k] = bs[k] * inv;
}
__global__ __launch_bounds__(256) void k_conv(const float* __restrict__ a, bf16_t* __restrict__ ao, size_t n8) {
    for (size_t i = (size_t)blockIdx.x * 256 + threadIdx.x; i < n8; i += (size_t)gridDim.x * 256) {
        const f32x4 x = *(const f32x4*)(a + i * 8), y = *(const f32x4*)(a + i * 8 + 4);
        u32x4 w; w.x = pk2(x.x, x.y); w.y = pk2(x.z, x.w); w.z = pk2(y.x, y.y); w.w = pk2(y.z, y.w);
        *(u32x4*)(ao + i * 8) = w;
    }
}
__global__ __launch_bounds__(256) void k_peer(const bf16_t* __restrict__ HN, const int* __restrict__ IDX, const float* __restrict__ GATE, const bf16_t* __restrict__ UB, const bf16_t* __restrict__ VB, float* __restrict__ out) {
    const int lane = threadIdx.x & 63, gw = (blockIdx.x * 256 + threadIdx.x) >> 6, nw = gridDim.x * 4;
    for (int m = gw; m < M; m += nw) {
        float hn[16], acc[16];
        unpack8(*(const u32x4*)(HN + (size_t)m * D + 8 * lane), hn); unpack8(*(const u32x4*)(HN + (size_t)m * D + 512 + 8 * lane), hn + 8);
#pragma unroll
        for (int i = 0; i < 16; ++i) acc[i] = 0.f;
        for (int e = 0; e < 128; ++e) {
            const int idx = IDX[(size_t)m * 128 + e]; const float g = GATE[(size_t)m * 128 + e];
            float u[16]; unpack8(*(const u32x4*)(UB + (size_t)idx * D + 8 * lane), u); unpack8(*(const u32x4*)(UB + (size_t)idx * D + 512 + 8 * lane), u + 8);
            float d = 0.f;
#pragma unroll
            for (int i = 0; i < 16; ++i) d += hn[i] * u[i];
            d = wsum(d);
            const float a = 0.5f * d * (1.f + erff(d * 0.70710678118654752f)) * g;
            float v[16]; unpack8(*(const u32x4*)(VB + (size_t)idx * D + 8 * lane), v); unpack8(*(const u32x4*)(VB + (size_t)idx * D + 512 + 8 * lane), v + 8);
#pragma unroll
            for (int i = 0; i < 16; ++i) acc[i] += a * v[i];
        }
        float* o = out + (size_t)m * D;
        f32x4 a0 = *(f32x4*)(o + 8 * lane), a1 = *(f32x4*)(o + 8 * lane + 4), b0 = *(f32x4*)(o + 512 + 8 * lane), b1 = *(f32x4*)(o + 512 + 8 * lane + 4);
        a0 += (f32x4){acc[0], acc[1], acc[2], acc[3]}; a1 += (f32x4){acc[4], acc[5], acc[6], acc[7]};
        b0 += (f32x4){acc[8], acc[9], acc[10], acc[11]}; b1 += (f32x4){acc[12], acc[13], acc[14], acc[15]};
        *(f32x4*)(o + 8 * lane) = a0; *(f32x4*)(o + 8 * lane + 4) = a1; *(f32x4*)(o + 512 + 8 * lane) = b0; *(f32x4*)(o + 512 + 8 * lane + 4) = b1;
    }
}

template <class Epi> static void gemm(hipStream_t st, const bf16_t* A, int lda, const bf16_t* Bt, int ldb, int Mr, int N, int K, Epi E) {
    hipLaunchKernelGGL(k_gemm<Epi>, dim3(N / 128, Mr / 128), dim3(256), 0, st, A, lda, Bt, ldb, K, E);
}
extern "C" void kernel_launch(void* const* d_in, const int* in_sizes, int n_in, void* d_out, int out_size, void* d_ws, size_t ws_size, hipStream_t st) {
    (void)in_sizes; (void)n_in; (void)out_size;
    if (ws_size < 512 * MiB) { fprintf(stderr, "kernel_launch: workspace %zu < 512 MiB\n", ws_size); return; }
    const float* x = (const float*)d_in[0]; const float* meta = (const float*)d_in[1]; const float* norm_mix = (const float*)d_in[2]; const float* w_in = (const float*)d_in[3];
    const float* q_norm = (const float*)d_in[4]; const float* w_uq = (const float*)d_in[5]; const float* kv_norm = (const float*)d_in[6]; const float* w_ukv = (const float*)d_in[7];
    const float* qn_nope = (const float*)d_in[8]; const float* qn_pe = (const float*)d_in[9]; const float* kn_nope = (const float*)d_in[10]; const float* kn_pe = (const float*)d_in[11];
    const float* w_a2 = (const float*)d_in[12]; const float* b_a = (const float*)d_in[13]; const float* gla_norm = (const float*)d_in[14];
    const float* w_o_mla = (const float*)d_in[15]; const float* w_o_gla = (const float*)d_in[16]; const float* w_out = (const float*)d_in[17]; const float* norm_ffn = (const float*)d_in[18];
    const float* peer_wq = (const float*)d_in[19]; const float* peer_keys = (const float*)d_in[20]; const float* peer_u = (const float*)d_in[21]; const float* peer_v = (const float*)d_in[22];
    char* ws = (char*)d_ws; float* out = (float*)d_out;
    bf16_t *WinT = (bf16_t*)(ws + O_WIN), *WuqT = (bf16_t*)(ws + O_WUQ), *WukvT = (bf16_t*)(ws + O_WUKV), *WomT = (bf16_t*)(ws + O_WOM), *WogT = (bf16_t*)(ws + O_WOG), *WoutT = (bf16_t*)(ws + O_WOUT), *WsT = (bf16_t*)(ws + O_WS);
    float *RT = (float*)(ws + O_ROPE), *R1 = (float*)(ws + O_R1), *RQ = (float*)(ws + O_RQ), *RKV = (float*)(ws + O_RKV);
    bf16_t *KPE = (bf16_t*)(ws + O_KPE), *XB = (bf16_t*)(ws + O_XB), *P0 = (bf16_t*)(ws + O_P0), *GQ = (bf16_t*)(ws + O_GQ), *GK = (bf16_t*)(ws + O_GK), *GKT = (bf16_t*)(ws + O_GKT), *GVT = (bf16_t*)(ws + O_GVT), *GG = (bf16_t*)(ws + O_GG);
    bf16_t *QC = (bf16_t*)(ws + O_QC), *KN = (bf16_t*)(ws + O_KN), *V = (bf16_t*)(ws + O_V), *YA = (bf16_t*)(ws + O_YA), *MIX = (bf16_t*)(ws + O_MIX), *HN2 = (bf16_t*)(ws + O_HN2);
    bf16_t *GA = (bf16_t*)out, *GB = (bf16_t*)out + (size_t)M * D;
    float* DEC = (float*)(ws + O_DEC); float* S = (float*)(ws + O_S); int* IDX = (int*)(ws + O_IDX); float* GATE = (float*)(ws + O_GATE); bf16_t *UB = (bf16_t*)(ws + O_UB), *VB = (bf16_t*)(ws + O_VB);
    const int G = 2048;
    hipLaunchKernelGGL(k_prep_x, dim3(G), dim3(256), 0, st, x, meta, XB, R1);
    hipLaunchKernelGGL(k_prep_w, dim3(G), dim3(256), 0, st, w_in, DIN, D, WinT, WIN_ROWS, norm_mix, D, (int)MAP_WIN);
    hipLaunchKernelGGL(k_prep_w, dim3(G), dim3(256), 0, st, w_uq, 1536, QR, WuqT, 1536, q_norm, QR, (int)MAP_ID);
    hipLaunchKernelGGL(k_prep_w, dim3(G), dim3(256), 0, st, w_ukv, 2048, KVR, WukvT, 2048, kv_norm, KVR, (int)MAP_UKV);
    hipLaunchKernelGGL(k_prep_w, dim3(G), dim3(256), 0, st, w_o_mla, D, D, WomT, D, (const float*)nullptr, 1, (int)MAP_ID);
    hipLaunchKernelGGL(k_prep_w, dim3(G), dim3(256), 0, st, w_o_gla, D, D, WogT, D, gla_norm, GHV, (int)MAP_ID);
    hipLaunchKernelGGL(k_prep_w, dim3(G), dim3(256), 0, st, w_out, D, D, WoutT, D, (const float*)nullptr, 1, (int)MAP_ID);
    hipLaunchKernelGGL(k_prep_ws, dim3(G), dim3(256), 0, st, peer_wq, peer_keys, WsT);
    hipLaunchKernelGGL(k_prep_rope, dim3((2064 * RH + 255) / 256), dim3(256), 0, st, RT);
    gemm(st, XB, D, WinT, D, ME, WIN_NAT, D, EpiProjNat{R1, P0, GQ, GK, GG, GA, GB});
    gemm(st, WinT + (size_t)WIN_NAT * D, D, XB, D, 1536, ME, D, EpiProjTr{R1, GKT, GVT});
    hipLaunchKernelGGL(k_p0stats, dim3(G), dim3(256), 0, st, P0, kn_pe, RT, RQ, RKV, KPE);
    for (int r = 0; r < 2; ++r) {
        gemm(st, P0, P0W, WuqT + (size_t)r * 768 * QR, QR, ME, 768, QR, EpiUq{RQ, QC});
        gemm(st, P0 + S_CKV, P0W, WukvT + (size_t)r * 1024 * KVR, KVR, ME, 1024, KVR, EpiUkv{RKV, KN, V});
        hipLaunchKernelGGL(k_qknorm, dim3(G), dim3(256), 0, st, QC, KN, qn_nope, qn_pe, kn_nope, RT);
        hipLaunchKernelGGL(k_attn, dim3(G), dim3(256), 0, st, QC, KN, KPE, V, YA, r);
    }
    hipLaunchKernelGGL(k_gla_dec, dim3(G), dim3(256), 0, st, P0, w_a2, b_a, DEC);
    bf16_t* YB = (bf16_t*)(ws + O_YB);
    hipLaunchKernelGGL(k_gla_naive, dim3(NB * 4), dim3(256), 0, st, GQ, GK, GVT, DEC, YB);
    hipLaunchKernelGGL(k_gla_post, dim3(G), dim3(256), 0, st, YB, GG);
    gemm(st, YA, D, WomT, D, M, D, D, EpiMix1{GA, MIX});
    gemm(st, YB, D, WogT, D, M, D, D, EpiMix2{GB, MIX});
    gemm(st, MIX, D, WoutT, D, M, D, D, EpiOut{x, out});
    hipLaunchKernelGGL(k_rms2, dim3(G), dim3(256), 0, st, out, norm_ffn, HN2);
    gemm(st, HN2, D, WsT, D, M, 2048, D, EpiScore{S});
    hipLaunchKernelGGL(k_topk, dim3(M * 8 / 64), dim3(64), 0, st, S, IDX, GATE);
    hipLaunchKernelGGL(k_conv, dim3(G), dim3(256), 0, st, peer_u, UB, (size_t)16384 * D / 8);
    hipLaunchKernelGGL(k_conv, dim3(G), dim3(256), 0, st, peer_v, VB, (size_t)16384 * D / 8);
    hipLaunchKernelGGL(k_peer, dim3(G), dim3(256), 0, st, HN2, IDX, GATE, UB, VB, out);
}
```

```cpp
#include <hip/hip_runtime.h>
#include <cstdint>
#include <cstdio>

typedef unsigned short bf16_t;
typedef unsigned u32x4 __attribute__((ext_vector_type(4)));
typedef float f32x4 __attribute__((ext_vector_type(4)));

constexpr int D = 1024, NB = 16, SEQ = 2048, M = NB * SEQ, ME = M + 256, NMETA = 16;
constexpr float EPS = 1e-6f;
constexpr int QR = 384, KVR = 256, NOPE = 128, ROPE = 64, RH = 32, QKD = 192;
constexpr int GDK = 512, GDV = 1024, GHK = 128, GHV = 256, GR = 16;
constexpr int DIN = 5840;
constexpr int S_CQ = 0, S_CKV = 384, S_KPE = 640, S_GQ = 704, S_GK = 1216, S_GV = 1728, S_GA = 2752, S_GG = 2768, S_A = 3792, S_B = 4816;
constexpr int WIN_ROWS = 6400, WIN_NAT = 4864, P0W = 768;
constexpr float SCL2 = 0.07216878364870323f * 1.4426950408889634f;
constexpr float GLA_QS = 0.08838834764831845f;

constexpr size_t MiB = 1u << 20;
constexpr size_t al(size_t x) { return (x + 255) / 256 * 256; }
constexpr size_t O_WIN = 0;
constexpr size_t O_WUQ = O_WIN + al((size_t)WIN_ROWS * D * 2);
constexpr size_t O_WUKV = O_WUQ + al((size_t)1536 * QR * 2);
constexpr size_t O_WOM = O_WUKV + al((size_t)2048 * KVR * 2);
constexpr size_t O_WOG = O_WOM + al((size_t)D * D * 2);
constexpr size_t O_WOUT = O_WOG + al((size_t)D * D * 2);
constexpr size_t O_WS = O_WOUT + al((size_t)D * D * 2);
constexpr size_t O_ROPE = O_WS + al((size_t)2048 * D * 2);
constexpr size_t O_R1 = O_ROPE + al((size_t)2064 * RH * 2 * 4);
constexpr size_t O_RQ = O_R1 + al((size_t)ME * 4);
constexpr size_t O_RKV = O_RQ + al((size_t)ME * 4);
constexpr size_t O_KPE = O_RKV + al((size_t)ME * 4);
constexpr size_t O_XB = O_KPE + al((size_t)ME * ROPE * 2);
constexpr size_t O_P0 = O_XB + al((size_t)ME * D * 2);
constexpr size_t O_GKT = O_P0 + al((size_t)ME * P0W * 2);
constexpr size_t O_GQ = O_GKT + al((size_t)ME * GDK * 2);
constexpr size_t O_GK = O_GQ + al((size_t)ME * GDK * 2);
constexpr size_t O_GVT = O_GK + al((size_t)ME * GDK * 2);
constexpr size_t O_GG = O_GVT + al((size_t)ME * GDV * 2);
constexpr size_t O_QC = O_GG + al((size_t)M * D * 2);
constexpr size_t O_KN = O_QC + al((size_t)M * 768 * 2);
constexpr size_t O_V = O_KN + al((size_t)ME * 512 * 2);
constexpr size_t O_END = O_V + al((size_t)ME * 512 * 2);
constexpr int GLA_NU = NB * 4 * 33;
constexpr size_t O_AG = O_END;
constexpr size_t O_DECL = O_AG + al((size_t)GLA_NU * 64 * 64 * 2);
static_assert(O_DECL + (size_t)GLA_NU * 128 * 4 <= 512 * MiB, "ws");
constexpr size_t O_YA = O_XB;
constexpr size_t O_DEC = O_QC;
constexpr size_t O_YB = O_QC;
static_assert(O_YB + (size_t)M * D * 2 <= O_END, "YB overlay");
constexpr size_t O_MIX = O_GVT;
constexpr size_t O_HN2 = O_XB;
constexpr size_t O_S = O_P0;
constexpr size_t O_IDX = O_QC;
static_assert(O_S + (size_t)M * 2048 * 4 <= O_QC, "S overlay");
constexpr size_t O_GATE = O_IDX + al((size_t)M * 128 * 4);
constexpr size_t O_UB = O_GATE + al((size_t)M * 128 * 4);
constexpr size_t O_VB = O_UB + al((size_t)16384 * D * 2);
static_assert(O_VB + (size_t)16384 * D * 2 <= 512 * MiB, "ws");
static_assert(O_END <= 512 * MiB, "ws");
static_assert(O_DEC + (size_t)ME * 512 * 4 <= O_END, "dec");

__device__ __forceinline__ float bf2f(bf16_t u) { return __uint_as_float((unsigned)u << 16); }
__device__ __forceinline__ bf16_t f2bf(float f) { unsigned u = __float_as_uint(f); return (bf16_t)((u + 0x7fffu + ((u >> 16) & 1u)) >> 16); }
__device__ __forceinline__ unsigned pk2(float lo, float hi) { return (unsigned)f2bf(lo) | ((unsigned)f2bf(hi) << 16); }
__device__ __forceinline__ void unpack8(u32x4 w, float* f) {
#pragma unroll
    for (int i = 0; i < 4; ++i) { f[2 * i] = __uint_as_float(w[i] << 16); f[2 * i + 1] = __uint_as_float(w[i] & 0xffff0000u); }
}
__device__ __forceinline__ u32x4 pack8(const float* f) { u32x4 w; w.x = pk2(f[0], f[1]); w.y = pk2(f[2], f[3]); w.z = pk2(f[4], f[5]); w.w = pk2(f[6], f[7]); return w; }
__device__ __forceinline__ float wsum(float v) {
#pragma unroll
    for (int o = 32; o >= 1; o >>= 1) v += __shfl_xor(v, o);
    return v;
}
__device__ __forceinline__ float wmax(float v) {
#pragma unroll
    for (int o = 32; o >= 1; o >>= 1) v = fmaxf(v, __shfl_xor(v, o));
    return v;
}
__device__ __forceinline__ float sigmoidf_(float x) { return 1.f / (1.f + __expf(-x)); }
__device__ __forceinline__ int tok_pos(int row) { return row < M ? (row & (SEQ - 1)) + NMETA : row - M; }

__global__ __launch_bounds__(256) void k_prep_x(const float* __restrict__ x, const float* __restrict__ meta, bf16_t* __restrict__ XB, float* __restrict__ R1) {
    const int lane = threadIdx.x & 63, gw = (blockIdx.x * 256 + threadIdx.x) >> 6, nw = gridDim.x * 4;
    for (int r = gw; r < ME; r += nw) {
        const float* src = r < M ? x + (size_t)r * D : (r < M + NMETA ? meta + (size_t)(r - M) * D : nullptr);
        f32x4 v[4]; float ss = 0.f;
#pragma unroll
        for (int j = 0; j < 4; ++j) { v[j] = src ? *(const f32x4*)(src + 256 * j + 4 * lane) : (f32x4){0.f, 0.f, 0.f, 0.f}; ss += v[j].x * v[j].x + v[j].y * v[j].y + v[j].z * v[j].z + v[j].w * v[j].w; }
        ss = wsum(ss);
        if (lane == 0) R1[r] = rsqrtf(ss * (1.f / D) + EPS);
#pragma unroll
        for (int j = 0; j < 4; ++j) { unsigned long long o = (unsigned long long)pk2(v[j].x, v[j].y) | ((unsigned long long)pk2(v[j].z, v[j].w) << 32); *(unsigned long long*)(XB + (size_t)r * D + 256 * j + 4 * lane) = o; }
    }
}
enum { MAP_ID = 0, MAP_WIN = 1, MAP_UKV = 2 };
__device__ __forceinline__ int map_col(int mode, int n) {
    if (mode == MAP_ID) return n;
    if (mode == MAP_WIN) {
        if (n < 704) return n;
        if (n < 720) return S_GA + (n - 704);
        if (n < 768) return -1;
        if (n < 1280) return S_GQ + (n - 768);
        if (n < 1792) return S_GK + (n - 1280);
        if (n < 2816) return S_GG + (n - 1792);
        if (n < 3840) return S_A + (n - 2816);
        if (n < 4864) return S_B + (n - 3840);
        if (n < 5376) return S_GK + (n - 4864);
        return S_GV + (n - 5376);
    }
    const int r = n >> 10, j = n & 1023;
    if (j < 512) return (4 * r + (j >> 7)) * 256 + (j & 127);
    return (4 * r + ((j - 512) >> 7)) * 256 + 128 + ((j - 512) & 127);
}
__global__ __launch_bounds__(256) void k_prep_w(const float* __restrict__ src, int Nsrc, int K, bf16_t* __restrict__ dst, int Ndst, const float* __restrict__ gain, int gmod, int mode) {
    const size_t total = (size_t)K * Ndst;
    for (size_t i = (size_t)blockIdx.x * 256 + threadIdx.x; i < total; i += (size_t)gridDim.x * 256) {
        const int k = (int)(i / Ndst), n = (int)(i % Ndst), c = map_col(mode, n);
        float v = c < 0 ? 0.f : src[(size_t)k * Nsrc + c];
        if (gain) v *= gain[k % gmod];
        dst[(size_t)n * K + k] = f2bf(v);
    }
}
__global__ __launch_bounds__(256) void k_prep_ws(const float* __restrict__ wq, const float* __restrict__ keys, bf16_t* __restrict__ WsT) {
    const size_t total = (size_t)2048 * D;
    for (size_t i = (size_t)blockIdx.x * 256 + threadIdx.x; i < total; i += (size_t)gridDim.x * 256) {
        const int n = (int)(i / D), k = (int)(i % D), hp = n >> 7, nn = n & 127;
        const float* a = wq + (size_t)k * 2048 + hp * 128; const float* b = keys + ((size_t)(hp & 1) * 128 + nn) * 128;
        float s = 0.f;
        for (int d = 0; d < 128; ++d) s += a[d] * b[d];
        WsT[(size_t)n * D + k] = f2bf(s);
    }
}
__global__ __launch_bounds__(256) void k_prep_rope(float* __restrict__ RT) {
    const int i = blockIdx.x * 256 + threadIdx.x;
    if (i < 2064 * RH) { const int pos = i / RH, f = i % RH; const float inv = powf(10000.f, -(float)f / (float)RH); const float ang = (float)pos * inv; RT[2 * i] = cosf(ang); RT[2 * i + 1] = sinf(ang); }
}

template <class Epi>
__global__ __launch_bounds__(256) void k_gemm(const bf16_t* __restrict__ A, int lda, const bf16_t* __restrict__ Bt, int ldb, int K, Epi E) {
    __shared__ float As[32][132];
    __shared__ float Bs[32][132];
    const int tid = threadIdx.x, ty = tid >> 4, tx = tid & 15;
    const int row0 = blockIdx.y * 128, col0 = blockIdx.x * 128;
    float acc[8][8];
#pragma unroll
    for (int i = 0; i < 8; ++i)
#pragma unroll
        for (int j = 0; j < 8; ++j) acc[i][j] = 0.f;
    const int lr = tid >> 1, lk = (tid & 1) * 16;
    for (int k0 = 0; k0 < K; k0 += 32) {
        const u32x4 a0 = *(const u32x4*)(A + (size_t)(row0 + lr) * lda + k0 + lk), a1 = *(const u32x4*)(A + (size_t)(row0 + lr) * lda + k0 + lk + 8);
        const u32x4 b0 = *(const u32x4*)(Bt + (size_t)(col0 + lr) * ldb + k0 + lk), b1 = *(const u32x4*)(Bt + (size_t)(col0 + lr) * ldb + k0 + lk + 8);
        float fa[16], fb[16]; unpack8(a0, fa); unpack8(a1, fa + 8); unpack8(b0, fb); unpack8(b1, fb + 8);
        __syncthreads();
#pragma unroll
        for (int i = 0; i < 16; ++i) { As[lk + i][lr] = fa[i]; Bs[lk + i][lr] = fb[i]; }
        __syncthreads();
#pragma unroll 8
        for (int k = 0; k < 32; ++k) {
            const f32x4 x0 = *(const f32x4*)&As[k][8 * ty], x1 = *(const f32x4*)&As[k][8 * ty + 4];
            const f32x4 y0 = *(const f32x4*)&Bs[k][8 * tx], y1 = *(const f32x4*)&Bs[k][8 * tx + 4];
            const float a[8] = {x0.x, x0.y, x0.z, x0.w, x1.x, x1.y, x1.z, x1.w}, b[8] = {y0.x, y0.y, y0.z, y0.w, y1.x, y1.y, y1.z, y1.w};
#pragma unroll
            for (int i = 0; i < 8; ++i)
#pragma unroll
                for (int j = 0; j < 8; ++j) acc[i][j] = fmaf(a[i], b[j], acc[i][j]);
        }
    }
#pragma unroll
    for (int i = 0; i < 8; ++i) E(row0 + 8 * ty + i, col0 + 8 * tx, acc[i]);
}

struct EpiProjNat {
    const float* R1; bf16_t *P0, *GQ, *GK, *GG, *GA, *GB;
    __device__ __forceinline__ void operator()(int row, int col, const float* v) const {
        const float s = R1[row]; float o[8];
#pragma unroll
        for (int i = 0; i < 8; ++i) o[i] = v[i] * s;
        bf16_t* dst;
        if (col < 768) dst = P0 + (size_t)row * P0W + col;
        else if (col < 1280) dst = GQ + (size_t)row * GDK + (col - 768);
        else if (col < 1792) dst = GK + (size_t)row * GDK + (col - 1280);
        else { if (row >= M) return;
            if (col < 2816) dst = GG + (size_t)row * D + (col - 1792);
            else if (col < 3840) dst = GA + (size_t)row * D + (col - 2816);
            else dst = GB + (size_t)row * D + (col - 3840); }
        *(u32x4*)dst = pack8(o);
    }
};
struct EpiProjTr {
    const float* R1; bf16_t *GKT, *GVT;
    __device__ __forceinline__ void operator()(int row, int col, const float* v) const {
        float o[8];
#pragma unroll
        for (int i = 0; i < 8; ++i) o[i] = v[i] * R1[col + i];
        bf16_t* dst = row < 512 ? GKT + (size_t)row * ME + col : GVT + (size_t)(row - 512) * ME + col;
        *(u32x4*)dst = pack8(o);
    }
};
struct EpiUq {
    const float* RQ; bf16_t* QC;
    __device__ __forceinline__ void operator()(int row, int col, const float* v) const {
        if (row >= M) return;
        const float s = RQ[row]; float o[8];
#pragma unroll
        for (int i = 0; i < 8; ++i) o[i] = v[i] * s;
        *(u32x4*)(QC + (size_t)row * 768 + col) = pack8(o);
    }
};
struct EpiUkv {
    const float* RKV; bf16_t *KN, *V; int roff = 0, pad = 0;
    __device__ __forceinline__ void operator()(int row, int col, const float* v) const {
        row += roff; const float s = RKV[row]; float o[8];
#pragma unroll
        for (int i = 0; i < 8; ++i) o[i] = v[i] * s;
        bf16_t* dst = col < 512 ? KN + (size_t)row * 512 + col : V + (size_t)row * 512 + (col - 512);
        *(u32x4*)dst = pack8(o);
    }
};
struct EpiMix1 { const bf16_t* GA; bf16_t* MIX;
    __device__ __forceinline__ void operator()(int row, int col, const float* v) const {
        float g[8], o[8]; unpack8(*(const u32x4*)(GA + (size_t)row * D + col), g);
#pragma unroll
        for (int i = 0; i < 8; ++i) o[i] = v[i] * sigmoidf_(g[i]);
        *(u32x4*)(MIX + (size_t)row * D + col) = pack8(o);
    }
};
struct EpiMix2 { const bf16_t* GB; bf16_t* MIX;
    __device__ __forceinline__ void operator()(int row, int col, const float* v) const {
        float g[8], o[8], p[8]; unpack8(*(const u32x4*)(GB + (size_t)row * D + col), g); unpack8(*(const u32x4*)(MIX + (size_t)row * D + col), p);
#pragma unroll
        for (int i = 0; i < 8; ++i) o[i] = p[i] + v[i] * sigmoidf_(g[i]);
        *(u32x4*)(MIX + (size_t)row * D + col) = pack8(o);
    }
};
struct EpiOut { const float* x; float* out;
    __device__ __forceinline__ void operator()(int row, int col, const float* v) const {
        const f32x4 a = *(const f32x4*)(x + (size_t)row * D + col), b = *(const f32x4*)(x + (size_t)row * D + col + 4);
        *(f32x4*)(out + (size_t)row * D + col) = (f32x4){a.x + v[0], a.y + v[1], a.z + v[2], a.w + v[3]};
        *(f32x4*)(out + (size_t)row * D + col + 4) = (f32x4){b.x + v[4], b.y + v[5], b.z + v[6], b.w + v[7]};
    }
};
struct EpiScore { float* S;
    __device__ __forceinline__ void operator()(int row, int col, const float* v) const {
        *(f32x4*)(S + (size_t)row * 2048 + col) = (f32x4){v[0], v[1], v[2], v[3]};
        *(f32x4*)(S + (size_t)row * 2048 + col + 4) = (f32x4){v[4], v[5], v[6], v[7]};
    }
};

__global__ __launch_bounds__(256) void k_p0stats(const bf16_t* __restrict__ P0, const float* __restrict__ kn_pe, const float* __restrict__ RT, float* __restrict__ RQ, float* __restrict__ RKV, bf16_t* __restrict__ KPE) {
    const int lane = threadIdx.x & 63, gw = (blockIdx.x * 256 + threadIdx.x) >> 6, nw = gridDim.x * 4;
    for (int r = gw; r < ME; r += nw) {
        const bf16_t* p = P0 + (size_t)r * P0W;
        float sq = 0.f, skv = 0.f;
#pragma unroll
        for (int j = 0; j < 6; ++j) { const float v = bf2f(p[lane + 64 * j]); sq += v * v; }
#pragma unroll
        for (int j = 0; j < 4; ++j) { const float v = bf2f(p[384 + lane + 64 * j]); skv += v * v; }
        const float kp = bf2f(p[640 + lane]);
        sq = wsum(sq); skv = wsum(skv); const float sk = wsum(kp * kp);
        if (lane == 0) { RQ[r] = rsqrtf(sq * (1.f / QR) + EPS); RKV[r] = rsqrtf(skv * (1.f / KVR) + EPS); }
        const float y = kp * rsqrtf(sk * (1.f / ROPE) + EPS) * kn_pe[lane];
        const float yo = __shfl_xor(y, 32);
        const int pos = tok_pos(r) < 2064 ? tok_pos(r) : 0, f = lane & 31;
        const float c = RT[(pos * RH + f) * 2], s = RT[(pos * RH + f) * 2 + 1];
        const float o = lane < 32 ? y * c - yo * s : y * c + yo * s;
        KPE[(size_t)r * ROPE + lane] = f2bf(o);
    }
}
__global__ __launch_bounds__(256) void k_qknorm(bf16_t* __restrict__ QC, bf16_t* __restrict__ KN, const float* __restrict__ qn_nope, const float* __restrict__ qn_pe, const float* __restrict__ kn_nope, const float* __restrict__ RT) {
    const int lane = threadIdx.x & 63, gw = (blockIdx.x * 256 + threadIdx.x) >> 6, nw = gridDim.x * 4;
    for (int it = gw; it < M * 4; it += nw) {
        const int row = it >> 2, hh = it & 3; bf16_t* p = QC + (size_t)row * 768 + hh * QKD;
        const float a = bf2f(p[lane]), b = bf2f(p[lane + 64]), e = bf2f(p[128 + lane]);
        const float rn = rsqrtf(wsum(a * a + b * b) * (1.f / NOPE) + EPS), rp = rsqrtf(wsum(e * e) * (1.f / ROPE) + EPS);
        p[lane] = f2bf(a * rn * qn_nope[lane] * SCL2); p[lane + 64] = f2bf(b * rn * qn_nope[lane + 64] * SCL2);
        const float y = e * rp * qn_pe[lane], yo = __shfl_xor(y, 32);
        const int pos = tok_pos(row), f = lane & 31; const float c = RT[(pos * RH + f) * 2], s = RT[(pos * RH + f) * 2 + 1];
        p[128 + lane] = f2bf((lane < 32 ? y * c - yo * s : y * c + yo * s) * SCL2);
    }
    for (int it = gw; it < ME * 4; it += nw) {
        const int row = it >> 2, hh = it & 3; bf16_t* p = KN + (size_t)row * 512 + hh * NOPE;
        const float a = bf2f(p[lane]), b = bf2f(p[lane + 64]);
        const float rn = rsqrtf(wsum(a * a + b * b) * (1.f / NOPE) + EPS);
        p[lane] = f2bf(a * rn * kn_nope[lane]); p[lane + 64] = f2bf(b * rn * kn_nope[lane + 64]);
    }
}
__global__ __launch_bounds__(256) void k_attn(const bf16_t* __restrict__ QC, const bf16_t* __restrict__ KN, const bf16_t* __restrict__ KPE, const bf16_t* __restrict__ V, bf16_t* __restrict__ YA, int round) {
    __shared__ float qs[4][QKD];
    const int lane = threadIdx.x & 63, wv = threadIdx.x >> 6, gw = (blockIdx.x * 256 + threadIdx.x) >> 6, nw = gridDim.x * 4;
    for (int it = gw; it < M * 4; it += nw) {
        const int m = it >> 2, hh = it & 3, b = m >> 11, t = m & (SEQ - 1), c = t >> 6;
        const bf16_t* q = QC + (size_t)m * 768 + hh * QKD;
        qs[wv][lane] = bf2f(q[lane]); qs[wv][lane + 64] = bf2f(q[lane + 64]); qs[wv][lane + 128] = bf2f(q[lane + 128]);
        float mrun = -1e30f, l = 0.f, o0 = 0.f, o1 = 0.f;
        for (int kb = -1; kb <= c; ++kb) {
            const int kbase = kb < 0 ? M : b * SEQ + 64 * kb, krow = kbase + lane;
            const bool valid = kb >= 0 || lane < NMETA;
            float s = 0.f;
            const bf16_t* kr = KN + (size_t)krow * 512 + hh * NOPE; const bf16_t* kp = KPE + (size_t)krow * ROPE;
#pragma unroll 4
            for (int d = 0; d < NOPE; d += 8) { float f[8]; unpack8(*(const u32x4*)(kr + d), f);
#pragma unroll
                for (int i = 0; i < 8; ++i) s += qs[wv][d + i] * f[i]; }
#pragma unroll 4
            for (int d = 0; d < ROPE; d += 8) { float f[8]; unpack8(*(const u32x4*)(kp + d), f);
#pragma unroll
                for (int i = 0; i < 8; ++i) s += qs[wv][NOPE + d + i] * f[i]; }
            if (!valid) s = -INFINITY;
            const float bm = wmax(s), mn = fmaxf(mrun, bm), alpha = exp2f(mrun - mn), p = valid ? exp2f(s - mn) : 0.f;
            l = l * alpha + wsum(p); o0 *= alpha; o1 *= alpha; mrun = mn;
            const int nk = kb < 0 ? NMETA : 64;
            for (int j = 0; j < nk; ++j) { const float pj = __shfl(p, j); const bf16_t* vr = V + (size_t)(kbase + j) * 512 + hh * 128;
                o0 += pj * bf2f(vr[lane]); o1 += pj * bf2f(vr[lane + 64]); }
        }
        const float il = 1.f / l;
        bf16_t* y = YA + (size_t)m * D + (round * 4 + hh) * 128;
        y[lane] = f2bf(o0 * il); y[lane + 64] = f2bf(o1 * il);
    }
}

__global__ __launch_bounds__(256) void k_gla_dec(const bf16_t* __restrict__ P0, const float* __restrict__ w_a2, const float* __restrict__ b_a, float* __restrict__ DEC) {
    const size_t total = (size_t)ME * GDK;
    for (size_t i = (size_t)blockIdx.x * 256 + threadIdx.x; i < total; i += (size_t)gridDim.x * 256) {
        const int row = (int)(i / GDK), c = (int)(i % GDK);
        float x = b_a[c];
#pragma unroll
        for (int r = 0; r < GR; ++r) x += bf2f(P0[(size_t)row * P0W + 704 + r]) * w_a2[r * GDK + c];
        const float ls = fminf(x, 0.f) - log1pf(__expf(-fabsf(x)));
        DEC[i] = __expf(ls * (1.f / 16.f));
    }
}
__global__ __launch_bounds__(256) void k_gla_naive(const bf16_t* __restrict__ GQ, const bf16_t* __restrict__ GK, const bf16_t* __restrict__ GVT, const float* __restrict__ DEC, bf16_t* __restrict__ OG) {
    const int b = blockIdx.x >> 2, h = blockIdx.x & 3, e = threadIdx.x;
    float S[GHK];
#pragma unroll
    for (int d = 0; d < GHK; ++d) S[d] = 0.f;
    const bf16_t* vt = GVT + (size_t)(h * GHV + e) * ME;
    for (int tk = 0; tk < NMETA + SEQ; ++tk) {
        const int row = tk < NMETA ? M + tk : b * SEQ + (tk - NMETA);
        const float v = bf2f(vt[row]);
        const bf16_t* qp = GQ + (size_t)row * GDK + h * GHK; const bf16_t* kp = GK + (size_t)row * GDK + h * GHK; const float* ap = DEC + (size_t)row * GDK + h * GHK;
        float o = 0.f;
#pragma unroll
        for (int d = 0; d < GHK; ++d) { S[d] = ap[d] * S[d] + bf2f(kp[d]) * v; o += bf2f(qp[d]) * S[d]; }
        if (tk >= NMETA) OG[(size_t)row * D + h * GHV + e] = f2bf(o * GLA_QS);
    }
}
__global__ __launch_bounds__(256) void k_gla_post(bf16_t* __restrict__ OG, const bf16_t* __restrict__ GG) {
    const int lane = threadIdx.x & 63, gw = (blockIdx.x * 256 + threadIdx.x) >> 6, nw = gridDim.x * 4;
    for (int it = gw; it < M * 4; it += nw) {
        const size_t off = (size_t)(it >> 2) * D + (it & 3) * GHV + 4 * lane;
        const unsigned long long w = *(const unsigned long long*)(OG + off), g = *(const unsigned long long*)(GG + off);
        float o[4], gg[4];
#pragma unroll
        for (int i = 0; i < 4; ++i) { o[i] = bf2f((bf16_t)(w >> (16 * i))); gg[i] = bf2f((bf16_t)(g >> (16 * i))); }
        const float rn = rsqrtf(wsum(o[0] * o[0] + o[1] * o[1] + o[2] * o[2] + o[3] * o[3]) * (1.f / GHV) + EPS);
#pragma unroll
        for (int i = 0; i < 4; ++i) o[i] = o[i] * rn * gg[i] * sigmoidf_(gg[i]);
        *(unsigned long long*)(OG + off) = (unsigned long long)pk2(o[0], o[1]) | ((unsigned long long)pk2(o[2], o[3]) << 32);
    }
}

__global__ __launch_bounds__(256) void k_rms2(const float* __restrict__ H2, const float* __restrict__ g, bf16_t* __restrict__ HN) {
    const int lane = threadIdx.x & 63, gw = (blockIdx.x * 256 + threadIdx.x) >> 6, nw = gridDim.x * 4;
    for (int r = gw; r < M; r += nw) {
        f32x4 v[4]; float ss = 0.f;
#pragma unroll
        for (int j = 0; j < 4; ++j) { v[j] = *(const f32x4*)(H2 + (size_t)r * D + 256 * j + 4 * lane); ss += v[j].x * v[j].x + v[j].y * v[j].y + v[j].z * v[j].z + v[j].w * v[j].w; }
        const float rn = rsqrtf(wsum(ss) * (1.f / D) + EPS);
#pragma unroll
        for (int j = 0; j < 4; ++j) { const f32x4 gg = *(const f32x4*)(g + 256 * j + 4 * lane);
            *(unsigned long long*)(HN + (size_t)r * D + 256 * j + 4 * lane) = (unsigned long long)pk2(v[j].x * rn * gg.x, v[j].y * rn * gg.y) | ((unsigned long long)pk2(v[j].z * rn * gg.z, v[j].w * rn * gg.w) << 32); }
    }
}
__global__ __launch_bounds__(64) void k_topk(const float* __restrict__ S, int* __restrict__ IDX, float* __restrict__ GATE) {
    __shared__ float tv[64][33];
    __shared__ int ti[64][33];
    const int tid = threadIdx.x; const int it = blockIdx.x * 64 + tid;
    const float* s = S + (size_t)it * 256;
    for (int p = 0; p < 2; ++p) {
        float pv = INFINITY; int pi = -1;
        for (int k = 0; k < 16; ++k) {
            float bv = -INFINITY; int bi = 1 << 30;
            for (int n = 0; n < 128; ++n) { const float x = s[p * 128 + n];
                const bool after = x < pv || (x == pv && n > pi);
                if (after && (x > bv || (x == bv && n < bi))) { bv = x; bi = n; } }
            tv[tid][p * 16 + k] = bv; ti[tid][p * 16 + k] = bi; pv = bv; pi = bi;
        }
    }
    float pv = INFINITY; int pi = -1; float bs[16]; float mx = 0.f;
#pragma unroll
    for (int k = 0; k < 16; ++k) {
        float bv = -INFINITY; int bi = 1 << 30;
        for (int c = 0; c < 256; ++c) { const float x = tv[tid][c >> 4] + tv[tid][16 + (c & 15)];
            const bool after = x < pv || (x == pv && c > pi);
            if (after && (x > bv || (x == bv && c < bi))) { bv = x; bi = c; } }
        bs[k] = bv; pv = bv; pi = bi; if (k == 0) mx = bv;
        IDX[(size_t)it * 16 + k] = ti[tid][bi >> 4] * 128 + ti[tid][16 + (bi & 15)];
    }
    float sum = 0.f;
#pragma unroll
    for (int k = 0; k < 16; ++k) { bs[k] = __expf(bs[k] - mx); sum += bs[k]; }
    const float inv = 1.f / sum;
#pragma unroll
    for (int k = 0; k < 16; ++k) GATE[(size_t)it * 16 + k] = bs[k] * inv;
}
__global__ __launch_bounds__(256) void k_conv(const float* __restrict__ a, bf16_t* __restrict__ ao, size_t n8) {
    for (size_t i = (size_t)blockIdx.x * 256 + threadIdx.x; i < n8; i += (size_t)gridDim.x * 256) {
        const f32x4 x = *(const f32x4*)(a + i * 8), y = *(const f32x4*)(a + i * 8 + 4);
        u32x4 w; w.x = pk2(x.x, x.y); w.y = pk2(x.z, x.w); w.z = pk2(y.x, y.y); w.w = pk2(y.z, y.w);
        *(u32x4*)(ao + i * 8) = w;
    }
}
__global__ __launch_bounds__(256) void k_peer(const bf16_t* __restrict__ HN, const int* __restrict__ IDX, const float* __restrict__ GATE, const bf16_t* __restrict__ UB, const bf16_t* __restrict__ VB, float* __restrict__ out) {
    const int lane = threadIdx.x & 63, gw = (blockIdx.x * 256 + threadIdx.x) >> 6, nw = gridDim.x * 4;
    for (int m = gw; m < M; m += nw) {
        float hn[16], acc[16];
        unpack8(*(const u32x4*)(HN + (size_t)m * D + 8 * lane), hn); unpack8(*(const u32x4*)(HN + (size_t)m * D + 512 + 8 * lane), hn + 8);
#pragma unroll
        for (int i = 0; i < 16; ++i) acc[i] = 0.f;
        for (int e = 0; e < 128; ++e) {
            const int idx = IDX[(size_t)m * 128 + e]; const float g = GATE[(size_t)m * 128 + e];
            float u[16]; unpack8(*(const u32x4*)(UB + (size_t)idx * D + 8 * lane), u); unpack8(*(const u32x4*)(UB + (size_t)idx * D + 512 + 8 * lane), u + 8);
            float d = 0.f;
#pragma unroll
            for (int i = 0; i < 16; ++i) d += hn[i] * u[i];
            d = wsum(d);
            const float a = 0.5f * d * (1.f + erff(d * 0.70710678118654752f)) * g;
            float v[16]; unpack8(*(const u32x4*)(VB + (size_t)idx * D + 8 * lane), v); unpack8(*(const u32x4*)(VB + (size_t)idx * D + 512 + 8 * lane), v + 8);
#pragma unroll
            for (int i = 0; i < 16; ++i) acc[i] += a * v[i];
        }
        float* o = out + (size_t)m * D;
        f32x4 a0 = *(f32x4*)(o + 8 * lane), a1 = *(f32x4*)(o + 8 * lane + 4), b0 = *(f32x4*)(o + 512 + 8 * lane), b1 = *(f32x4*)(o + 512 + 8 * lane + 4);
        a0 += (f32x4){acc[0], acc[1], acc[2], acc[3]}; a1 += (f32x4){acc[4], acc[5], acc[6], acc[7]};
        b0 += (f32x4){acc[8], acc[9], acc[10], acc[11]}; b1 += (f32x4){acc[12], acc[13], acc[14], acc[15]};
        *(f32x4*)(o + 8 * lane) = a0; *(f32x4*)(o + 8 * lane + 4) = a1; *(f32x4*)(o + 512 + 8 * lane) = b0; *(f32x4*)(o + 512 + 8 * lane + 4) = b1;
    }
}


namespace pg8 {
#define PG8_LAS __attribute__((address_space(3)))
typedef short bf16x8 __attribute__((ext_vector_type(8)));
constexpr int BM = 256, BK = 64, HALF = 128, HTB = HALF * BK * 2, STAGE_BYTES = 8 * HTB, NXCD = 8, WGM = 8;
__host__ __device__ __forceinline__ int lds_byte(int r, int c) { const int st = (r >> 4) * 2 + (c >> 5), rr = r & 15, cc = c & 31, ob = rr * 64 + cc * 2; return st * 1024 + (ob ^ (((ob >> 9) & 1) << 5)); }
__host__ __device__ __forceinline__ void stage_rc(int b, int& R, int& C) { const int st = b / 1024, sb = b % 1024, swz = sb ^ (((sb >> 9) & 1) << 5); R = (st >> 1) * 16 + swz / 64; C = (st & 1) * 32 + (swz % 64) / 2; }
__host__ __device__ __forceinline__ int perm32(int rho) { const int n = rho >> 4, i = rho & 15; return 8 * (i >> 2) + 4 * n + (i & 3); }
struct Unit { const char* A; const char* B; int pm, pn, gid; };
struct Fam { int lda, ldb, K; };
__device__ __forceinline__ void tile_of(int L, int nM, int nN, int& pm, int& pn) {
    const int nwg = nM * nN; int wgid = L; { const int q = nwg / NXCD, r = nwg % NXCD, xcd = wgid % NXCD, off = wgid / NXCD; wgid = (xcd < r ? xcd * (q + 1) : r * (q + 1) + (xcd - r) * q) + off; }
    const int nig = WGM * nN, gid = wgid / nig, fm = gid * WGM, gsz = (nM - fm) < WGM ? (nM - fm) : WGM;
    pm = fm + ((wgid % nig) % gsz); pn = (wgid % nig) / gsz;
}
template <class Epi, class Sched>
__device__ __forceinline__ void gemm_phase(PG8_LAS unsigned char* lds, const Fam f, const Sched& S, const Epi& E) {
    const int tid = threadIdx.x, wid = __builtin_amdgcn_readfirstlane(tid >> 6), lane = tid & 63, wr = wid >> 2, wc = wid & 3, fr = lane & 15, fq = lane >> 4;
    const int nt = f.K / BK;
    unsigned voffA[2], voffB[2];
#pragma unroll
    for (int i = 0; i < 2; ++i) { int R, C; stage_rc(tid * 16 + i * 8192, R, C); const int Rb = (R & ~31) + perm32(R & 31);
        voffA[i] = (unsigned)(R * f.lda + C) * 2u; voffB[i] = (unsigned)(Rb * f.ldb + C) * 2u; }
    const size_t kstep = (size_t)(BK * 2);
    const size_t hstepA = (size_t)HALF * f.lda * 2, hstepB = (size_t)HALF * f.ldb * 2;
    const unsigned ldsw = (unsigned)wid * 1024u;
    const int aoff = lds_byte(wr * 64 + fr, fq * 8), boff = lds_byte(wc * 32 + fr, fq * 8);
#define PG8_SA(b, h) (((b) * 2 + (h)) * HTB)
#define PG8_SB(b, h) ((4 + (b) * 2 + (h)) * HTB)
#define PG8_STAGE(bufoff, gbase, voff) do { _Pragma("unroll") for (int _i = 0; _i < 2; ++_i) \
        __builtin_amdgcn_global_load_lds((const unsigned*)((const char*)(gbase) + (voff)[_i]), (PG8_LAS unsigned*)(lds + (bufoff) + ldsw + _i * 8192), 16, 0, 0); } while (0)
#define PG8_LDA(dst, b, h) do { _Pragma("unroll") for (int m = 0; m < 4; ++m) _Pragma("unroll") for (int k = 0; k < 2; ++k) dst[m][k] = *(const PG8_LAS bf16x8*)(lds + PG8_SA(b, h) + aoff + m * 2048 + k * 1024); } while (0)
#define PG8_LDB(dst, b, h) do { _Pragma("unroll") for (int n = 0; n < 2; ++n) _Pragma("unroll") for (int k = 0; k < 2; ++k) dst[n][k] = *(const PG8_LAS bf16x8*)(lds + PG8_SB(b, h) + boff + n * 2048 + k * 1024); } while (0)
#define PG8_MMA(ai, bj, At, Bt) do { __builtin_amdgcn_s_setprio(1); _Pragma("unroll") for (int m = 0; m < 4; ++m) _Pragma("unroll") for (int n = 0; n < 2; ++n) _Pragma("unroll") for (int k = 0; k < 2; ++k) \
        acc[ai][bj][m][n] = __builtin_amdgcn_mfma_f32_16x16x32_bf16(Bt[n][k], At[m][k], acc[ai][bj][m][n], 0, 0, 0); __builtin_amdgcn_s_setprio(0); } while (0)
#define PG8_WAIT_V(n) asm volatile("s_waitcnt vmcnt(" #n ")" ::: "memory")
#define PG8_WAIT_L(n) asm volatile("s_waitcnt lgkmcnt(" #n ")" ::: "memory")
#define PG8_BAR __builtin_amdgcn_s_barrier()
#define PG8_SCHED __builtin_amdgcn_sched_barrier(0)
    Unit cur, nxt; int ui = 0;
    if (!S.next(0, cur)) return;
    f32x4 acc[2][2][4][2];
#pragma unroll
    for (int a = 0; a < 2; ++a)
#pragma unroll
        for (int b = 0; b < 2; ++b)
#pragma unroll
            for (int m = 0; m < 4; ++m)
#pragma unroll
                for (int n = 0; n < 2; ++n) acc[a][b][m][n] = (f32x4){0.f, 0.f, 0.f, 0.f};
    bf16x8 At[4][2], B0[2][2], B1[2][2];
    const char* cA = cur.A; const char* cB = cur.B;
    PG8_STAGE(PG8_SB(0, 0), cB, voffB); PG8_STAGE(PG8_SB(0, 1), cB + hstepB, voffB); PG8_STAGE(PG8_SA(0, 0), cA, voffA); PG8_STAGE(PG8_SA(0, 1), cA + hstepA, voffA);
    if (wr == 1) PG8_BAR;
    PG8_WAIT_V(2); PG8_BAR;
    PG8_STAGE(PG8_SB(1, 0), cB + kstep, voffB); PG8_STAGE(PG8_SA(1, 0), cA + kstep, voffA); PG8_STAGE(PG8_SB(1, 1), cB + hstepB + kstep, voffB);
    PG8_WAIT_V(6); PG8_BAR;
    for (;;) {
        const bool has_next = S.next(ui + 1, nxt);
        const char* nA = has_next ? nxt.A : cA; const char* nB = has_next ? nxt.B : cB;
        for (int t = 0; t < nt; t += 2) {
            const bool last = (t == nt - 2);
            const char* a1 = cA + (size_t)(t + 1) * kstep;
            const char* a2 = last ? nA : cA + (size_t)(t + 2) * kstep; const char* b2 = last ? nB : cB + (size_t)(t + 2) * kstep;
            const char* a3 = a2 + kstep; const char* b3 = b2 + kstep;
            PG8_LDB(B0, 0, 0); PG8_LDB(B1, 0, 1); PG8_SCHED; PG8_LDA(At, 0, 0); PG8_STAGE(PG8_SA(1, 1), a1 + hstepA, voffA);
            PG8_WAIT_V(8); PG8_WAIT_L(0); PG8_BAR; PG8_MMA(0, 0, At, B0); PG8_MMA(0, 1, At, B1); PG8_BAR; PG8_SCHED;
            PG8_LDA(At, 0, 1); PG8_STAGE(PG8_SB(0, 0), b2, voffB); PG8_STAGE(PG8_SB(0, 1), b2 + hstepB, voffB); PG8_STAGE(PG8_SA(0, 0), a2, voffA);
            PG8_WAIT_V(8); PG8_WAIT_L(0); PG8_BAR; PG8_MMA(1, 0, At, B0); PG8_MMA(1, 1, At, B1); PG8_BAR; PG8_SCHED;
            PG8_LDB(B0, 1, 0); PG8_LDB(B1, 1, 1); PG8_SCHED; PG8_LDA(At, 1, 0); PG8_STAGE(PG8_SA(0, 1), a2 + hstepA, voffA);
            PG8_WAIT_V(8); PG8_WAIT_L(0); PG8_BAR; PG8_MMA(0, 0, At, B0); PG8_MMA(0, 1, At, B1); PG8_BAR; PG8_SCHED;
            PG8_LDA(At, 1, 1); PG8_STAGE(PG8_SB(1, 0), b3, voffB); PG8_STAGE(PG8_SB(1, 1), b3 + hstepB, voffB); PG8_STAGE(PG8_SA(1, 0), a3, voffA);
            PG8_WAIT_V(8); PG8_WAIT_L(0); PG8_BAR; PG8_MMA(1, 0, At, B0); PG8_MMA(1, 1, At, B1); PG8_BAR; PG8_SCHED;
        }
        if (wr == 0) PG8_BAR;
        {
            const int row0 = cur.pm * BM + wr * 64 + fr, col0 = cur.pn * BM + wc * 32 + 8 * fq;
#pragma unroll
            for (int ai = 0; ai < 2; ++ai)
#pragma unroll
                for (int m = 0; m < 4; ++m)
#pragma unroll
                    for (int bj = 0; bj < 2; ++bj) {
                        const f32x4 v0 = acc[ai][bj][m][0], v1 = acc[ai][bj][m][1];
                        float v[8] = {v0[0], v0[1], v0[2], v0[3], v1[0], v1[1], v1[2], v1[3]};
                        if constexpr (Epi::XFORM) { if (E.xform(cur.gid, row0 + ai * HALF + m * 16, col0 + bj * HALF, v)) {
                            acc[ai][bj][m][0] = (f32x4){v[0], v[1], v[2], v[3]}; acc[ai][bj][m][1] = (f32x4){v[4], v[5], v[6], v[7]}; } }
                        else E(cur.gid, row0 + ai * HALF + m * 16, col0 + bj * HALF, v);
                    }
        }
        if (!has_next) break;
        bool keep = false; if constexpr (Epi::XFORM) keep = E.keep(cur.gid);
        if (!keep) {
#pragma unroll
        for (int a = 0; a < 2; ++a)
#pragma unroll
            for (int b = 0; b < 2; ++b)
#pragma unroll
                for (int m = 0; m < 4; ++m)
#pragma unroll
                    for (int n = 0; n < 2; ++n) acc[a][b][m][n] = (f32x4){0.f, 0.f, 0.f, 0.f};
        }
        cur = nxt; cA = nA; cB = nB; ++ui;
        if (wr == 1) PG8_BAR;
    }
    PG8_WAIT_V(0);
    PG8_BAR;
#undef PG8_SA
#undef PG8_SB
#undef PG8_STAGE
#undef PG8_LDA
#undef PG8_LDB
#undef PG8_MMA
#undef PG8_WAIT_V
#undef PG8_WAIT_L
#undef PG8_BAR
#undef PG8_SCHED
}
}


namespace att {
typedef short bf16x8 __attribute__((ext_vector_type(8)));
typedef short s16x4 __attribute__((ext_vector_type(4)));
typedef float f32x16 __attribute__((ext_vector_type(16)));
typedef PG8_LAS const char* lptr;
constexpr int KROWB = 384, SHM_K = 64 * KROWB, SHM_V = 64 * 256;
constexpr int L_K = 0, L_V = 2 * SHM_K, L_WS = L_V + 2 * SHM_V, L_END = L_WS + 8 * 256;
constexpr float THRL = 11.5f;
__device__ __forceinline__ int crow(int r, int hi) { return (r & 3) + 8 * (r >> 2) + 4 * hi; }
__device__ __forceinline__ unsigned cvtpk(float lo, float hi) { unsigned r; asm volatile("v_cvt_pk_bf16_f32 %0, %1, %2" : "=v"(r) : "v"(lo), "v"(hi)); return r; }
__device__ __forceinline__ int v_rd_base(int lane) { return ((lane & 3) << 3) | (((lane >> 2) & 3) << 6) | (((lane >> 4) & 1) << 5) | (((lane >> 5) & 1) << 8); }
constexpr int v_rd_off(int d0, int ks, int half) { return d0 * 512 + ks * 4096 + half * 2048; }
__device__ __forceinline__ void partialSM(f32x16& p0, f32x16& p1, float& m_reg, float& alpha) {
    float pmax = p0[0];
#pragma unroll
    for (int r = 1; r < 16; ++r) pmax = fmaxf(pmax, p0[r]);
#pragma unroll
    for (int r = 0; r < 16; ++r) pmax = fmaxf(pmax, p1[r]);
    { auto rr = __builtin_amdgcn_permlane32_swap(__float_as_uint(pmax), __float_as_uint(pmax), false, false); pmax = fmaxf(__uint_as_float(rr[0]), __uint_as_float(rr[1])); }
    float mn;
    if (__builtin_expect(__all(pmax - m_reg <= THRL), 1)) { mn = m_reg; alpha = 1.f; }
    else { mn = fmaxf(m_reg, pmax); alpha = __builtin_amdgcn_exp2f(m_reg - mn); m_reg = mn; }
#pragma unroll
    for (int r = 0; r < 16; ++r) { p0[r] = __builtin_amdgcn_exp2f(p0[r] - mn); p1[r] = __builtin_amdgcn_exp2f(p1[r] - mn); }
}
__device__ __forceinline__ void finishSM(const f32x16& p0, const f32x16& p1, float alpha, float& l_reg, bf16x8& pa0, bf16x8& pa1, bf16x8& pa2, bf16x8& pa3) {
    float ps = 0.f;
#pragma unroll
    for (int r = 0; r < 16; ++r) ps += p0[r] + p1[r];
    { auto rr = __builtin_amdgcn_permlane32_swap(__float_as_uint(ps), __float_as_uint(ps), false, false); ps = __uint_as_float(rr[0]) + __uint_as_float(rr[1]); }
    l_reg = l_reg * alpha + ps;
#define PK4(P, B_, OUT) do { unsigned a0 = cvtpk(P[B_+0], P[B_+1]), a1 = cvtpk(P[B_+2], P[B_+3]); unsigned b0 = cvtpk(P[B_+4], P[B_+5]), b1 = cvtpk(P[B_+6], P[B_+7]); \
        auto r0 = __builtin_amdgcn_permlane32_swap(a0, b0, false, false); auto r1 = __builtin_amdgcn_permlane32_swap(a1, b1, false, false); \
        u32x4 w = {r0[0], r1[0], r0[1], r1[1]}; OUT = __builtin_bit_cast(bf16x8, w); } while (0)
    PK4(p0, 0, pa0); PK4(p0, 8, pa1); PK4(p1, 0, pa2); PK4(p1, 8, pa3);
#undef PK4
}
template <int KB>
__device__ __forceinline__ void qkt(f32x16& p0, f32x16& p1, lptr K_lds, int r32, int hi, const bf16x8* qr) {
    p0 = f32x16{}; p1 = f32x16{};
    lptr kb[4];
#pragma unroll
    for (int dd = 0; dd < 4; ++dd) kb[dd] = K_lds + KB * SHM_K + r32 * KROWB + (((dd * 16 + hi * 8) * 2) ^ ((r32 & 7) << 4));
#pragma unroll
    for (int d0 = 0; d0 < 12; ++d0) { lptr a = kb[d0 & 3] + (d0 >> 2) * 128;
        const bf16x8 b0 = *(const PG8_LAS bf16x8*)a, b1 = *(const PG8_LAS bf16x8*)(a + 32 * KROWB);
        p0 = __builtin_amdgcn_mfma_f32_32x32x16_bf16(b0, qr[d0], p0, 0, 0, 0);
        p1 = __builtin_amdgcn_mfma_f32_32x32x16_bf16(b1, qr[d0], p1, 0, 0, 0); }
}
template <int VB>
__device__ __forceinline__ void pv_tile(f32x16* o, int vb0, bf16x8 pa0, bf16x8 pa1, bf16x8 pa2, bf16x8 pa3) {
#define TRRD(dst, off) asm volatile("ds_read_b64_tr_b16 %0, %1 offset:%2" : "=&v"(dst) : "v"(vb0), "i"(off) : "memory")
#define PV_D0(d0) do { s16x4 l0, l1, l2, l3, h0, h1, h2, h3; constexpr int b_ = VB * SHM_V + v_rd_off(d0, 0, 0); \
        TRRD(l0, b_); TRRD(h0, b_ + 2048); TRRD(l1, b_ + 4096); TRRD(h1, b_ + 6144); TRRD(l2, b_ + 8192); TRRD(h2, b_ + 10240); TRRD(l3, b_ + 12288); TRRD(h3, b_ + 14336); \
        asm volatile("s_waitcnt lgkmcnt(0)" ::: "memory"); __builtin_amdgcn_sched_barrier(0); \
        o[d0] = __builtin_amdgcn_mfma_f32_32x32x16_bf16(pa0, (bf16x8){l0[0], l0[1], l0[2], l0[3], h0[0], h0[1], h0[2], h0[3]}, o[d0], 0, 0, 0); \
        o[d0] = __builtin_amdgcn_mfma_f32_32x32x16_bf16(pa1, (bf16x8){l1[0], l1[1], l1[2], l1[3], h1[0], h1[1], h1[2], h1[3]}, o[d0], 0, 0, 0); \
        o[d0] = __builtin_amdgcn_mfma_f32_32x32x16_bf16(pa2, (bf16x8){l2[0], l2[1], l2[2], l2[3], h2[0], h2[1], h2[2], h2[3]}, o[d0], 0, 0, 0); \
        o[d0] = __builtin_amdgcn_mfma_f32_32x32x16_bf16(pa3, (bf16x8){l3[0], l3[1], l3[2], l3[3], h3[0], h3[1], h3[2], h3[3]}, o[d0], 0, 0, 0); } while (0)
    PV_D0(0); PV_D0(1); PV_D0(2); PV_D0(3);
#undef PV_D0
#undef TRRD
}
struct Tens { const bf16_t* QC; const bf16_t* KN; const bf16_t* KPE; const bf16_t* V; bf16_t* YA; };
__device__ __forceinline__ void attn_unit(PG8_LAS unsigned char* lds, const Tens& T, int b, int hh, int qb, int round) {
    const int tid = threadIdx.x, wid = __builtin_amdgcn_readfirstlane(tid >> 6), lane = tid & 63, r32 = lane & 31, hi = lane >> 5;
    const int NT = 4 * qb + 5, last_act = 4 * qb + (wid >> 1) + 1;
    unsigned koff[3]; bool kpe[3]; unsigned voff[2];
#pragma unroll
    for (int i = 0; i < 3; ++i) { const int p16 = (i * 8 + wid) * 64 + lane, row = p16 / 24, cp = p16 % 24, c = (cp & ~7) | ((cp & 7) ^ (row & 7));
        kpe[i] = c >= 16; koff[i] = kpe[i] ? (unsigned)(row * ROPE + (c - 16) * 8) * 2u : (unsigned)(row * 512 + hh * NOPE + c * 8) * 2u; }
#pragma unroll
    for (int i = 0; i < 2; ++i) { const int p16 = (i * 8 + wid) * 64 + lane, sub = p16 >> 5, kk = (sub >> 2) * 8 + ((p16 >> 2) & 7), cc = (sub & 3) * 32 + (p16 & 3) * 8;
        const int k = (kk & ~0xC) | ((kk & 4) << 1) | ((kk & 8) >> 1); voff[i] = (unsigned)(k * 512 + hh * 128 + cc) * 2u; }
    const unsigned ldsw = (unsigned)wid * 1024u;
#define ATT_DMA(jt, buf) do { const int kbase_ = (jt) == 0 ? M : b * SEQ + 64 * ((jt) - 1); \
        const char* kn_ = (const char*)(T.KN + (size_t)kbase_ * 512); const char* kp_ = (const char*)(T.KPE + (size_t)kbase_ * ROPE); const char* vv_ = (const char*)(T.V + (size_t)kbase_ * 512); \
        _Pragma("unroll") for (int i_ = 0; i_ < 3; ++i_) __builtin_amdgcn_global_load_lds((const unsigned*)((kpe[i_] ? kp_ : kn_) + koff[i_]), (PG8_LAS unsigned*)(lds + L_K + (buf) * SHM_K + ldsw + i_ * 8192), 16, 0, 0); \
        _Pragma("unroll") for (int i_ = 0; i_ < 2; ++i_) __builtin_amdgcn_global_load_lds((const unsigned*)(vv_ + voff[i_]), (PG8_LAS unsigned*)(lds + L_V + (buf) * SHM_V + ldsw + i_ * 8192), 16, 0, 0); } while (0)
    ATT_DMA(0, 0);
    const bf16_t* Qw = T.QC + (size_t)(b * SEQ + qb * 256 + wid * 32 + r32) * 768 + hh * QKD + hi * 8;
    bf16x8 qr[12];
#pragma unroll
    for (int d0 = 0; d0 < 12; ++d0) qr[d0] = *(const bf16x8*)(Qw + d0 * 16);
    float m_reg = -1e30f, l_reg = 0.f; f32x16 o[4] = {};
    PG8_LAS float* wsf = (PG8_LAS float*)(lds + L_WS) + wid * 64;
    const lptr K_lds = (lptr)(lds + L_K);
    const int vb0 = (int)(uintptr_t)(lds + L_V) + v_rd_base(lane);
    asm volatile("s_waitcnt vmcnt(0)" ::: "memory"); __builtin_amdgcn_s_barrier(); asm volatile("" ::: "memory");
#define ATT_TILE(KB, t) do { if ((t) + 1 < NT) ATT_DMA((t) + 1, 1 - (KB)); \
        if ((t) <= last_act) { f32x16 p0, p1; qkt<KB>(p0, p1, K_lds, r32, hi, qr); \
            if ((t) == 0) { const float NEG = -__builtin_inff(); _Pragma("unroll") for (int r = 0; r < 16; ++r) { if (crow(r, hi) >= NMETA) p0[r] = NEG; p1[r] = NEG; } } \
            float alpha; partialSM(p0, p1, m_reg, alpha); \
            if (__any(alpha < 1.f)) { if (hi == 0) wsf[r32] = alpha; asm volatile("s_waitcnt lgkmcnt(0)" ::: "memory"); \
                _Pragma("unroll") for (int d_ = 0; d_ < 4; ++d_) _Pragma("unroll") for (int r = 0; r < 16; ++r) o[d_][r] *= wsf[crow(r, hi)]; } \
            bf16x8 pa0, pa1, pa2, pa3; finishSM(p0, p1, alpha, l_reg, pa0, pa1, pa2, pa3); __builtin_amdgcn_sched_barrier(0); \
            pv_tile<KB>(o, vb0, pa0, pa1, pa2, pa3); } \
        asm volatile("s_waitcnt vmcnt(0) lgkmcnt(0)" ::: "memory"); __builtin_amdgcn_s_barrier(); asm volatile("" ::: "memory"); } while (0)
    for (int t = 0; t < NT; t += 2) { ATT_TILE(0, t); if (t + 1 < NT) ATT_TILE(1, t + 1); }
#undef ATT_TILE
#undef ATT_DMA
    if (hi == 0) wsf[32 + r32] = l_reg; asm volatile("s_waitcnt lgkmcnt(0)" ::: "memory");
    bf16_t* Ow = T.YA + (size_t)(b * SEQ + qb * 256 + wid * 32) * D + (round * 4 + hh) * 128;
#pragma unroll
    for (int r = 0; r < 16; ++r) { const int orow = crow(r, hi); const float rl = __builtin_amdgcn_rcpf(wsf[32 + orow]);
#pragma unroll
        for (int d0 = 0; d0 < 4; ++d0) { const float v = o[d0][r] * rl, vn = __shfl_xor(v, 1);
            if ((r32 & 1) == 0) *(unsigned*)(Ow + (size_t)orow * D + d0 * 32 + r32) = cvtpk(v, vn); } }
    asm volatile("s_waitcnt lgkmcnt(0)" ::: "memory"); __builtin_amdgcn_s_barrier(); asm volatile("" ::: "memory");
}
__device__ __forceinline__ void attn_phase(PG8_LAS unsigned char* lds, const Tens& T, int round, int G, int c) {
    for (int p = c; p < 256; p += G) {
        const int xcd = p & 7, j = p >> 3, x = j & 3, g = (j >> 2) * 8 + xcd, b = g >> 2, hh = g & 3;
        attn_unit(lds, T, b, hh, 7 - x, round);
        attn_unit(lds, T, b, hh, x, round);
    }
}
}


namespace peer {
typedef _Float16 h2 __attribute__((ext_vector_type(2)));
__device__ __forceinline__ h2 as_h2(unsigned w) { return __builtin_bit_cast(h2, w); }
__device__ __forceinline__ void ins16(float (&t)[16], float x) {
#pragma unroll
    for (int i = 15; i >= 1; --i) t[i] = __builtin_amdgcn_fmed3f(t[i - 1], t[i], x);
    t[0] = fmaxf(t[0], x);
}
constexpr int TK_WAVE_LDS = 8704;
__device__ __forceinline__ void topk_phase(PG8_LAS unsigned char* lds, const float* __restrict__ S, int* __restrict__ IDX, float* __restrict__ GATE, int G, int c) {
    const int lane = threadIdx.x & 63, wid = __builtin_amdgcn_readfirstlane(threadIdx.x >> 6);
    PG8_LAS float* wl = (PG8_LAS float*)(lds + wid * TK_WAVE_LDS);
    for (int grp = c * 8 + wid; grp < M / 8; grp += G * 8) {
        const int m0 = grp * 8;
        float ta[16], tb[16];
#pragma unroll
        for (int p = 0; p < 2; ++p) {
            float t[16];
#pragma unroll
            for (int i = 0; i < 16; ++i) t[i] = -__builtin_inff();
#pragma unroll 1
            for (int q = 0; q < 4; ++q) {
                f32x4 st[8];
#pragma unroll
                for (int j = 0; j < 8; ++j) { const int list = j * 8 + (lane >> 3);
                    st[j] = *(const f32x4*)(S + (size_t)(m0 + (list >> 3)) * 2048 + (list & 7) * 256 + p * 128 + q * 32 + (lane & 7) * 4); }
#pragma unroll
                for (int j = 0; j < 8; ++j) *(PG8_LAS f32x4*)(wl + (j * 8 + (lane >> 3)) * 32 + (lane & 7) * 4) = st[j];
                asm volatile("s_waitcnt lgkmcnt(0)" ::: "memory");
#pragma unroll 8
                for (int i = 0; i < 32; ++i) { const int e = (i + lane) & 31; const float x = wl[lane * 32 + e];
                    ins16(t, __uint_as_float((__float_as_uint(x) & ~127u) | (unsigned)(q * 32 + e))); }
                asm volatile("s_waitcnt lgkmcnt(0)" ::: "memory");
            }
#pragma unroll
            for (int i = 0; i < 16; ++i) { if (p == 0) ta[i] = t[i]; else tb[i] = t[i]; }
        }
        PG8_LAS int* wi = (PG8_LAS int*)wl + lane * 33;
#pragma unroll
        for (int i = 0; i < 16; ++i) { wi[i] = (int)(__float_as_uint(ta[i]) & 127u); wi[16 + i] = (int)(__float_as_uint(tb[i]) & 127u);
            ta[i] = __uint_as_float(__float_as_uint(ta[i]) & ~127u); tb[i] = __uint_as_float(__float_as_uint(tb[i]) & ~127u); }
        float tc[16];
#pragma unroll
        for (int i = 0; i < 16; ++i) tc[i] = -__builtin_inff();
#pragma unroll
        for (int i = 0; i < 16; ++i)
#pragma unroll
            for (int j = 0; j < 16; ++j) if ((i + 1) * (j + 1) <= 16) ins16(tc, __uint_as_float((__float_as_uint(ta[i] + tb[j]) & ~255u) | (unsigned)(i * 16 + j)));
        asm volatile("s_waitcnt lgkmcnt(0)" ::: "memory");
        float g[16]; int id[16]; float sum = 0.f;
        const float mx = __uint_as_float(__float_as_uint(tc[0]) & ~255u);
#pragma unroll
        for (int k = 0; k < 16; ++k) { const unsigned key = __float_as_uint(tc[k]); const int pos = (int)(key & 255u);
            id[k] = wi[pos >> 4] * 128 + wi[16 + (pos & 15)]; g[k] = __expf(__uint_as_float(key & ~255u) - mx); sum += g[k]; }
        const float inv = 1.f / sum;
        const size_t o = ((size_t)(m0 + (lane >> 3)) * 8 + (lane & 7)) * 16;
#pragma unroll
        for (int k = 0; k < 16; k += 4) { *(f32x4*)(GATE + o + k) = (f32x4){g[k] * inv, g[k + 1] * inv, g[k + 2] * inv, g[k + 3] * inv};
            *(u32x4*)(IDX + o + k) = (u32x4){(unsigned)id[k], (unsigned)id[k + 1], (unsigned)id[k + 2], (unsigned)id[k + 3]}; }
        asm volatile("s_waitcnt lgkmcnt(0)" ::: "memory");
    }
}
__device__ __forceinline__ void gather_phase(const bf16_t* __restrict__ HN, const int* __restrict__ IDX, const float* __restrict__ GATE, const _Float16* __restrict__ UH, const _Float16* __restrict__ VH, float* out, int G, int c) {
    const int lane = threadIdx.x & 63, wid = __builtin_amdgcn_readfirstlane(threadIdx.x >> 6);
    for (int m = c * 8 + wid; m < M; m += G * 8) {
        const u32x4 x0 = *(const u32x4*)(HN + (size_t)m * D + 8 * lane), x1 = *(const u32x4*)(HN + (size_t)m * D + 512 + 8 * lane);
        h2 hp[8];
#pragma unroll
        for (int i = 0; i < 4; ++i) { hp[i] = (h2){(_Float16)__uint_as_float(x0[i] << 16), (_Float16)__uint_as_float(x0[i] & 0xffff0000u)};
            hp[4 + i] = (h2){(_Float16)__uint_as_float(x1[i] << 16), (_Float16)__uint_as_float(x1[i] & 0xffff0000u)}; }
        float acc[16];
#pragma unroll
        for (int i = 0; i < 16; ++i) acc[i] = 0.f;
        const int* ip = IDX + (size_t)m * 128; const float* gp = GATE + (size_t)m * 128;
        u32x4 ub[4][2], vb[4][2];
#define LOAD_ROWS(dst, TAB, k) do { _Pragma("unroll") for (int j = 0; j < 4; ++j) { const _Float16* r_ = TAB + (size_t)ip[(k) * 4 + j] * D; \
            dst[j][0] = *(const u32x4*)(r_ + 8 * lane); dst[j][1] = *(const u32x4*)(r_ + 512 + 8 * lane); } } while (0)
        LOAD_ROWS(ub, UH, 0);
#pragma unroll 1
        for (int k = 0; k < 32; ++k) {
            LOAD_ROWS(vb, VH, k);
            float d[4];
#pragma unroll
            for (int j = 0; j < 4; ++j) { float s = 0.f;
#pragma unroll
                for (int i = 0; i < 4; ++i) { s = __builtin_amdgcn_fdot2(as_h2(ub[j][0][i]), hp[i], s, false); s = __builtin_amdgcn_fdot2(as_h2(ub[j][1][i]), hp[4 + i], s, false); }
                d[j] = s; }
            asm volatile("" ::: "memory");
            if (k + 1 < 32) LOAD_ROWS(ub, UH, k + 1);
            float s2[2], s1;
            { const bool up = lane & 32;
#pragma unroll
              for (int j = 0; j < 2; ++j) { const float keep = up ? d[j + 2] : d[j], send = up ? d[j] : d[j + 2]; s2[j] = keep + __shfl_xor(send, 32); } }
            { const bool up = lane & 16; const float keep = up ? s2[1] : s2[0], send = up ? s2[0] : s2[1]; s1 = keep + __shfl_xor(send, 16); }
            s1 += __shfl_xor(s1, 8); s1 += __shfl_xor(s1, 4); s1 += __shfl_xor(s1, 2); s1 += __shfl_xor(s1, 1);
            const float act = 0.5f * s1 * (1.f + erff(s1 * 0.70710678118654752f)) * gp[k * 4 + (lane >> 4)];
#pragma unroll
            for (int j = 0; j < 4; ++j) { const float a = __builtin_bit_cast(float, __builtin_amdgcn_readlane(__builtin_bit_cast(int, act), j * 16));
#pragma unroll
                for (int i = 0; i < 4; ++i) { const h2 v0 = as_h2(vb[j][0][i]), v1 = as_h2(vb[j][1][i]);
                    acc[2 * i] = fmaf(a, (float)v0[0], acc[2 * i]); acc[2 * i + 1] = fmaf(a, (float)v0[1], acc[2 * i + 1]);
                    acc[8 + 2 * i] = fmaf(a, (float)v1[0], acc[8 + 2 * i]); acc[8 + 2 * i + 1] = fmaf(a, (float)v1[1], acc[8 + 2 * i + 1]); } }
        }
#undef LOAD_ROWS
        float* o = out + (size_t)m * D;
        f32x4 a0 = *(f32x4*)(o + 8 * lane), a1 = *(f32x4*)(o + 8 * lane + 4), b0 = *(f32x4*)(o + 512 + 8 * lane), b1 = *(f32x4*)(o + 512 + 8 * lane + 4);
        a0 += (f32x4){acc[0], acc[1], acc[2], acc[3]}; a1 += (f32x4){acc[4], acc[5], acc[6], acc[7]};
        b0 += (f32x4){acc[8], acc[9], acc[10], acc[11]}; b1 += (f32x4){acc[12], acc[13], acc[14], acc[15]};
        *(f32x4*)(o + 8 * lane) = a0; *(f32x4*)(o + 8 * lane + 4) = a1; *(f32x4*)(o + 512 + 8 * lane) = b0; *(f32x4*)(o + 512 + 8 * lane + 4) = b1;
    }
}
}
__global__ __launch_bounds__(256) void k_conv_h(const float* __restrict__ a, _Float16* __restrict__ ao, size_t n8) {
    typedef _Float16 h8 __attribute__((ext_vector_type(8)));
    for (size_t i = (size_t)blockIdx.x * 256 + threadIdx.x; i < n8; i += (size_t)gridDim.x * 256) {
        const f32x4 x = *(const f32x4*)(a + i * 8), y = *(const f32x4*)(a + i * 8 + 4);
        h8 w = {(_Float16)x.x, (_Float16)x.y, (_Float16)x.z, (_Float16)x.w, (_Float16)y.x, (_Float16)y.y, (_Float16)y.z, (_Float16)y.w};
        *(h8*)(ao + i * 8) = w;
    }
}


namespace gla {
typedef short bf16x8 __attribute__((ext_vector_type(8)));
typedef float f32x16 __attribute__((ext_vector_type(16)));
__device__ __forceinline__ int chunk_row0(int b, int c) { return c == 0 ? M : b * SEQ + 64 * (c - 1); }
__device__ __forceinline__ int ppos(int d) { const int g = (d >> 2) & 3; return (d & ~12) | ((g == 1 ? 2 : (g == 2 ? 1 : g)) << 2); }
__device__ __forceinline__ unsigned cvtpk(float lo, float hi) { unsigned r; asm volatile("v_cvt_pk_bf16_f32 %0, %1, %2" : "=v"(r) : "v"(lo), "v"(hi)); return r; }
struct Tens { bf16_t* GQ; const bf16_t* GK; bf16_t* GKT; const bf16_t* GVT; const bf16_t* P0; const float* w_a2; const float* b_a; bf16_t* AG; float* DECL; bf16_t* OG; };
constexpr int PQROW = 136;
constexpr int P_GAL = 0, P_TOT = 2048, P_QL = 4096, P_KL = P_QL + 64 * PQROW * 2, P_END = P_KL + 64 * PQROW * 2;
__device__ __forceinline__ void prep_unit(PG8_LAS unsigned char* lds, const Tens& T, int u) {
    const int tid = threadIdx.x, wid = __builtin_amdgcn_readfirstlane(tid >> 6), lane = tid & 63;
    const int b = u / 132, h = (u / 33) & 3, c = u % 33, row0 = chunk_row0(b, c), d = tid & 127, jq = tid >> 7;
    if (c == 0 && b > 0) return;
    PG8_LAS bf16_t* GAL = (PG8_LAS bf16_t*)(lds + P_GAL); PG8_LAS float* TOT = (PG8_LAS float*)(lds + P_TOT);
    PG8_LAS bf16_t* QL = (PG8_LAS bf16_t*)(lds + P_QL); PG8_LAS bf16_t* KL = (PG8_LAS bf16_t*)(lds + P_KL);
    if (tid < 128) *(PG8_LAS u32x4*)(GAL + (tid >> 1) * 16 + (tid & 1) * 8) = *(const u32x4*)(T.P0 + (size_t)(row0 + (tid >> 1)) * P0W + 704 + (tid & 1) * 8);
    float w[GR];
#pragma unroll
    for (int r = 0; r < GR; ++r) w[r] = T.w_a2[r * GDK + h * GHK + d];
    const float ba = T.b_a[h * GHK + d];
    __syncthreads();
    float Bv[16]; float run = 0.f;
#pragma unroll
    for (int jj = 0; jj < 16; ++jj) { const int j = jq * 16 + jj; float x = ba;
        const u32x4 g0 = *(const PG8_LAS u32x4*)(GAL + j * 16), g1 = *(const PG8_LAS u32x4*)(GAL + j * 16 + 8); float gf[16]; unpack8(g0, gf); unpack8(g1, gf + 8);
#pragma unroll
        for (int r = 0; r < GR; ++r) x += gf[r] * w[r];
        float la = (fminf(x, 0.f) - log1pf(__expf(-fabsf(x)))) * (1.f / 16.f);
        if (c == 0 && j >= NMETA) la = 0.f;
        run += la; Bv[jj] = run; }
    TOT[jq * 128 + d] = run;
    __syncthreads();
    float base = 0.f, blast = 0.f;
#pragma unroll
    for (int g = 0; g < 4; ++g) { const float t = TOT[g * 128 + d]; blast += t; if (g < jq) base += t; }
    const int pd = ppos(d);
    { bf16_t* kt = T.GKT + (size_t)(h * GHK + d) * ME + row0 + jq * 16;
      const u32x4 k0 = *(const u32x4*)kt, k1 = *(const u32x4*)(kt + 8); float kf[16]; unpack8(k0, kf); unpack8(k1, kf + 8);
#pragma unroll
      for (int jj = 0; jj < 16; ++jj) kf[jj] *= __expf(blast - (base + Bv[jj]));
      *(u32x4*)kt = pack8(kf); *(u32x4*)(kt + 8) = pack8(kf + 8); }
    if (jq == 0) T.DECL[(size_t)u * GHK + d] = __expf(blast);
#pragma unroll
    for (int jj = 0; jj < 16; ++jj) { const int j = jq * 16 + jj; const float Bj = base + Bv[jj]; const size_t g = (size_t)(row0 + j) * GDK + h * GHK + d;
        QL[j * PQROW + pd] = f2bf(bf2f(T.GQ[g]) * GLA_QS * __expf(Bj)); KL[j * PQROW + pd] = f2bf(bf2f(T.GK[g]) * __expf(-Bj)); }
    __syncthreads();
#pragma unroll
    for (int i = 0; i < 2; ++i) { const int ch = tid + i * 512, r = ch >> 4, cc = ch & 15;
        *(u32x4*)(T.GQ + (size_t)(row0 + r) * GDK + h * GHK + cc * 8) = *(const PG8_LAS u32x4*)(QL + r * PQROW + cc * 8); }
    { const int bi = wid >> 1, fr = lane & 15, fq = lane >> 4;
#pragma unroll
      for (int t = 0; t < 2; ++t) { const int bj = 2 * (wid & 1) + t; f32x4 acc = {0.f, 0.f, 0.f, 0.f};
#pragma unroll
        for (int s_ = 0; s_ < 4; ++s_) { const bf16x8 af = *(const PG8_LAS bf16x8*)(QL + (16 * bi + fr) * PQROW + 32 * s_ + 8 * fq), bf = *(const PG8_LAS bf16x8*)(KL + (16 * bj + fr) * PQROW + 32 * s_ + 8 * fq);
            acc = __builtin_amdgcn_mfma_f32_16x16x32_bf16(af, bf, acc, 0, 0, 0); }
#pragma unroll
        for (int r = 0; r < 4; ++r) { const int i = 16 * bi + fq * 4 + r, j = 16 * bj + fr; T.AG[((size_t)u * 64 + i) * 64 + j] = f2bf(j <= i ? acc[r] : 0.f); } } }
    __syncthreads();
}
constexpr int S_Q = 0, S_A = 64 * 272, S_K = S_A + 64 * 144, S_D = S_K + 128 * 144, S_BUF = S_D + 512;
__device__ __forceinline__ void scan_wg(PG8_LAS unsigned char* lds, const Tens& T, int b, int h) {
    const int tid = threadIdx.x, wid = __builtin_amdgcn_readfirstlane(tid >> 6), lane = tid & 63, r32 = lane & 31, hi = lane >> 5;
    f32x16 S[4];
#pragma unroll
    for (int i = 0; i < 4; ++i) S[i] = f32x16{};
    const int u0 = (b * 4 + h) * 33;
    u32x4 sq[2], sa, sk[2]; float sd = 0.f; bf16x8 vcur[4], vnxt[4];
    const bf16_t* vrow = T.GVT + (size_t)(h * GHV + 32 * wid + r32) * ME + 8 * hi;
#define GLA_LOAD(c_) do { const int row0_ = chunk_row0(b, (c_)); \
        _Pragma("unroll") for (int i = 0; i < 2; ++i) { const int ch = tid + i * 512; sq[i] = *(const u32x4*)(T.GQ + (size_t)(row0_ + (ch >> 4)) * GDK + h * GHK + (ch & 15) * 8); \
            sk[i] = *(const u32x4*)(T.GKT + (size_t)(h * GHK + (ch >> 3)) * ME + row0_ + (ch & 7) * 8); } \
        const int uc_ = (c_) == 0 ? h * 33 : u0 + (c_); sa = *(const u32x4*)(T.AG + ((size_t)uc_ * 64 + (tid >> 3)) * 64 + (tid & 7) * 8); if (tid < 128) sd = T.DECL[(size_t)uc_ * GHK + tid]; \
        _Pragma("unroll") for (int s_ = 0; s_ < 4; ++s_) vnxt[s_] = *(const bf16x8*)(vrow + row0_ + 16 * s_); } while (0)
#define GLA_WRITE(buf) do { PG8_LAS unsigned char* L_ = lds + (buf) * S_BUF; \
        _Pragma("unroll") for (int i = 0; i < 2; ++i) { const int ch = tid + i * 512; *(PG8_LAS u32x4*)(L_ + S_Q + (ch >> 4) * 272 + (ch & 15) * 16) = sq[i]; *(PG8_LAS u32x4*)(L_ + S_K + (ch >> 3) * 144 + (ch & 7) * 16) = sk[i]; } \
        *(PG8_LAS u32x4*)(L_ + S_A + (tid >> 3) * 144 + (tid & 7) * 16) = sa; if (tid < 128) *(PG8_LAS float*)(L_ + S_D + tid * 4) = sd; } while (0)
    GLA_LOAD(0); GLA_WRITE(0);
#pragma unroll
    for (int s_ = 0; s_ < 4; ++s_) vcur[s_] = vnxt[s_];
    __syncthreads();
#pragma unroll 1
    for (int c = 0; c < 33; ++c) {
        if (c + 1 < 33) GLA_LOAD(c + 1);
        PG8_LAS unsigned char* L = lds + (c & 1) * S_BUF;
        f32x16 o[2];
#pragma unroll
        for (int ib = 0; ib < 2; ++ib) { o[ib] = f32x16{};
#pragma unroll
            for (int s_ = 0; s_ < 4; ++s_) { const bf16x8 af = *(const PG8_LAS bf16x8*)(L + S_A + (32 * ib + r32) * 144 + (16 * s_ + 8 * hi) * 2);
                o[ib] = __builtin_amdgcn_mfma_f32_32x32x16_bf16(af, vcur[s_], o[ib], 0, 0, 0); } }
#pragma unroll
        for (int s_ = 0; s_ < 8; ++s_) { const int db = s_ >> 1, t8 = 8 * (s_ & 1);
            u32x4 wv; wv.x = cvtpk(S[db][t8 + 0], S[db][t8 + 1]); wv.y = cvtpk(S[db][t8 + 2], S[db][t8 + 3]); wv.z = cvtpk(S[db][t8 + 4], S[db][t8 + 5]); wv.w = cvtpk(S[db][t8 + 6], S[db][t8 + 7]);
            const bf16x8 sf = __builtin_bit_cast(bf16x8, wv);
#pragma unroll
            for (int ib = 0; ib < 2; ++ib) { const bf16x8 qf = *(const PG8_LAS bf16x8*)(L + S_Q + (32 * ib + r32) * 272 + (16 * s_ + 8 * hi) * 2);
                o[ib] = __builtin_amdgcn_mfma_f32_32x32x16_bf16(qf, sf, o[ib], 0, 0, 0); } }
        if (c > 0) { bf16_t* Ow = T.OG + (size_t)chunk_row0(b, c) * D + h * GHV + 32 * wid;
#pragma unroll
            for (int ib = 0; ib < 2; ++ib)
#pragma unroll
                for (int r = 0; r < 16; ++r) { const int orow = 32 * ib + (r & 3) + 8 * (r >> 2) + 4 * hi; const float v = o[ib][r], vn = __shfl_xor(v, 1);
                    if ((r32 & 1) == 0) *(unsigned*)(Ow + (size_t)orow * D + r32) = cvtpk(v, vn); } }
#pragma unroll
        for (int db = 0; db < 4; ++db) {
#pragma unroll
            for (int g = 0; g < 4; ++g) { const f32x4 dv = *(const PG8_LAS f32x4*)(L + S_D + (32 * db + 8 * g + 4 * hi) * 4);
                S[db][4 * g + 0] *= dv[0]; S[db][4 * g + 1] *= dv[1]; S[db][4 * g + 2] *= dv[2]; S[db][4 * g + 3] *= dv[3]; }
#pragma unroll
            for (int s_ = 0; s_ < 4; ++s_) { const bf16x8 kf = *(const PG8_LAS bf16x8*)(L + S_K + (32 * db + r32) * 144 + (16 * s_ + 8 * hi) * 2);
                S[db] = __builtin_amdgcn_mfma_f32_32x32x16_bf16(kf, vcur[s_], S[db], 0, 0, 0); } }
        if (c + 1 < 33) { GLA_WRITE((c + 1) & 1);
#pragma unroll
            for (int s_ = 0; s_ < 4; ++s_) vcur[s_] = vnxt[s_]; }
        __syncthreads();
    }
#undef GLA_LOAD
#undef GLA_WRITE
}
}

constexpr int MEGA_THREADS = 512, MEGA_LDS = 147456;
struct MegaArgs {
    const float* in[23]; float* out; char* ws; int ph_lo, ph_hi, coop, pad;
};
enum { PH_PROJ = 1, PH_UP0 = 2, PH_UP1 = 3, PH_MIX = 4, PH_OUT = 5, PH_SCORE = 6, PH_ATT0 = 7, PH_ATT1 = 8, PH_TOPK = 9, PH_GATHER = 10, PH_GLAPREP = 11, PH_GLASCAN = 12 };

struct SchedProj { const char* XB; const char* WinT; int G, c;
    __device__ __forceinline__ bool next(int i, pg8::Unit& u) const {
        const int L = i * G + c; constexpr int NNAT = 129 * 19, NTR = 6 * 129;
        if (L >= NNAT + NTR) return false;
        if (L < NNAT) { pg8::tile_of(L, 129, 19, u.pm, u.pn); u.gid = 0; u.A = XB + (size_t)u.pm * 256 * D * 2; u.B = WinT + (size_t)u.pn * 256 * D * 2; }
        else { pg8::tile_of(L - NNAT, 6, 129, u.pm, u.pn); u.gid = 1; u.A = WinT + (size_t)(WIN_NAT + u.pm * 256) * D * 2; u.B = XB + (size_t)u.pn * 256 * D * 2; }
        return true; }
};
struct EpiProj { static constexpr bool XFORM = false; EpiProjNat n; EpiProjTr t;
    __device__ __forceinline__ void operator()(int gid, int row, int col, const float* v) const { if (gid == 0) n(row, col, v); else t(row, col, v); } };
struct SchedSimple { const char* A; const char* B; size_t sA, sB; int nM, nN, G, c, gid;
    __device__ __forceinline__ bool next(int i, pg8::Unit& u) const {
        const int L = i * G + c; if (L >= nM * nN) return false;
        pg8::tile_of(L, nM, nN, u.pm, u.pn); u.gid = gid; u.A = A + (size_t)u.pm * sA; u.B = B + (size_t)u.pn * sB; return true; }
};
struct EpiUp { static constexpr bool XFORM = false; EpiUq q; EpiUkv kv;
    __device__ __forceinline__ void operator()(int gid, int row, int col, const float* v) const { if (gid == 0) q(row, col, v); else kv(row, col, v); } };
template <class E1> struct EpiWrap { static constexpr bool XFORM = false; E1 e;
    __device__ __forceinline__ void operator()(int, int row, int col, const float* v) const { e(row, col, v); } };
struct SchedMix { const char* YA; const char* YB; const char* W1; const char* W2; int G, c;
    __device__ __forceinline__ bool next(int i, pg8::Unit& u) const {
        const int L = (i >> 1) * G + c; if (L >= 128 * 4) return false;
        pg8::tile_of(L, 128, 4, u.pm, u.pn); u.gid = i & 1;
        u.A = (u.gid ? YB : YA) + (size_t)u.pm * 256 * D * 2; u.B = (u.gid ? W2 : W1) + (size_t)u.pn * 256 * D * 2; return true; }
};
struct EpiMix { static constexpr bool XFORM = true; const bf16_t* GA; const bf16_t* GB; bf16_t* MIX;
    __device__ __forceinline__ bool keep(int gid) const { return gid == 0; }
    __device__ __forceinline__ bool xform(int gid, int row, int col, float* v) const {
        float gb[8]; unpack8(*(const u32x4*)(GB + (size_t)row * D + col), gb);
        if (gid == 0) { float ga[8]; unpack8(*(const u32x4*)(GA + (size_t)row * D + col), ga);
#pragma unroll
            for (int i = 0; i < 8; ++i) v[i] *= (1.f + __expf(-gb[i])) / (1.f + __expf(-ga[i]));
            return true; }
        float o[8];
#pragma unroll
        for (int i = 0; i < 8; ++i) o[i] = v[i] * sigmoidf_(gb[i]);
        *(u32x4*)(MIX + (size_t)row * D + col) = pack8(o); return false; }
};

__global__ void __launch_bounds__(MEGA_THREADS, 2) mega(MegaArgs a) {
    extern __shared__ __attribute__((aligned(16))) unsigned char lds_raw[];
    PG8_LAS unsigned char* lds = (PG8_LAS unsigned char*)lds_raw;
    char* ws = a.ws;
    const int G = gridDim.x, bx = blockIdx.x;
    bf16_t *WinT = (bf16_t*)(ws + O_WIN), *XB = (bf16_t*)(ws + O_XB), *P0 = (bf16_t*)(ws + O_P0), *GQ = (bf16_t*)(ws + O_GQ), *GK = (bf16_t*)(ws + O_GK), *GKT = (bf16_t*)(ws + O_GKT), *GVT = (bf16_t*)(ws + O_GVT), *GG = (bf16_t*)(ws + O_GG);
    float *R1 = (float*)(ws + O_R1), *RQ = (float*)(ws + O_RQ), *RKV = (float*)(ws + O_RKV), *SC = (float*)(ws + O_S);
    bf16_t *WuqT = (bf16_t*)(ws + O_WUQ), *WukvT = (bf16_t*)(ws + O_WUKV), *WomT = (bf16_t*)(ws + O_WOM), *WogT = (bf16_t*)(ws + O_WOG), *WoutT = (bf16_t*)(ws + O_WOUT), *WsT = (bf16_t*)(ws + O_WS);
    bf16_t *QC = (bf16_t*)(ws + O_QC), *KN = (bf16_t*)(ws + O_KN), *V = (bf16_t*)(ws + O_V), *YA = (bf16_t*)(ws + O_YA), *YB = (bf16_t*)(ws + O_YB), *MIX = (bf16_t*)(ws + O_MIX), *HN2 = (bf16_t*)(ws + O_HN2);
    bf16_t *GA = (bf16_t*)a.out, *GB = (bf16_t*)a.out + (size_t)M * D; bf16_t* KPE = (bf16_t*)(ws + O_KPE);
#define IN(k) (a.ph_lo <= (k) && (k) < a.ph_hi)
    {
        if (IN(PH_PROJ)) {
            SchedProj S{(const char*)XB, (const char*)WinT, G, bx};
            EpiProj E{EpiProjNat{R1, P0, GQ, GK, GG, GA, GB}, EpiProjTr{R1, GKT, GVT}};
            pg8::gemm_phase(lds, pg8::Fam{D, D, D}, S, E);
        }
#pragma unroll 1
        for (int ph = PH_UP0; ph <= PH_UP1; ++ph) if (IN(ph)) {
            const int r = ph - PH_UP0, Gh = G >> 1; const bool isq = bx < Gh;
            SchedSimple S{(const char*)(isq ? P0 : P0 + S_CKV), (const char*)(isq ? WuqT + (size_t)r * 768 * QR : WukvT + (size_t)r * 1024 * KVR), (size_t)256 * P0W * 2, (size_t)256 * (isq ? QR : KVR) * 2, 128, isq ? 3 : 4, isq ? Gh : G - Gh, isq ? bx : bx - Gh, isq ? 0 : 1};
            pg8::gemm_phase(lds, pg8::Fam{P0W, isq ? QR : KVR, isq ? QR : KVR}, S, EpiUp{EpiUq{RQ, QC}, EpiUkv{RKV, KN, V}});
        }
#pragma unroll 1
        for (int ph = PH_ATT0; ph <= PH_ATT1; ++ph) if (IN(ph)) {
            att::attn_phase(lds, att::Tens{QC, KN, KPE, V, YA}, ph - PH_ATT0, G, bx);
        }
        if (IN(PH_GLAPREP) || IN(PH_GLASCAN)) {
            const gla::Tens GT{GQ, GK, GKT, GVT, P0, a.in[12], a.in[13], (bf16_t*)(ws + O_AG), (float*)(ws + O_DECL), YB};
            if (IN(PH_GLAPREP)) for (int u = bx; u < GLA_NU; u += G) gla::prep_unit(lds, GT, u);
            if (IN(PH_GLASCAN)) for (int u = bx; u < NB * 4; u += G) gla::scan_wg(lds, GT, u >> 2, u & 3);
        }
        if (IN(PH_MIX)) {
            SchedMix S{(const char*)YA, (const char*)YB, (const char*)WomT, (const char*)WogT, G, bx};
            pg8::gemm_phase(lds, pg8::Fam{D, D, D}, S, EpiMix{GA, GB, MIX});
        }
        if (IN(PH_OUT)) {
            SchedSimple S{(const char*)MIX, (const char*)WoutT, (size_t)256 * D * 2, (size_t)256 * D * 2, 128, 4, G, bx, 0};
            pg8::gemm_phase(lds, pg8::Fam{D, D, D}, S, EpiWrap<EpiOut>{EpiOut{a.in[0], a.out}});
        }
        if (IN(PH_SCORE)) {
            SchedSimple S{(const char*)HN2, (const char*)WsT, (size_t)256 * D * 2, (size_t)256 * D * 2, 128, 8, G, bx, 0};
            pg8::gemm_phase(lds, pg8::Fam{D, D, D}, S, EpiWrap<EpiScore>{EpiScore{SC}});
        }
        if (IN(PH_TOPK)) peer::topk_phase(lds, SC, (int*)(ws + O_IDX), (float*)(ws + O_GATE), G, bx);
        if (IN(PH_GATHER)) peer::gather_phase(HN2, (const int*)(ws + O_IDX), (const float*)(ws + O_GATE), (const _Float16*)(ws + O_UB), (const _Float16*)(ws + O_VB), a.out, G, bx);
    }
}

template <class Epi> static void gemm(hipStream_t st, const bf16_t* A, int lda, const bf16_t* Bt, int ldb, int Mr, int N, int K, Epi E) {
    hipLaunchKernelGGL(k_gemm<Epi>, dim3(N / 128, Mr / 128), dim3(256), 0, st, A, lda, Bt, ldb, K, E);
}
extern "C" void kernel_launch(void* const* d_in, const int* in_sizes, int n_in, void* d_out, int out_size, void* d_ws, size_t ws_size, hipStream_t st) {
    (void)in_sizes; (void)n_in; (void)out_size;
    if (ws_size < 512 * MiB) { fprintf(stderr, "kernel_launch: workspace %zu < 512 MiB\n", ws_size); return; }
    const float* x = (const float*)d_in[0]; const float* meta = (const float*)d_in[1]; const float* norm_mix = (const float*)d_in[2]; const float* w_in = (const float*)d_in[3];
    const float* q_norm = (const float*)d_in[4]; const float* w_uq = (const float*)d_in[5]; const float* kv_norm = (const float*)d_in[6]; const float* w_ukv = (const float*)d_in[7];
    const float* qn_nope = (const float*)d_in[8]; const float* qn_pe = (const float*)d_in[9]; const float* kn_nope = (const float*)d_in[10]; const float* kn_pe = (const float*)d_in[11];
    const float* w_a2 = (const float*)d_in[12]; const float* b_a = (const float*)d_in[13]; const float* gla_norm = (const float*)d_in[14];
    const float* w_o_mla = (const float*)d_in[15]; const float* w_o_gla = (const float*)d_in[16]; const float* w_out = (const float*)d_in[17]; const float* norm_ffn = (const float*)d_in[18];
    const float* peer_wq = (const float*)d_in[19]; const float* peer_keys = (const float*)d_in[20]; const float* peer_u = (const float*)d_in[21]; const float* peer_v = (const float*)d_in[22];
    char* ws = (char*)d_ws; float* out = (float*)d_out;
    bf16_t *WinT = (bf16_t*)(ws + O_WIN), *WuqT = (bf16_t*)(ws + O_WUQ), *WukvT = (bf16_t*)(ws + O_WUKV), *WomT = (bf16_t*)(ws + O_WOM), *WogT = (bf16_t*)(ws + O_WOG), *WoutT = (bf16_t*)(ws + O_WOUT), *WsT = (bf16_t*)(ws + O_WS);
    float *RT = (float*)(ws + O_ROPE), *R1 = (float*)(ws + O_R1), *RQ = (float*)(ws + O_RQ), *RKV = (float*)(ws + O_RKV);
    bf16_t *KPE = (bf16_t*)(ws + O_KPE), *XB = (bf16_t*)(ws + O_XB), *P0 = (bf16_t*)(ws + O_P0), *GQ = (bf16_t*)(ws + O_GQ), *GK = (bf16_t*)(ws + O_GK), *GKT = (bf16_t*)(ws + O_GKT), *GVT = (bf16_t*)(ws + O_GVT), *GG = (bf16_t*)(ws + O_GG);
    bf16_t *QC = (bf16_t*)(ws + O_QC), *KN = (bf16_t*)(ws + O_KN), *V = (bf16_t*)(ws + O_V), *YA = (bf16_t*)(ws + O_YA), *MIX = (bf16_t*)(ws + O_MIX), *HN2 = (bf16_t*)(ws + O_HN2);
    bf16_t *GA = (bf16_t*)out, *GB = (bf16_t*)out + (size_t)M * D;
    float* DEC = (float*)(ws + O_DEC); float* S = (float*)(ws + O_S); int* IDX = (int*)(ws + O_IDX); float* GATE = (float*)(ws + O_GATE); bf16_t *UB = (bf16_t*)(ws + O_UB), *VB = (bf16_t*)(ws + O_VB);
    const int G = 2048;
    hipLaunchKernelGGL(k_prep_x, dim3(G), dim3(256), 0, st, x, meta, XB, R1);
    hipLaunchKernelGGL(k_prep_w, dim3(G), dim3(256), 0, st, w_in, DIN, D, WinT, WIN_ROWS, norm_mix, D, (int)MAP_WIN);
    hipLaunchKernelGGL(k_prep_w, dim3(G), dim3(256), 0, st, w_uq, 1536, QR, WuqT, 1536, q_norm, QR, (int)MAP_ID);
    hipLaunchKernelGGL(k_prep_w, dim3(G), dim3(256), 0, st, w_ukv, 2048, KVR, WukvT, 2048, kv_norm, KVR, (int)MAP_UKV);
    hipLaunchKernelGGL(k_prep_w, dim3(G), dim3(256), 0, st, w_o_mla, D, D, WomT, D, (const float*)nullptr, 1, (int)MAP_ID);
    hipLaunchKernelGGL(k_prep_w, dim3(G), dim3(256), 0, st, w_o_gla, D, D, WogT, D, gla_norm, GHV, (int)MAP_ID);
    hipLaunchKernelGGL(k_prep_w, dim3(G), dim3(256), 0, st, w_out, D, D, WoutT, D, (const float*)nullptr, 1, (int)MAP_ID);
    hipLaunchKernelGGL(k_prep_ws, dim3(G), dim3(256), 0, st, peer_wq, peer_keys, WsT);
    hipLaunchKernelGGL(k_prep_rope, dim3((2064 * RH + 255) / 256), dim3(256), 0, st, RT);
    static int mega_ok = 0;
    if (!mega_ok) { if (hipFuncSetAttribute((const void*)mega, hipFuncAttributeMaxDynamicSharedMemorySize, MEGA_LDS) != hipSuccess) fprintf(stderr, "hipFuncSetAttribute failed\n"); mega_ok = 1; }
    MegaArgs ma{}; for (int i = 0; i < 23; ++i) ma.in[i] = (const float*)d_in[i]; ma.out = out; ma.ws = ws; ma.coop = 0;
    ma.ph_lo = PH_PROJ; ma.ph_hi = PH_PROJ + 1;
    hipLaunchKernelGGL(mega, dim3(256), dim3(MEGA_THREADS), MEGA_LDS, st, ma);
    hipLaunchKernelGGL(k_p0stats, dim3(G), dim3(256), 0, st, P0, kn_pe, RT, RQ, RKV, KPE);
    for (int r = 0; r < 2; ++r) {
        ma.ph_lo = PH_UP0 + r; ma.ph_hi = ma.ph_lo + 1;
        hipLaunchKernelGGL(mega, dim3(256), dim3(MEGA_THREADS), MEGA_LDS, st, ma);
        gemm(st, P0 + (size_t)M * P0W + S_CKV, P0W, WukvT + (size_t)r * 1024 * KVR, KVR, 128, 1024, KVR, EpiUkv{RKV, KN, V, M, 0});
        hipLaunchKernelGGL(k_qknorm, dim3(G), dim3(256), 0, st, QC, KN, qn_nope, qn_pe, kn_nope, RT);
        ma.ph_lo = PH_ATT0 + r; ma.ph_hi = ma.ph_lo + 1;
        hipLaunchKernelGGL(mega, dim3(256), dim3(MEGA_THREADS), MEGA_LDS, st, ma);
    }
    bf16_t* YB = (bf16_t*)(ws + O_YB);
    ma.ph_lo = PH_GLAPREP; ma.ph_hi = PH_GLAPREP + 1;
    hipLaunchKernelGGL(mega, dim3(256), dim3(MEGA_THREADS), MEGA_LDS, st, ma);
    ma.ph_lo = PH_GLASCAN; ma.ph_hi = PH_GLASCAN + 1;
    hipLaunchKernelGGL(mega, dim3(256), dim3(MEGA_THREADS), MEGA_LDS, st, ma);
    (void)DEC; (void)w_a2; (void)b_a;
    hipLaunchKernelGGL(k_gla_post, dim3(G), dim3(256), 0, st, YB, GG);
    ma.ph_lo = PH_MIX; ma.ph_hi = PH_MIX + 1;
    hipLaunchKernelGGL(mega, dim3(256), dim3(MEGA_THREADS), MEGA_LDS, st, ma);
    ma.ph_lo = PH_OUT; ma.ph_hi = PH_OUT + 1;
    hipLaunchKernelGGL(mega, dim3(256), dim3(MEGA_THREADS), MEGA_LDS, st, ma);
    hipLaunchKernelGGL(k_rms2, dim3(G), dim3(256), 0, st, out, norm_ffn, HN2);
    ma.ph_lo = PH_SCORE; ma.ph_hi = PH_SCORE + 1;
    hipLaunchKernelGGL(mega, dim3(256), dim3(MEGA_THREADS), MEGA_LDS, st, ma);
    ma.ph_lo = PH_TOPK; ma.ph_hi = PH_TOPK + 1;
    hipLaunchKernelGGL(mega, dim3(256), dim3(MEGA_THREADS), MEGA_LDS, st, ma);
    hipLaunchKernelGGL(k_conv_h, dim3(G), dim3(256), 0, st, peer_u, (_Float16*)UB, (size_t)16384 * D / 8);
    hipLaunchKernelGGL(k_conv_h, dim3(G), dim3(256), 0, st, peer_v, (_Float16*)VB, (size_t)16384 * D / 8);
    ma.ph_lo = PH_GATHER; ma.ph_hi = PH_GATHER + 1;
    hipLaunchKernelGGL(mega, dim3(256), dim3(MEGA_THREADS), MEGA_LDS, st, ma);
    (void)IDX; (void)GATE; (void)S;
}
```

```cpp
#include <hip/hip_runtime.h>
#include <hip/hip_cooperative_groups.h>
namespace cg = cooperative_groups;
#include <cstdint>
#include <cstdio>

typedef unsigned short bf16_t;
typedef unsigned u32x4 __attribute__((ext_vector_type(4)));
typedef unsigned u32x2 __attribute__((ext_vector_type(2)));
typedef float f32x4 __attribute__((ext_vector_type(4)));

constexpr int D = 1024, NB = 16, SEQ = 2048, M = NB * SEQ, ME = M + 256, NMETA = 16;
constexpr float EPS = 1e-6f;
constexpr int QR = 384, KVR = 256, NOPE = 128, ROPE = 64, RH = 32, QKD = 192;
constexpr int GDK = 512, GDV = 1024, GHK = 128, GHV = 256, GR = 16;
constexpr int DIN = 5840;
constexpr int S_CQ = 0, S_CKV = 384, S_KPE = 640, S_GQ = 704, S_GK = 1216, S_GV = 1728, S_GA = 2752, S_GG = 2768, S_A = 3792, S_B = 4816;
constexpr int WIN_ROWS = 5888, WIN_NAT = 4352, P0W = 768;
constexpr float SCL2 = 0.07216878364870323f * 1.4426950408889634f;
constexpr float GLA_QS = 0.08838834764831845f;

constexpr size_t MiB = 1u << 20;
constexpr size_t al(size_t x) { return (x + 255) / 256 * 256; }
constexpr size_t O_WIN = 0;
constexpr size_t O_WUQ = O_WIN + al((size_t)WIN_ROWS * D * 2);
constexpr size_t O_WUKV = O_WUQ + al((size_t)1536 * QR * 2);
constexpr size_t O_WOM = O_WUKV + al((size_t)2048 * KVR * 2);
constexpr size_t O_WOG = O_WOM + al((size_t)D * D * 2);
constexpr size_t O_WOUT = O_WOG + al((size_t)D * D * 2);
constexpr size_t O_WS = O_WOUT + al((size_t)D * D * 2);
constexpr size_t O_ROPE = O_WS + al((size_t)2048 * D * 2);
constexpr size_t O_R1 = O_ROPE + al((size_t)2064 * RH * 2 * 4);
constexpr size_t O_RQ = O_R1 + al((size_t)ME * 4);
constexpr size_t O_RKV = O_RQ + al((size_t)ME * 4);
constexpr size_t O_KPE = O_RKV + al((size_t)ME * 4);
constexpr size_t O_XB = O_KPE + al((size_t)ME * ROPE * 2);
constexpr size_t O_POOL = O_XB + al((size_t)ME * D * 2);
constexpr size_t O_GKT = O_POOL;
constexpr size_t O_GQ = O_GKT + al((size_t)ME * GDK * 2);
constexpr size_t O_P0 = O_GQ + al((size_t)ME * GDK * 2);
constexpr size_t O_GK = O_P0 + al((size_t)ME * P0W * 2);
constexpr size_t O_GVT = O_GK + al((size_t)ME * GDK * 2);
constexpr size_t O_GG = O_GVT + al((size_t)ME * GDV * 2);
constexpr size_t O_QC = O_GG + al((size_t)M * D * 2);
constexpr size_t O_KN = O_QC + al((size_t)M * 768 * 2);
constexpr size_t O_V = O_KN + al((size_t)ME * 512 * 2);
constexpr size_t O_END = O_V + al((size_t)ME * 512 * 2);
constexpr int GLA_NU = NB * 4 * 33;
constexpr size_t O_AG = O_END;
constexpr size_t O_DECL = O_AG + al((size_t)GLA_NU * 64 * 64 * 2);
constexpr size_t O_BAR = O_DECL + al((size_t)GLA_NU * 128 * 4);
constexpr size_t BAR_BYTES = 16384;
constexpr size_t O_SSQ = O_BAR + BAR_BYTES;
constexpr size_t O_WSEND = O_SSQ + al((size_t)M * 32 * 4);
static_assert(O_WSEND <= 512 * MiB, "ws");
constexpr size_t O_YA = O_XB;
constexpr size_t O_YB = O_P0;
static_assert(O_YB + (size_t)M * D * 2 <= O_GVT, "YB overlay");
constexpr size_t O_MIX = O_GVT;
constexpr size_t O_HN2 = O_XB;
constexpr size_t O_S = O_POOL;
constexpr size_t O_IDX = O_QC;
static_assert(O_S + (size_t)M * 2048 * 4 <= O_QC, "S overlay");
constexpr size_t O_GATE = O_IDX + al((size_t)M * 128 * 4);
constexpr size_t O_UB = O_GATE + al((size_t)M * 128 * 4);
constexpr size_t O_VB = O_UB + al((size_t)16384 * D * 2);
static_assert(O_VB + (size_t)16384 * D * 2 <= O_END, "tables overlay");

__device__ __forceinline__ float bf2f(bf16_t u) { return __uint_as_float((unsigned)u << 16); }
__device__ __forceinline__ bf16_t f2bf(float f) { unsigned u = __float_as_uint(f); return (bf16_t)((u + 0x7fffu + ((u >> 16) & 1u)) >> 16); }
__device__ __forceinline__ unsigned pk2(float lo, float hi) { return (unsigned)f2bf(lo) | ((unsigned)f2bf(hi) << 16); }
__device__ __forceinline__ void unpack8(u32x4 w, float* f) {
#pragma unroll
    for (int i = 0; i < 4; ++i) { f[2 * i] = __uint_as_float(w[i] << 16); f[2 * i + 1] = __uint_as_float(w[i] & 0xffff0000u); }
}
__device__ __forceinline__ u32x4 pack8(const float* f) { u32x4 w; w.x = pk2(f[0], f[1]); w.y = pk2(f[2], f[3]); w.z = pk2(f[4], f[5]); w.w = pk2(f[6], f[7]); return w; }
__device__ __forceinline__ float swap_add32(float a, float b) { const u32x2 r = __builtin_amdgcn_permlane32_swap(__float_as_uint(a), __float_as_uint(b), false, false); return __uint_as_float(r.x) + __uint_as_float(r.y); }
__device__ __forceinline__ float swap_add16(float a, float b) { const u32x2 r = __builtin_amdgcn_permlane16_swap(__float_as_uint(a), __float_as_uint(b), false, false); return __uint_as_float(r.x) + __uint_as_float(r.y); }
template <int CTRL> __device__ __forceinline__ float dpp_f(float x) { return __builtin_bit_cast(float, __builtin_amdgcn_update_dpp(0, __builtin_bit_cast(int, x), CTRL, 0xf, 0xf, true)); }
__device__ __forceinline__ float wsum(float v) {
    const float h = swap_add32(v, v); float s = swap_add16(h, h);
    s += dpp_f<0x128>(s); s += dpp_f<0xB1>(s); s += dpp_f<0x4E>(s); s += dpp_f<0x141>(s); return s;
}
__device__ __forceinline__ float wmax(float v) {
#pragma unroll
    for (int o = 32; o >= 1; o >>= 1) v = fmaxf(v, __shfl_xor(v, o));
    return v;
}
__device__ __forceinline__ int lane_id() { return (int)__builtin_amdgcn_mbcnt_hi(~0u, __builtin_amdgcn_mbcnt_lo(~0u, 0u)); }
__device__ __forceinline__ float sigmoidf_(float x) { return 1.f / (1.f + __expf(-x)); }
__device__ __forceinline__ int tok_pos(int row) { return row < M ? (row & (SEQ - 1)) + NMETA : row - M; }

enum { MAP_ID = 0, MAP_WIN = 1, MAP_UKV = 2 };
__device__ __forceinline__ int map_col(int mode, int n) {
    if (mode == MAP_ID) return n;
    if (mode == MAP_WIN) {
        if (n < 704) return n;
        if (n < 720) return S_GA + (n - 704);
        if (n < 768) return -1;
        if (n < 1280) return S_GQ + (n - 768);
        if (n < 2304) return S_GG + (n - 1280);
        if (n < 3328) return S_A + (n - 2304);
        if (n < 4352) return S_B + (n - 3328);
        if (n < 4864) return S_GK + (n - 4352);
        return S_GV + (n - 4864);
    }
    const int r = n >> 10, j = n & 1023;
    if (j < 512) return (4 * r + (j >> 7)) * 256 + (j & 127);
    return (4 * r + ((j - 512) >> 7)) * 256 + 128 + ((j - 512) & 127);
}
struct EpiProjNat {
    const float* R1; bf16_t *P0, *GQ, *GG, *GA, *GB;
    __device__ __forceinline__ void operator()(int row, int col, const float* v, float s) const {
        float o[8];
#pragma unroll
        for (int i = 0; i < 8; ++i) o[i] = v[i] * s;
        bf16_t* dst;
        if (col < 768) dst = P0 + (size_t)row * P0W + col;
        else if (col < 1280) dst = GQ + (size_t)row * GDK + (col - 768);
        else { if (row >= M) return;
            if (col < 2304) dst = GG + (size_t)row * D + (col - 1280);
            else if (col < 3328) dst = GA + (size_t)row * D + (col - 2304);
            else dst = GB + (size_t)row * D + (col - 3328); }
        *(u32x4*)dst = pack8(o);
    }
};
struct EpiProjTr {
    const float* R1; bf16_t *GKT, *GVT;
    __device__ __forceinline__ void operator()(int row, int col, const float* v, const f32x4 (&c)[2]) const {
        const float o[8] = {v[0] * c[0].x, v[1] * c[0].y, v[2] * c[0].z, v[3] * c[0].w, v[4] * c[1].x, v[5] * c[1].y, v[6] * c[1].z, v[7] * c[1].w};
        bf16_t* dst = row < 512 ? GKT + (size_t)row * ME + col : GVT + (size_t)(row - 512) * ME + col;
        *(u32x4*)dst = pack8(o);
    }
};
struct EpiUq {
    const float* RQ; bf16_t* QC;
    __device__ __forceinline__ void operator()(int row, int col, const float* v, float s) const {
        if (row >= M) return;
        float o[8];
#pragma unroll
        for (int i = 0; i < 8; ++i) o[i] = v[i] * s;
        *(u32x4*)(QC + (size_t)row * 768 + col) = pack8(o);
    }
};
struct EpiUkv {
    const float* RKV; bf16_t *KN, *V; int roff = 0, pad = 0;
    __device__ __forceinline__ void operator()(int row, int col, const float* v, float s) const {
        row += roff; float o[8];
#pragma unroll
        for (int i = 0; i < 8; ++i) o[i] = v[i] * s;
        bf16_t* dst = col < 512 ? KN + (size_t)row * 512 + col : V + (size_t)row * 512 + (col - 512);
        *(u32x4*)dst = pack8(o);
    }
};
struct EpiOut { static constexpr bool XFORM = false, ROWSTAT = false, PRE = false, AUX = true;
    const float* __restrict__ x; float* __restrict__ out; bf16_t* __restrict__ HB; float* __restrict__ SSQ;
    __device__ __forceinline__ bool keep(int) const { return false; }
    __device__ __forceinline__ void aux(int, int row, int col, u32x4 (&ax)[2]) const { ax[0] = *(const u32x4*)(x + (size_t)row * D + col); ax[1] = *(const u32x4*)(x + (size_t)row * D + col + 4); }
    __device__ __forceinline__ bool apply(int, int row, int col, float* v, const u32x4 (&ax)[2]) const {
        const f32x4 a = __builtin_bit_cast(f32x4, ax[0]), b = __builtin_bit_cast(f32x4, ax[1]);
        const float h[8] = {a.x + v[0], a.y + v[1], a.z + v[2], a.w + v[3], b.x + v[4], b.y + v[5], b.z + v[6], b.w + v[7]};
        *(u32x4*)(HB + (size_t)row * D + col) = pack8(h);
        float ss = (h[0] * h[0] + h[1] * h[1]) + (h[2] * h[2] + h[3] * h[3]) + (h[4] * h[4] + h[5] * h[5]) + (h[6] * h[6] + h[7] * h[7]);
        ss = swap_add16(ss, ss); ss = swap_add32(ss, ss);
        if (((col >> 3) & 3) == 0) SSQ[(size_t)row * 32 + (col >> 5)] = ss;
        return false; }
};
struct EpiScore { bf16_t* S;
    __device__ __forceinline__ void operator()(int row, int col, const float* v) const { *(u32x4*)(S + (size_t)row * 2048 + col) = pack8(v); }
};

namespace pg8 {
#define PG8_LAS __attribute__((address_space(3)))
typedef short bf16x8 __attribute__((ext_vector_type(8)));
constexpr int BM = 256, BK = 64, HALF = 128, HTB = HALF * BK * 2, STAGE_BYTES = 8 * HTB, NXCD = 8, WGM = 8;
__host__ __device__ __forceinline__ int lds_byte(int r, int c) { const int st = (r >> 4) * 2 + (c >> 5), rr = r & 15, cc = c & 31, ob = rr * 64 + cc * 2; return st * 1024 + (ob ^ (((ob >> 9) & 1) << 5)); }
__host__ __device__ __forceinline__ void stage_rc(int b, int& R, int& C) { const int st = b / 1024, sb = b % 1024, swz = sb ^ (((sb >> 9) & 1) << 5); R = (st >> 1) * 16 + swz / 64; C = (st & 1) * 32 + (swz % 64) / 2; }
__host__ __device__ __forceinline__ int perm32(int rho) { const int n = rho >> 4, i = rho & 15; return 8 * (i >> 2) + 4 * n + (i & 3); }
struct Unit { const char* A; const char* B; int pm, pn, gid; };
struct Fam { int lda, ldb, K; };
__device__ __forceinline__ void tile_of(int L, int nM, int nN, int& pm, int& pn) {
    const int nwg = nM * nN; int wgid = L; { const int q = nwg / NXCD, r = nwg % NXCD, xcd = wgid % NXCD, off = wgid / NXCD; wgid = (xcd < r ? xcd * (q + 1) : r * (q + 1) + (xcd - r) * q) + off; }
    const int nig = WGM * nN, gid = wgid / nig, fm = gid * WGM, gsz = (nM - fm) < WGM ? (nM - fm) : WGM;
    pm = fm + ((wgid % nig) % gsz); pn = (wgid % nig) / gsz;
}
template <class Epi, class Sched>
__device__ __forceinline__ void gemm_phase(PG8_LAS unsigned char* lds, const Fam f, const Sched& S, const Epi& E, int wv) {
    int tid_ = wv * 64 + lane_id(); asm volatile("" : "+v"(tid_));
    const int tid = tid_, wid = __builtin_amdgcn_readfirstlane(tid >> 6), lane = tid & 63, wr = wid >> 2, wc = wid & 3, fr = lane & 15, fq = lane >> 4;
    const int nt = f.K / BK;
    unsigned voffA[2], voffB[2];
#pragma unroll
    for (int i = 0; i < 2; ++i) { int R, C; stage_rc(tid * 16 + i * 8192, R, C); const int Rb = (R & ~31) + perm32(R & 31);
        voffA[i] = (unsigned)(R * f.lda + C) * 2u; voffB[i] = (unsigned)(Rb * f.ldb + C) * 2u; }
    const size_t kstep = (size_t)(BK * 2);
    const size_t hstepA = (size_t)HALF * f.lda * 2, hstepB = (size_t)HALF * f.ldb * 2;
    const unsigned ldsw = (unsigned)wid * 1024u;
    const int aoff = lds_byte(wr * 64 + fr, fq * 8), boff = lds_byte(wc * 32 + fr, fq * 8);
#define PG8_SA(b, h) (((b) * 2 + (h)) * HTB)
#define PG8_SB(b, h) ((4 + (b) * 2 + (h)) * HTB)
#define PG8_STAGE(bufoff, gbase, voff) do { _Pragma("unroll") for (int _i = 0; _i < 2; ++_i) \
        __builtin_amdgcn_global_load_lds((const unsigned*)((const char*)(gbase) + (voff)[_i]), (PG8_LAS unsigned*)(lds + (bufoff) + ldsw + _i * 8192), 16, 0, 0); } while (0)
#define PG8_LDA(dst, b, h) do { _Pragma("unroll") for (int m = 0; m < 4; ++m) _Pragma("unroll") for (int k = 0; k < 2; ++k) dst[m][k] = *(const PG8_LAS bf16x8*)(lds + PG8_SA(b, h) + aoff + m * 2048 + k * 1024); } while (0)
#define PG8_LDB(dst, b, h) do { _Pragma("unroll") for (int n = 0; n < 2; ++n) _Pragma("unroll") for (int k = 0; k < 2; ++k) dst[n][k] = *(const PG8_LAS bf16x8*)(lds + PG8_SB(b, h) + boff + n * 2048 + k * 1024); } while (0)
#define PG8_MMA(ai, bj, At, Bt) do { __builtin_amdgcn_s_setprio(1); _Pragma("unroll") for (int m = 0; m < 4; ++m) _Pragma("unroll") for (int n = 0; n < 2; ++n) _Pragma("unroll") for (int k = 0; k < 2; ++k) \
        acc[ai][bj][m][n] = __builtin_amdgcn_mfma_f32_16x16x32_bf16(Bt[n][k], At[m][k], acc[ai][bj][m][n], 0, 0, 0); __builtin_amdgcn_s_setprio(0); } while (0)
#define PG8_WAIT_V(n) asm volatile("s_waitcnt vmcnt(" #n ")" ::: "memory")
#define PG8_WAIT_L(n) asm volatile("s_waitcnt lgkmcnt(" #n ")" ::: "memory")
#define PG8_BAR __builtin_amdgcn_s_barrier()
#define PG8_SCHED __builtin_amdgcn_sched_barrier(0)
    Unit cur, nxt; int ui = 0;
    if (!S.next(0, cur)) return;
    f32x4 acc[2][2][4][2];
#pragma unroll
    for (int a = 0; a < 2; ++a)
#pragma unroll
        for (int b = 0; b < 2; ++b)
#pragma unroll
            for (int m = 0; m < 4; ++m)
#pragma unroll
                for (int n = 0; n < 2; ++n) acc[a][b][m][n] = (f32x4){0.f, 0.f, 0.f, 0.f};
    bf16x8 At[4][2], B0[2][2], B1[2][2];
    const char* cA = cur.A; const char* cB = cur.B;
    PG8_STAGE(PG8_SB(0, 0), cB, voffB); PG8_STAGE(PG8_SB(0, 1), cB + hstepB, voffB); PG8_STAGE(PG8_SA(0, 0), cA, voffA); PG8_STAGE(PG8_SA(0, 1), cA + hstepA, voffA);
    if (wr == 1) PG8_BAR;
    PG8_WAIT_V(2); PG8_BAR;
    PG8_STAGE(PG8_SB(1, 0), cB + kstep, voffB); PG8_STAGE(PG8_SA(1, 0), cA + kstep, voffA); PG8_STAGE(PG8_SB(1, 1), cB + hstepB + kstep, voffB);
    PG8_WAIT_V(6); PG8_BAR;
    for (;;) {
        const bool has_next = S.next(ui + 1, nxt);
        const char* nA = has_next ? nxt.A : cA; const char* nB = has_next ? nxt.B : cB;
        for (int t = 0; t < nt; t += 2) {
            const bool last = (t == nt - 2);
            const char* a1 = cA + (size_t)(t + 1) * kstep;
            const char* a2 = last ? nA : cA + (size_t)(t + 2) * kstep; const char* b2 = last ? nB : cB + (size_t)(t + 2) * kstep;
            const char* a3 = a2 + kstep; const char* b3 = b2 + kstep;
            PG8_LDB(B0, 0, 0); PG8_LDB(B1, 0, 1); PG8_SCHED; PG8_LDA(At, 0, 0); PG8_STAGE(PG8_SA(1, 1), a1 + hstepA, voffA);
            PG8_WAIT_V(8); PG8_WAIT_L(0); PG8_BAR; PG8_MMA(0, 0, At, B0); PG8_MMA(0, 1, At, B1); PG8_BAR; PG8_SCHED;
            PG8_LDA(At, 0, 1); PG8_STAGE(PG8_SB(0, 0), b2, voffB); PG8_STAGE(PG8_SB(0, 1), b2 + hstepB, voffB); PG8_STAGE(PG8_SA(0, 0), a2, voffA);
            PG8_WAIT_V(8); PG8_WAIT_L(0); PG8_BAR; PG8_MMA(1, 0, At, B0); PG8_MMA(1, 1, At, B1); PG8_BAR; PG8_SCHED;
            PG8_LDB(B0, 1, 0); PG8_LDB(B1, 1, 1); PG8_SCHED; PG8_LDA(At, 1, 0); PG8_STAGE(PG8_SA(0, 1), a2 + hstepA, voffA);
            PG8_WAIT_V(8); PG8_WAIT_L(0); PG8_BAR; PG8_MMA(0, 0, At, B0); PG8_MMA(0, 1, At, B1); PG8_BAR; PG8_SCHED;
            PG8_LDA(At, 1, 1); PG8_STAGE(PG8_SB(1, 0), b3, voffB); PG8_STAGE(PG8_SB(1, 1), b3 + hstepB, voffB); PG8_STAGE(PG8_SA(1, 0), a3, voffA);
            PG8_WAIT_V(8); PG8_WAIT_L(0); PG8_BAR; PG8_MMA(1, 0, At, B0); PG8_MMA(1, 1, At, B1); PG8_BAR; PG8_SCHED;
        }
        if (wr == 0) PG8_BAR;
        {
            const int row0 = cur.pm * BM + wr * 64 + fr, col0 = cur.pn * BM + wc * 32 + 8 * fq;
            float rs[2][4]; f32x4 cs[2][2];
            if constexpr (Epi::PRE) E.pre(cur.gid, row0, col0, rs, cs);
            bool stat = false; PG8_LAS float* XS = (PG8_LAS float*)(lds + 131072 + 512);
            if constexpr (Epi::ROWSTAT) { if (E.want_stat(cur.gid, cur.pn)) {
                stat = true;
#pragma unroll
                for (int ai = 0; ai < 2; ++ai)
#pragma unroll
                    for (int m = 0; m < 4; ++m)
#pragma unroll
                        for (int bj = 0; bj < 2; ++bj) { const f32x4 v0 = acc[ai][bj][m][0], v1 = acc[ai][bj][m][1];
                            float ss = (v0[0] * v0[0] + v0[1] * v0[1]) + (v0[2] * v0[2] + v0[3] * v0[3]) + (v1[0] * v1[0] + v1[1] * v1[1]) + (v1[2] * v1[2] + v1[3] * v1[3]);
                            ss = swap_add16(ss, ss); ss = swap_add32(ss, ss);
                            if (fq == 0) XS[(wc * 256 + ai * 128 + wr * 64 + m * 16 + fr) * 2 + bj] = ss; }
                asm volatile("s_waitcnt lgkmcnt(0)" ::: "memory"); __builtin_amdgcn_s_barrier(); asm volatile("" ::: "memory");
            } }
            if constexpr (Epi::AUX) {
                u32x4 axn[2]; E.aux(cur.gid, row0, col0, axn);
#pragma unroll
                for (int k = 0; k < 16; ++k) { const int ai = k >> 3, m = (k >> 1) & 3, bj = k & 1; u32x4 ax[2] = {axn[0], axn[1]};
                    if (k + 1 < 16) E.aux(cur.gid, row0 + ((k + 1) >> 3) * HALF + (((k + 1) >> 1) & 3) * 16, col0 + ((k + 1) & 1) * HALF, axn);
                    const f32x4 v0 = acc[ai][bj][m][0], v1 = acc[ai][bj][m][1];
                    float v[8] = {v0[0], v0[1], v0[2], v0[3], v1[0], v1[1], v1[2], v1[3]};
                    if (E.apply(cur.gid, row0 + ai * HALF + m * 16, col0 + bj * HALF, v, ax)) { acc[ai][bj][m][0] = (f32x4){v[0], v[1], v[2], v[3]}; acc[ai][bj][m][1] = (f32x4){v[4], v[5], v[6], v[7]}; } }
            } else
#pragma unroll
            for (int ai = 0; ai < 2; ++ai)
#pragma unroll
                for (int m = 0; m < 4; ++m)
#pragma unroll
                    for (int bj = 0; bj < 2; ++bj) {
                        const f32x4 v0 = acc[ai][bj][m][0], v1 = acc[ai][bj][m][1];
                        float v[8] = {v0[0], v0[1], v0[2], v0[3], v1[0], v1[1], v1[2], v1[3]};
                        if constexpr (Epi::XFORM) { if (E.xform(cur.gid, row0 + ai * HALF + m * 16, col0 + bj * HALF, v)) {
                            acc[ai][bj][m][0] = (f32x4){v[0], v[1], v[2], v[3]}; acc[ai][bj][m][1] = (f32x4){v[4], v[5], v[6], v[7]}; } }
                        else if constexpr (Epi::ROWSTAT) { float ss = 0.f; if (stat) { const int rl = (ai * 128 + wr * 64 + m * 16 + fr) * 2 + bj; ss = (XS[rl] + XS[512 + rl]) + (XS[1024 + rl] + XS[1536 + rl]); }
                            E(cur.gid, row0 + ai * HALF + m * 16, col0 + bj * HALF, v, ss, rs[ai][m], cs[bj]); }
                        else if constexpr (Epi::PRE) E(cur.gid, row0 + ai * HALF + m * 16, col0 + bj * HALF, v, rs[ai][m], cs[bj]);
                        else E(cur.gid, row0 + ai * HALF + m * 16, col0 + bj * HALF, v);
                    }
        }
        if (!has_next) break;
        bool keep = false; if constexpr (Epi::XFORM || Epi::AUX) keep = E.keep(cur.gid);
        if (!keep) {
#pragma unroll
        for (int a = 0; a < 2; ++a)
#pragma unroll
            for (int b = 0; b < 2; ++b)
#pragma unroll
                for (int m = 0; m < 4; ++m)
#pragma unroll
                    for (int n = 0; n < 2; ++n) acc[a][b][m][n] = (f32x4){0.f, 0.f, 0.f, 0.f};
        }
        cur = nxt; cA = nA; cB = nB; ++ui;
        if (wr == 1) PG8_BAR;
    }
    PG8_WAIT_V(0);
    PG8_BAR;
#undef PG8_SA
#undef PG8_SB
#undef PG8_STAGE
#undef PG8_LDA
#undef PG8_LDB
#undef PG8_MMA
#undef PG8_WAIT_V
#undef PG8_WAIT_L
#undef PG8_BAR
#undef PG8_SCHED
}
}


namespace att {
typedef short bf16x8 __attribute__((ext_vector_type(8)));
typedef short s16x4 __attribute__((ext_vector_type(4)));
typedef float f32x16 __attribute__((ext_vector_type(16)));
typedef PG8_LAS const char* lptr;
constexpr int KROWB = 384, SHM_K = 64 * KROWB, SHM_V = 64 * 256;
constexpr int L_K = 0, L_V = 2 * SHM_K, L_WS = L_V + 2 * SHM_V, L_END = L_WS + 8 * 256;
constexpr float THRL = 11.5f;
__device__ __forceinline__ int crow(int r, int hi) { return (r & 3) + 8 * (r >> 2) + 4 * hi; }
__device__ __forceinline__ unsigned cvtpk(float lo, float hi) { unsigned r; asm volatile("v_cvt_pk_bf16_f32 %0, %1, %2" : "=v"(r) : "v"(lo), "v"(hi)); return r; }
__device__ __forceinline__ int v_rd_base(int lane) { return ((lane & 3) << 3) | (((lane >> 2) & 3) << 6) | (((lane >> 4) & 1) << 5) | (((lane >> 5) & 1) << 8); }
constexpr int v_rd_off(int d0, int ks, int half) { return d0 * 512 + ks * 4096 + half * 2048; }
__device__ __forceinline__ void partialSM(f32x16& p0, f32x16& p1, float& m_reg, float& alpha) {
    float pmax = p0[0];
#pragma unroll
    for (int r = 1; r < 16; ++r) pmax = fmaxf(pmax, p0[r]);
#pragma unroll
    for (int r = 0; r < 16; ++r) pmax = fmaxf(pmax, p1[r]);
    { auto rr = __builtin_amdgcn_permlane32_swap(__float_as_uint(pmax), __float_as_uint(pmax), false, false); pmax = fmaxf(__uint_as_float(rr[0]), __uint_as_float(rr[1])); }
    float mn;
    if (__builtin_expect(__all(pmax - m_reg <= THRL), 1)) { mn = m_reg; alpha = 1.f; }
    else { mn = fmaxf(m_reg, pmax); alpha = __builtin_amdgcn_exp2f(m_reg - mn); m_reg = mn; }
#pragma unroll
    for (int r = 0; r < 16; ++r) { p0[r] = __builtin_amdgcn_exp2f(p0[r] - mn); p1[r] = __builtin_amdgcn_exp2f(p1[r] - mn); }
}
__device__ __forceinline__ void finishSM(const f32x16& p0, const f32x16& p1, float alpha, float& l_reg, bf16x8& pa0, bf16x8& pa1, bf16x8& pa2, bf16x8& pa3) {
    float ps = 0.f;
#pragma unroll
    for (int r = 0; r < 16; ++r) ps += p0[r] + p1[r];
    { auto rr = __builtin_amdgcn_permlane32_swap(__float_as_uint(ps), __float_as_uint(ps), false, false); ps = __uint_as_float(rr[0]) + __uint_as_float(rr[1]); }
    l_reg = l_reg * alpha + ps;
#define PK4(P, B_, OUT) do { unsigned a0 = cvtpk(P[B_+0], P[B_+1]), a1 = cvtpk(P[B_+2], P[B_+3]); unsigned b0 = cvtpk(P[B_+4], P[B_+5]), b1 = cvtpk(P[B_+6], P[B_+7]); \
        auto r0 = __builtin_amdgcn_permlane32_swap(a0, b0, false, false); auto r1 = __builtin_amdgcn_permlane32_swap(a1, b1, false, false); \
        u32x4 w = {r0[0], r1[0], r0[1], r1[1]}; OUT = __builtin_bit_cast(bf16x8, w); } while (0)
    PK4(p0, 0, pa0); PK4(p0, 8, pa1); PK4(p1, 0, pa2); PK4(p1, 8, pa3);
#undef PK4
}
template <int KB>
__device__ __forceinline__ void qkt(f32x16& p0, f32x16& p1, lptr K_lds, int r32, int hi, const bf16x8* qr) {
    p0 = f32x16{}; p1 = f32x16{};
    lptr kb[4];
#pragma unroll
    for (int dd = 0; dd < 4; ++dd) kb[dd] = K_lds + KB * SHM_K + r32 * KROWB + (((dd * 16 + hi * 8) * 2) ^ ((r32 & 7) << 4));
#pragma unroll
    for (int d0 = 0; d0 < 12; ++d0) { lptr a = kb[d0 & 3] + (d0 >> 2) * 128;
        const bf16x8 b0 = *(const PG8_LAS bf16x8*)a, b1 = *(const PG8_LAS bf16x8*)(a + 32 * KROWB);
        p0 = __builtin_amdgcn_mfma_f32_32x32x16_bf16(b0, qr[d0], p0, 0, 0, 0);
        p1 = __builtin_amdgcn_mfma_f32_32x32x16_bf16(b1, qr[d0], p1, 0, 0, 0); }
}
template <int VB>
__device__ __forceinline__ void pv_tile(f32x16* o, int vb0, bf16x8 pa0, bf16x8 pa1, bf16x8 pa2, bf16x8 pa3) {
#define TRRD(dst, off) asm volatile("ds_read_b64_tr_b16 %0, %1 offset:%2" : "=&v"(dst) : "v"(vb0), "i"(off) : "memory")
#define PV_D0(d0) do { s16x4 l0, l1, l2, l3, h0, h1, h2, h3; constexpr int b_ = VB * SHM_V + v_rd_off(d0, 0, 0); \
        TRRD(l0, b_); TRRD(h0, b_ + 2048); TRRD(l1, b_ + 4096); TRRD(h1, b_ + 6144); TRRD(l2, b_ + 8192); TRRD(h2, b_ + 10240); TRRD(l3, b_ + 12288); TRRD(h3, b_ + 14336); \
        asm volatile("s_waitcnt lgkmcnt(0)" ::: "memory"); __builtin_amdgcn_sched_barrier(0); \
        o[d0] = __builtin_amdgcn_mfma_f32_32x32x16_bf16(pa0, (bf16x8){l0[0], l0[1], l0[2], l0[3], h0[0], h0[1], h0[2], h0[3]}, o[d0], 0, 0, 0); \
        o[d0] = __builtin_amdgcn_mfma_f32_32x32x16_bf16(pa1, (bf16x8){l1[0], l1[1], l1[2], l1[3], h1[0], h1[1], h1[2], h1[3]}, o[d0], 0, 0, 0); \
        o[d0] = __builtin_amdgcn_mfma_f32_32x32x16_bf16(pa2, (bf16x8){l2[0], l2[1], l2[2], l2[3], h2[0], h2[1], h2[2], h2[3]}, o[d0], 0, 0, 0); \
        o[d0] = __builtin_amdgcn_mfma_f32_32x32x16_bf16(pa3, (bf16x8){l3[0], l3[1], l3[2], l3[3], h3[0], h3[1], h3[2], h3[3]}, o[d0], 0, 0, 0); } while (0)
    PV_D0(0); PV_D0(1); PV_D0(2); PV_D0(3);
#undef PV_D0
#undef TRRD
}
struct Tens { const bf16_t* QC; const bf16_t* KN; const bf16_t* KPE; const bf16_t* V; bf16_t* YA; const float* qn_nope; const float* qn_pe; const float* RT; };
__device__ __forceinline__ void attn_unit(PG8_LAS unsigned char* lds, const Tens& T, int b, int hh, int qb, int round, int wv) {
    int tid_ = wv * 64 + lane_id(); asm volatile("" : "+v"(tid_));
    const int tid = tid_, wid = __builtin_amdgcn_readfirstlane(tid >> 6), lane = tid & 63, r32 = lane & 31, hi = lane >> 5;
    const int NT = 4 * qb + 5, last_act = 4 * qb + (wid >> 1) + 1;
    unsigned koff[3]; bool kpe[3]; unsigned voff[2];
#pragma unroll
    for (int i = 0; i < 3; ++i) { const int p16 = (i * 8 + wid) * 64 + lane, row = p16 / 24, cp = p16 % 24, c = (cp & ~7) | ((cp & 7) ^ (row & 7));
        kpe[i] = c >= 16; koff[i] = kpe[i] ? (unsigned)(row * ROPE + (c - 16) * 8) * 2u : (unsigned)(row * 512 + hh * NOPE + c * 8) * 2u; }
#pragma unroll
    for (int i = 0; i < 2; ++i) { const int p16 = (i * 8 + wid) * 64 + lane, sub = p16 >> 5, kk = (sub >> 2) * 8 + ((p16 >> 2) & 7), cc = (sub & 3) * 32 + (p16 & 3) * 8;
        const int k = (kk & ~0xC) | ((kk & 4) << 1) | ((kk & 8) >> 1); voff[i] = (unsigned)(k * 512 + hh * 128 + cc) * 2u; }
    const unsigned ldsw = (unsigned)wid * 1024u;
#define ATT_DMA(jt, buf) do { const int kbase_ = (jt) == 0 ? M : b * SEQ + 64 * ((jt) - 1); \
        const char* kn_ = (const char*)(T.KN + (size_t)kbase_ * 512); const char* kp_ = (const char*)(T.KPE + (size_t)kbase_ * ROPE); const char* vv_ = (const char*)(T.V + (size_t)kbase_ * 512); \
        _Pragma("unroll") for (int i_ = 0; i_ < 3; ++i_) __builtin_amdgcn_global_load_lds((const unsigned*)((kpe[i_] ? kp_ : kn_) + koff[i_]), (PG8_LAS unsigned*)(lds + L_K + (buf) * SHM_K + ldsw + i_ * 8192), 16, 0, 0); \
        _Pragma("unroll") for (int i_ = 0; i_ < 2; ++i_) __builtin_amdgcn_global_load_lds((const unsigned*)(vv_ + voff[i_]), (PG8_LAS unsigned*)(lds + L_V + (buf) * SHM_V + ldsw + i_ * 8192), 16, 0, 0); } while (0)
    ATT_DMA(0, 0);
    const bf16_t* Qw = T.QC + (size_t)(b * SEQ + qb * 256 + wid * 32 + r32) * 768 + hh * QKD + hi * 8;
    bf16x8 qr[12];
#pragma unroll
    for (int d0 = 0; d0 < 12; ++d0) qr[d0] = *(const bf16x8*)(Qw + d0 * 16);
    {
        float ssn = 0.f, ssp = 0.f;
#pragma unroll
        for (int d0 = 0; d0 < 12; ++d0) { float f[8]; unpack8(__builtin_bit_cast(u32x4, qr[d0]), f); float t = 0.f;
#pragma unroll
            for (int j = 0; j < 8; ++j) t += f[j] * f[j];
            if (d0 < 8) ssn += t; else ssp += t; }
        ssn = swap_add32(ssn, ssn); ssp = swap_add32(ssp, ssp);
        const float rn = rsqrtf(ssn * (1.f / NOPE) + EPS) * SCL2, rp = rsqrtf(ssp * (1.f / ROPE) + EPS) * SCL2;
#pragma unroll
        for (int d0 = 0; d0 < 8; ++d0) { float f[8]; unpack8(__builtin_bit_cast(u32x4, qr[d0]), f);
            const f32x4 g0 = *(const f32x4*)(T.qn_nope + d0 * 16 + hi * 8), g1 = *(const f32x4*)(T.qn_nope + d0 * 16 + hi * 8 + 4);
            f[0] *= rn * g0.x; f[1] *= rn * g0.y; f[2] *= rn * g0.z; f[3] *= rn * g0.w; f[4] *= rn * g1.x; f[5] *= rn * g1.y; f[6] *= rn * g1.z; f[7] *= rn * g1.w;
            qr[d0] = __builtin_bit_cast(bf16x8, pack8(f)); }
        const int pos = qb * 256 + wid * 32 + r32 + NMETA;
#pragma unroll
        for (int dd = 0; dd < 2; ++dd) { float x1[8], x2[8]; unpack8(__builtin_bit_cast(u32x4, qr[8 + dd]), x1); unpack8(__builtin_bit_cast(u32x4, qr[10 + dd]), x2);
            const int c0 = dd * 16 + hi * 8;
#pragma unroll
            for (int j = 0; j < 8; ++j) { const float y1 = x1[j] * rp * T.qn_pe[c0 + j], y2 = x2[j] * rp * T.qn_pe[c0 + j + 32];
                const float cs = T.RT[(pos * RH + c0 + j) * 2], sn = T.RT[(pos * RH + c0 + j) * 2 + 1];
                x1[j] = y1 * cs - y2 * sn; x2[j] = y2 * cs + y1 * sn; }
            qr[8 + dd] = __builtin_bit_cast(bf16x8, pack8(x1)); qr[10 + dd] = __builtin_bit_cast(bf16x8, pack8(x2)); }
    }
    float m_reg = -1e30f, l_reg = 0.f; f32x16 o[4] = {};
    PG8_LAS float* wsf = (PG8_LAS float*)(lds + L_WS) + wid * 64;
    const lptr K_lds = (lptr)(lds + L_K);
    const int vb0 = (int)(uintptr_t)(lds + L_V) + v_rd_base(lane);
    asm volatile("s_waitcnt vmcnt(0)" ::: "memory"); __builtin_amdgcn_s_barrier(); asm volatile("" ::: "memory");
#define ATT_TILE(KB, t) do { if ((t) + 1 < NT) ATT_DMA((t) + 1, 1 - (KB)); \
        if ((t) <= last_act) { f32x16 p0, p1; qkt<KB>(p0, p1, K_lds, r32, hi, qr); \
            if ((t) == 0) { const float NEG = -__builtin_inff(); _Pragma("unroll") for (int r = 0; r < 16; ++r) { if (crow(r, hi) >= NMETA) p0[r] = NEG; p1[r] = NEG; } } \
            float alpha; partialSM(p0, p1, m_reg, alpha); \
            if (__any(alpha < 1.f)) { if (hi == 0) wsf[r32] = alpha; asm volatile("s_waitcnt lgkmcnt(0)" ::: "memory"); \
                _Pragma("unroll") for (int d_ = 0; d_ < 4; ++d_) _Pragma("unroll") for (int r = 0; r < 16; ++r) o[d_][r] *= wsf[crow(r, hi)]; } \
            bf16x8 pa0, pa1, pa2, pa3; finishSM(p0, p1, alpha, l_reg, pa0, pa1, pa2, pa3); __builtin_amdgcn_sched_barrier(0); \
            pv_tile<KB>(o, vb0, pa0, pa1, pa2, pa3); } \
        asm volatile("s_waitcnt vmcnt(0) lgkmcnt(0)" ::: "memory"); __builtin_amdgcn_s_barrier(); asm volatile("" ::: "memory"); } while (0)
    for (int t = 0; t < NT; t += 2) { ATT_TILE(0, t); if (t + 1 < NT) ATT_TILE(1, t + 1); }
#undef ATT_TILE
#undef ATT_DMA
    if (hi == 0) wsf[32 + r32] = l_reg; asm volatile("s_waitcnt lgkmcnt(0)" ::: "memory");
    bf16_t* Ow = T.YA + (size_t)(b * SEQ + qb * 256 + wid * 32) * D + (round * 4 + hh) * 128;
#pragma unroll
    for (int r = 0; r < 16; ++r) { const int orow = crow(r, hi); const float rl = __builtin_amdgcn_rcpf(wsf[32 + orow]);
#pragma unroll
        for (int d0 = 0; d0 < 4; ++d0) { const float v = o[d0][r] * rl, vn = dpp_f<0xB1>(v);
            if ((r32 & 1) == 0) *(unsigned*)(Ow + (size_t)orow * D + d0 * 32 + r32) = cvtpk(v, vn); } }
    asm volatile("s_waitcnt lgkmcnt(0)" ::: "memory"); __builtin_amdgcn_s_barrier(); asm volatile("" ::: "memory");
}
__device__ __forceinline__ void attn_phase(PG8_LAS unsigned char* lds, const Tens& T, int round, int G, int c, int wv) {
    for (int p = c; p < 256; p += G) {
        const int xcd = p & 7, j = p >> 3, x = j & 3, g = (j >> 2) * 8 + xcd, b = g >> 2, hh = g & 3;
        attn_unit(lds, T, b, hh, 7 - x, round, wv);
        attn_unit(lds, T, b, hh, x, round, wv);
    }
}
__device__ __forceinline__ void attn_phase_dyn(PG8_LAS unsigned char* lds, const Tens& T, int round, unsigned* ticket, volatile PG8_LAS unsigned* slot, int wv) {
    for (;;) {
        if (wv == 0 && lane_id() == 0) *slot = __hip_atomic_fetch_add(ticket, 1u, __ATOMIC_RELAXED, __HIP_MEMORY_SCOPE_AGENT);
        __syncthreads();
        const int u = (int)*slot;
        if (u >= 512) break;
        attn_unit(lds, T, (u & 63) >> 2, u & 3, 7 - (u >> 6), round, wv);
    }
}
}


namespace peer {
typedef _Float16 h2 __attribute__((ext_vector_type(2)));
__device__ __forceinline__ h2 as_h2(unsigned w) { return __builtin_bit_cast(h2, w); }
__device__ __forceinline__ void ins16(float (&t)[16], float x) {
#pragma unroll
    for (int i = 15; i >= 1; --i) t[i] = __builtin_amdgcn_fmed3f(t[i - 1], t[i], x);
    t[0] = fmaxf(t[0], x);
}
constexpr int TK_WAVE_LDS = 16384;
__device__ __forceinline__ void topk64(PG8_LAS float* wl, const bf16_t* __restrict__ S, const float* __restrict__ SSQ, int* __restrict__ IDX, float* __restrict__ GATE, int m0, int hd, bool tile, int lane) {
    {
        float ta[16], tb[16];
#pragma unroll
        for (int p = 0; p < 2; ++p) {
            float t[16];
#pragma unroll
            for (int i = 0; i < 16; ++i) t[i] = -__builtin_inff();
#pragma unroll 1
            for (int q = 0; q < 2; ++q) {
                u32x4 st[8];
#pragma unroll
                for (int j = 0; j < 8; ++j) { const int list = j * 8 + (lane >> 3);
                    st[j] = *(const u32x4*)(S + (size_t)(tile ? m0 + list : m0 + (list >> 3)) * 2048 + (tile ? hd : (list & 7)) * 256 + p * 128 + q * 64 + (lane & 7) * 8); }
#pragma unroll
                for (int j = 0; j < 8; ++j) { float f[8]; unpack8(st[j], f); PG8_LAS float* wp = wl + (j * 8 + (lane >> 3)) * 64 + (lane & 7) * 8;
                    *(PG8_LAS f32x4*)wp = (f32x4){f[0], f[1], f[2], f[3]}; *(PG8_LAS f32x4*)(wp + 4) = (f32x4){f[4], f[5], f[6], f[7]}; }
                asm volatile("s_waitcnt lgkmcnt(0)" ::: "memory");
#pragma unroll 8
                for (int i = 0; i < 64; ++i) { const int e = (i + lane) & 63; const float x = wl[lane * 64 + e];
                    ins16(t, __uint_as_float((__float_as_uint(x) & ~127u) | (unsigned)(q * 64 + e))); }
                asm volatile("s_waitcnt lgkmcnt(0)" ::: "memory");
            }
#pragma unroll
            for (int i = 0; i < 16; ++i) { if (p == 0) ta[i] = t[i]; else tb[i] = t[i]; }
        }
        PG8_LAS int* wi = (PG8_LAS int*)wl + lane * 33;
#pragma unroll
        for (int i = 0; i < 16; ++i) { wi[i] = (int)(__float_as_uint(ta[i]) & 127u); wi[16 + i] = (int)(__float_as_uint(tb[i]) & 127u);
            ta[i] = __uint_as_float(__float_as_uint(ta[i]) & ~127u); tb[i] = __uint_as_float(__float_as_uint(tb[i]) & ~127u); }
        float tc[16];
#pragma unroll
        for (int i = 0; i < 16; ++i) tc[i] = -__builtin_inff();
#pragma unroll
        for (int i = 0; i < 16; ++i)
#pragma unroll
            for (int j = 0; j < 16; ++j) if ((i + 1) * (j + 1) <= 16) ins16(tc, __uint_as_float((__float_as_uint(ta[i] + tb[j]) & ~255u) | (unsigned)(i * 16 + j)));
        asm volatile("s_waitcnt lgkmcnt(0)" ::: "memory");
        float g[16]; int id[16]; float sum = 0.f;
        const float mx = __uint_as_float(__float_as_uint(tc[0]) & ~255u);
        const int mtok = tile ? m0 + lane : m0 + (lane >> 3), mhd = tile ? hd : (lane & 7);
        float r2; { const float* sp = SSQ + (size_t)mtok * 32; float t = 0.f;
#pragma unroll
            for (int i = 0; i < 8; ++i) { const f32x4 q = *(const f32x4*)(sp + 4 * i); t += (q.x + q.y) + (q.z + q.w); }
            r2 = rsqrtf(t * (1.f / D) + EPS); }
#pragma unroll
        for (int k = 0; k < 16; ++k) { const unsigned key = __float_as_uint(tc[k]); const int pos = (int)(key & 255u);
            id[k] = wi[pos >> 4] * 128 + wi[16 + (pos & 15)]; g[k] = __expf((__uint_as_float(key & ~255u) - mx) * r2); sum += g[k]; }
        const float inv = 1.f / sum;
        const size_t o = ((size_t)mtok * 8 + mhd) * 16;
#pragma unroll
        for (int k = 0; k < 16; k += 4) { *(f32x4*)(GATE + o + k) = (f32x4){g[k] * inv, g[k + 1] * inv, g[k + 2] * inv, g[k + 3] * inv};
            *(u32x4*)(IDX + o + k) = (u32x4){(unsigned)id[k], (unsigned)id[k + 1], (unsigned)id[k + 2], (unsigned)id[k + 3]}; }
        asm volatile("s_waitcnt lgkmcnt(0)" ::: "memory");
    }
}
constexpr float PEER_SU = 94.4f, PEER_SV = 5.883f;
struct __attribute__((packed, aligned(4))) U3 { unsigned x, y, z; };
typedef unsigned u32x6 __attribute__((ext_vector_type(6)));
typedef float f32x32 __attribute__((ext_vector_type(32)));
typedef float f32x2 __attribute__((ext_vector_type(2)));
__device__ __forceinline__ float gelu_erf(float x) {
    const float z = fabsf(x) * 0.70710678118654752f, t = __builtin_amdgcn_rcpf(fmaf(0.3275911f, z, 1.f));
    const float pl = t * fmaf(t, fmaf(t, fmaf(t, fmaf(t, 1.061405429f, -1.453152027f), 1.421413741f), -0.284496736f), 0.254829592f);
    const float e = 1.f - pl * __expf(-z * z);
    return 0.5f * x * (1.f + (x < 0.f ? -e : e));
}
__device__ __forceinline__ int row3(int idx) { int t; asm("v_lshl_add_u32 %0, %1, 1, %1" : "=v"(t) : "v"(idx)); return t << 8; }
__device__ __forceinline__ void gather1s_phase(PG8_LAS unsigned char* lds, const bf16_t* __restrict__ HN, const int* __restrict__ IDX, const float* __restrict__ GATE, const unsigned char* __restrict__ U8, const unsigned char* __restrict__ V8, const float* __restrict__ SSQ, float* out, int G, int c, int wv) {
    int tid_ = wv * 64 + lane_id(); asm volatile("" : "+v"(tid_));
    const int lane = tid_ & 63, wid = wv;
    typedef unsigned u32x2_ __attribute__((ext_vector_type(2)));
    PG8_LAS u32x2_* LW = (PG8_LAS u32x2_*)(lds + wid * 2048);
#pragma unroll
    for (int i = 0; i < 4; ++i) LW[64 * i + lane] = (u32x2_){0u, 0u};
    const int m0 = c * 8 + wid, mstep = G * 8, l12 = 12 * lane, l8 = 8 * lane;
    if (m0 >= M) return;
#define LOAD_TOK(mm, lane) do { pi0 = IDX[(size_t)(mm) * 128 + lane]; pi1 = IDX[(size_t)(mm) * 128 + 64 + lane]; pg0 = GATE[(size_t)(mm) * 128 + lane]; pg1 = GATE[(size_t)(mm) * 128 + 64 + lane]; } while (0)
#define LOAD_HN(mm, lane) do { hp0 = *(const u32x4*)(HN + (size_t)(mm) * D + 16 * lane); hp1 = *(const u32x4*)(HN + (size_t)(mm) * D + 16 * lane + 8); pss = lane < 32 ? SSQ[(size_t)(mm) * 32 + lane] : 0.f; } while (0)
#define BUILD_LIST(base) do { const int i0_ = pi0, i1_ = pi1; const float g0_ = pg0, g1_ = pg1; \
          int cnt = (base); \
          _Pragma("unroll 1") for (int sl = 0; sl < 16; ++sl) { \
              const bool q0 = (i0_ >> 10) == sl, q1 = (i1_ >> 10) == sl; const unsigned long long k0 = __ballot(q0), k1 = __ballot(q1); \
              if (q0) LW[cnt + (int)__builtin_amdgcn_mbcnt_hi((unsigned)(k0 >> 32), __builtin_amdgcn_mbcnt_lo((unsigned)k0, 0u))] = (u32x2_){(unsigned)i0_, __float_as_uint(g0_)}; \
              cnt += __builtin_popcountll(k0); \
              if (q1) LW[cnt + (int)__builtin_amdgcn_mbcnt_hi((unsigned)(k1 >> 32), __builtin_amdgcn_mbcnt_lo((unsigned)k1, 0u))] = (u32x2_){(unsigned)i1_, __float_as_uint(g1_)}; \
              cnt += __builtin_popcountll(k1); } \
          asm volatile("s_waitcnt lgkmcnt(0)" ::: "memory"); } while (0)
#define LOAD_ROWS(dst, TAB, e) do { _Pragma("unroll") for (int j = 0; j < 8; ++j) dst[j] = *(const U3*)(TAB + (size_t)(unsigned)(row3((int)LW[(e) + j].x) + l12)); asm volatile("" ::: "memory"); } while (0)
    int pi0, pi1; float pg0, pg1, pss; u32x4 hp0, hp1;
    LOAD_TOK(m0, lane); BUILD_LIST(0); LOAD_HN(m0, lane);
    if (m0 + mstep < M) LOAD_TOK(m0 + mstep, lane);
    #define LOAD_ROWS4(dst, TAB, e) do { _Pragma("unroll") for (int j = 0; j < 8; ++j) dst[j] = *(const u32x2_*)(TAB + (size_t)(unsigned)(__mul24((int)LW[(e) + j].x, 512) + l8)); asm volatile("" ::: "memory"); } while (0)
    u32x2_ ub0[8], ub1[8], vb0[8], vb1[8];
    LOAD_ROWS4(ub0, U8, 0); LOAD_ROWS4(vb0, V8, 0); LOAD_ROWS4(ub1, U8, 8); LOAD_ROWS4(vb1, V8, 8);
    int ring = 0;
#pragma unroll 1
    for (int m = m0; m < M; m += mstep) {
        f32x2 hn[8], acc[8]; unsigned hq1[2], hq2[2]; float hs1, hs2;
        int ln = lane; asm volatile("" : "+v"(ln));
        const float ssq = pss;
        { float f[16]; unpack8(hp0, f); unpack8(hp1, f + 8);
#pragma unroll
          for (int i = 0; i < 8; ++i) { hn[i] = (f32x2){f[2 * i], f[2 * i + 1]}; acc[i] = (f32x2){0.f, 0.f}; }
          float am = 0.f;
#pragma unroll
          for (int i = 0; i < 16; ++i) am = fmaxf(am, fabsf(f[i]));
          { const u32x2 r_ = __builtin_amdgcn_permlane32_swap(__float_as_uint(am), __float_as_uint(am), false, false); am = fmaxf(__uint_as_float(r_.x), __uint_as_float(r_.y)); }
          { const u32x2 r_ = __builtin_amdgcn_permlane16_swap(__float_as_uint(am), __float_as_uint(am), false, false); am = fmaxf(__uint_as_float(r_.x), __uint_as_float(r_.y)); }
          am = fmaxf(am, dpp_f<0x128>(am)); am = fmaxf(am, dpp_f<0xB1>(am)); am = fmaxf(am, dpp_f<0x4E>(am)); am = fmaxf(am, dpp_f<0x141>(am));
          hs1 = fmaxf(am, 1e-20f) * (1.f / 7.5f); hs2 = hs1 * (1.f / 16.f); const float i1_ = 1.f / hs1, i2_ = 1.f / hs2;
          hq1[0] = hq1[1] = hq2[0] = hq2[1] = 0u;
#pragma unroll
          for (int i = 0; i < 16; ++i) { const float q1 = fminf(fmaxf(__builtin_rintf(f[i] * i1_), -8.f), 7.f), rr = f[i] - q1 * hs1, q2 = fminf(fmaxf(__builtin_rintf(rr * i2_), -8.f), 7.f);
              hq1[i >> 3] |= ((unsigned)(int)q1 & 15u) << (4 * (i & 7)); hq2[i >> 3] |= ((unsigned)(int)q2 & 15u) << (4 * (i & 7)); } }
        float sq = swap_add16(swap_add32(ssq, ssq), swap_add32(ssq, ssq)); sq += dpp_f<0x128>(sq); sq += dpp_f<0xB1>(sq); sq += dpp_f<0x4E>(sq); sq += dpp_f<0x141>(sq);
        const float r2su = rsqrtf(sq * (1.f / D) + EPS) * (1.f / PEER_SU);
        if (m + mstep < M) { BUILD_LIST(ring ^ 128); LOAD_HN(m + mstep, ln); if (m + 2 * mstep < M) LOAD_TOK(m + 2 * mstep, ln); }
#define F4ACC(vb, b) { acc[4 * w + b] = __builtin_elementwise_fma((f32x2){a, a}, __builtin_amdgcn_cvt_scalef32_pk_f32_fp4(vb[j][w], 1.0f, b), acc[4 * w + b]); }
#define ACC_ROWS(vb, ap, j0, j1) do { _Pragma("unroll") for (int j = j0; j < j1; ++j) { const float a = __builtin_bit_cast(float, __builtin_amdgcn_readlane(__builtin_bit_cast(int, ap), j * 8)); \
                _Pragma("unroll") for (int w = 0; w < 2; ++w) { F4ACC(vb, 0) F4ACC(vb, 1) F4ACC(vb, 2) F4ACC(vb, 3) } } } while (0)
#define DOT8(ub, d) do { _Pragma("unroll") for (int j = 0; j < 8; ++j) {     \
                const int d1_ = __builtin_amdgcn_sdot8((int)ub[j].y, (int)hq1[1], __builtin_amdgcn_sdot8((int)ub[j].x, (int)hq1[0], 0, false), false); \
                const int d2_ = __builtin_amdgcn_sdot8((int)ub[j].y, (int)hq2[1], __builtin_amdgcn_sdot8((int)ub[j].x, (int)hq2[0], 0, false), false); \
                d[j] = fmaf((float)d2_, hs2, (float)d1_ * hs1); } } while (0)
#define GSTEP(ub, vb, k, HAVE_PREV) do { const int e0 = ring + (k) * 8, e2 = (e0 + 16) & 255, e1 = (e0 + 8) & 255; \
            float d[8]; DOT8(ub, d); \
            asm volatile("" ::: "memory"); \
            LOAD_ROWS4(ub, U8, e2); \
            float s4[4], s2[2], s1; \
            if (HAVE_PREV) ACC_ROWS(vb, actp, 0, 1); \
            _Pragma("unroll") for (int j = 0; j < 4; ++j) s4[j] = swap_add32(d[j], d[j + 4]); \
            if (HAVE_PREV) ACC_ROWS(vb, actp, 1, 2); \
            _Pragma("unroll") for (int j = 0; j < 2; ++j) s2[j] = swap_add16(s4[j], s4[j + 2]); \
            if (HAVE_PREV) ACC_ROWS(vb, actp, 2, 3); \
            { const bool up = lane & 8; const float keep = up ? s2[1] : s2[0], send = up ? s2[0] : s2[1]; s1 = keep + dpp_f<0x128>(send); } \
            if (HAVE_PREV) ACC_ROWS(vb, actp, 3, 4); \
            s1 += dpp_f<0xB1>(s1); s1 += dpp_f<0x4E>(s1); s1 += dpp_f<0x141>(s1); \
            s1 *= r2su; \
            if (HAVE_PREV) ACC_ROWS(vb, actp, 4, 5); \
            const float actn = gelu_erf(s1) * __uint_as_float(LW[e0 + (lane >> 3)].y) * (1.f / PEER_SV); \
            if (HAVE_PREV) { ACC_ROWS(vb, actp, 5, 8); \
                asm volatile("" ::: "memory"); \
                LOAD_ROWS4(vb, V8, e1); } \
            actp = actn; \
        } while (0)
        float actp;
        GSTEP(ub0, vb1, 0, false);
#pragma unroll 1
        for (int k = 1; k < 15; k += 2) { GSTEP(ub1, vb0, k, true); GSTEP(ub0, vb1, k + 1, true); }
        GSTEP(ub1, vb0, 15, true);
        ACC_ROWS(vb1, actp, 0, 8);
        asm volatile("" ::: "memory");
        LOAD_ROWS4(vb1, V8, (ring + 136) & 255);
#undef GSTEP
#undef DOT8
#undef ACC_ROWS
#undef F4ACC
        int lo_ = lane; asm volatile("" : "+v"(lo_));
        float* o = out + (size_t)m * D + 16 * lo_;
#pragma unroll
        for (int i = 0; i < 4; ++i) *(f32x4*)(o + 4 * i) = (f32x4){hn[2 * i].x + acc[2 * i].x, hn[2 * i].y + acc[2 * i].y, hn[2 * i + 1].x + acc[2 * i + 1].x, hn[2 * i + 1].y + acc[2 * i + 1].y};
        ring ^= 128;
    }
#undef LOAD_ROWS
#undef LOAD_ROWS4
#undef BUILD_LIST
#undef LOAD_TOK
#undef LOAD_HN
    asm volatile("s_waitcnt lgkmcnt(0)" ::: "memory");
}
}
namespace gla {
#define LDS_BARRIER() do { asm volatile("s_waitcnt lgkmcnt(0)" ::: "memory"); __builtin_amdgcn_s_barrier(); asm volatile("" ::: "memory"); } while (0)
typedef short bf16x8 __attribute__((ext_vector_type(8)));
typedef float f32x16 __attribute__((ext_vector_type(16)));
__device__ __forceinline__ int chunk_row0(int b, int c) { return c == 0 ? M : b * SEQ + 64 * (c - 1); }
__device__ __forceinline__ int ppos(int d) { const int g = (d >> 2) & 3; return (d & ~12) | ((g == 1 ? 2 : (g == 2 ? 1 : g)) << 2); }
__device__ __forceinline__ unsigned cvtpk(float lo, float hi) { unsigned r; asm volatile("v_cvt_pk_bf16_f32 %0, %1, %2" : "=v"(r) : "v"(lo), "v"(hi)); return r; }
struct Tens { bf16_t* GQ; bf16_t* GKT; const bf16_t* GVT; bf16_t* GQo; bf16_t* GKTo; int var; const bf16_t* P0; const float* w_a2; const float* b_a; bf16_t* AG; float* DECL; bf16_t* OG; };
constexpr int PQROW = 136;
constexpr int BMROW = 132;
constexpr int P_GAL = 0, P_TOT = 2048, P_BM = 4096, P_QL = P_BM + 64 * BMROW * 4, P_KL = P_QL + 64 * PQROW * 2, P_END = P_KL + 64 * PQROW * 2;
struct PrepIn { u32x4 ga, kt0, kt1, q0, q1; };
__device__ __forceinline__ void prep_load(PrepIn& I, const Tens& T, int u, int tid) {
    const int b = u / 132, h = (u / 33) & 3, c = u % 33, row0 = chunk_row0(b, c), d = tid & 127, jq = tid >> 7, j = tid >> 3, c16 = tid & 7;
    I.ga = tid < 128 ? *(const u32x4*)(T.P0 + (size_t)(row0 + (tid >> 1)) * P0W + 704 + (tid & 1) * 8) : (u32x4){0u, 0u, 0u, 0u};
    const bf16_t* kt = T.GKT + (size_t)(h * GHK + d) * ME + row0 + jq * 16; I.kt0 = *(const u32x4*)kt; I.kt1 = *(const u32x4*)(kt + 8);
    const size_t g = (size_t)(row0 + j) * GDK + h * GHK + c16 * 16;
    I.q0 = *(const u32x4*)(T.GQ + g); I.q1 = *(const u32x4*)(T.GQ + g + 8);
}
__device__ __forceinline__ void prep_compute(PG8_LAS unsigned char* lds, const Tens& T, const PrepIn& I, const float (&w)[GR], float ba, int u, int tid, int wid, int lane) {
    const int b = u / 132, h = (u / 33) & 3, c = u % 33, row0 = chunk_row0(b, c), d = tid & 127, jq = tid >> 7, j = tid >> 3, c16 = tid & 7;
    PG8_LAS bf16_t* GAL = (PG8_LAS bf16_t*)(lds + P_GAL); PG8_LAS float* TOT = (PG8_LAS float*)(lds + P_TOT); PG8_LAS float* BM = (PG8_LAS float*)(lds + P_BM);
    PG8_LAS bf16_t* QL = (PG8_LAS bf16_t*)(lds + P_QL); PG8_LAS bf16_t* KL = (PG8_LAS bf16_t*)(lds + P_KL);
    if (tid < 128) *(PG8_LAS u32x4*)(GAL + (tid >> 1) * 16 + (tid & 1) * 8) = I.ga;
    LDS_BARRIER();
    float Bv[16]; float run = 0.f;
#pragma unroll
    for (int jj = 0; jj < 16; ++jj) { const int jt = jq * 16 + jj; float x = ba;
        const u32x4 g0 = *(const PG8_LAS u32x4*)(GAL + jt * 16), g1 = *(const PG8_LAS u32x4*)(GAL + jt * 16 + 8); float gf[16]; unpack8(g0, gf); unpack8(g1, gf + 8);
#pragma unroll
        for (int r = 0; r < GR; ++r) x += gf[r] * w[r];
        float la = (fminf(x, 0.f) - __logf(1.f + __expf(-fabsf(x)))) * (1.f / 16.f);
        if (c == 0 && jt >= NMETA) la = 0.f;
        run += la; Bv[jj] = run; }
    TOT[jq * 128 + d] = run;
    LDS_BARRIER();
    float base = 0.f, blast = 0.f;
#pragma unroll
    for (int g = 0; g < 4; ++g) { const float t = TOT[g * 128 + d]; blast += t; if (g < jq) base += t; }
#pragma unroll
    for (int jj = 0; jj < 16; ++jj) BM[(jq * 16 + jj) * BMROW + d] = base + Bv[jj];
    { float kf[16]; unpack8(I.kt0, kf); unpack8(I.kt1, kf + 8);
      const int pd = ppos(d);
#pragma unroll
      for (int jj = 0; jj < 16; ++jj) { const float e = __expf(-(base + Bv[jj])); KL[(jq * 16 + jj) * PQROW + pd] = f2bf(kf[jj] * e); kf[jj] *= e * __expf(blast); }
      bf16_t* kto = T.GKTo + (size_t)(h * GHK + d) * ME + row0 + jq * 16; if (T.var == 0) { *(u32x4*)kto = pack8(kf); *(u32x4*)(kto + 8) = pack8(kf + 8); } else if (kf[3] == 1.2345f) T.DECL[1] = 1.f; }
    if (jq == 0) T.DECL[(size_t)u * GHK + d] = __expf(blast);
    LDS_BARRIER();
    {
        float qf[16], bv[16]; unpack8(I.q0, qf); unpack8(I.q1, qf + 8);
#pragma unroll
        for (int i = 0; i < 4; ++i) { const f32x4 t = *(const PG8_LAS f32x4*)(BM + j * BMROW + c16 * 16 + 4 * i); bv[4 * i] = t.x; bv[4 * i + 1] = t.y; bv[4 * i + 2] = t.z; bv[4 * i + 3] = t.w; }
        float qo[16];
#pragma unroll
        for (int i = 0; i < 16; ++i) { const int p = (i & 3) | ((((i >> 2) == 1) ? 2 : ((i >> 2) == 2 ? 1 : (i >> 2))) << 2); qo[p] = qf[i] * GLA_QS * __expf(bv[i]); }
        const u32x4 qa = pack8(qo), qb = pack8(qo + 8);
        *(PG8_LAS u32x4*)(QL + j * PQROW + c16 * 16) = qa; *(PG8_LAS u32x4*)(QL + j * PQROW + c16 * 16 + 8) = qb;
        bf16_t* go = T.GQo + (size_t)(row0 + j) * GDK + h * GHK + c16 * 16; if (T.var == 0) { *(u32x4*)go = qa; *(u32x4*)(go + 8) = qb; } }
    LDS_BARRIER();
    { const int bi = wid >> 1, fr = lane & 15, fq = lane >> 4;
#pragma unroll
      for (int t = 0; t < 2; ++t) { const int bj = 2 * (wid & 1) + t; f32x4 acc = {0.f, 0.f, 0.f, 0.f};
#pragma unroll
        for (int s_ = 0; s_ < 4; ++s_) { const bf16x8 af = *(const PG8_LAS bf16x8*)(QL + (16 * bi + fr) * PQROW + 32 * s_ + 8 * fq), bf = *(const PG8_LAS bf16x8*)(KL + (16 * bj + fr) * PQROW + 32 * s_ + 8 * fq);
            acc = __builtin_amdgcn_mfma_f32_16x16x32_bf16(af, bf, acc, 0, 0, 0); }
#pragma unroll
        for (int r = 0; r < 4; ++r) { const int i = 16 * bi + fq * 4 + r, jc = 16 * bj + fr; if (T.var == 0) T.AG[((size_t)u * 64 + i) * 64 + jc] = f2bf(jc <= i ? acc[r] : 0.f); else if (acc[r] == 1.2345f) T.DECL[2] = 1.f; } } }
    LDS_BARRIER();
}
__device__ __forceinline__ int prep_unit_id(int k) { return k < NB * 4 * 32 ? (k >> 5) * 33 + 1 + (k & 31) : (k - NB * 4 * 32) * 33; }
__device__ __forceinline__ void prep_phase(PG8_LAS unsigned char* lds, const Tens& T, int G, int c, int wv) {
    int tid_ = wv * 64 + lane_id(); asm volatile("" : "+v"(tid_));
    const int tid = tid_, lane = tid & 63, wid = wv; constexpr int NK = NB * 4 * 32 + 4;
    if (c >= NK) return;
    PrepIn cur, nxt; prep_load(cur, T, prep_unit_id(c), tid);
    float w[GR], ba = 0.f; int hcur = -1;
#pragma unroll 1
    for (int k = c; k < NK; k += G) {
        const bool more = k + G < NK; const int u = prep_unit_id(k), h = (u / 33) & 3;
        if (more) prep_load(nxt, T, prep_unit_id(k + G), tid);
        if (h != hcur) { hcur = h; const int d = tid & 127;
#pragma unroll
            for (int r = 0; r < GR; ++r) w[r] = T.w_a2[r * GDK + h * GHK + d];
            ba = T.b_a[h * GHK + d]; }
        prep_compute(lds, T, cur, w, ba, u, tid, wid, lane);
        if (more) cur = nxt;
    }
}
constexpr int S_Q = 0, S_A = 64 * 272, S_K = S_A + 64 * 144, S_D = S_K + 128 * 144, S_BUF = S_D + 512;
__device__ __forceinline__ void scan_wg(PG8_LAS unsigned char* lds, const Tens& T, int b, int h, int wv) {
    int tid_ = wv * 64 + lane_id(); asm volatile("" : "+v"(tid_));
    const int tid = tid_, wid = __builtin_amdgcn_readfirstlane(tid >> 6), lane = tid & 63, r32 = lane & 31, hi = lane >> 5;
    f32x16 S[4];
#pragma unroll
    for (int i = 0; i < 4; ++i) S[i] = f32x16{};
    const int u0 = (b * 4 + h) * 33;
    u32x4 sq[2], sa, sk[2]; float sd = 0.f; bf16x8 vcur[4], vnxt[4];
    const bf16_t* vrow = T.GVT + (size_t)(h * GHV + 32 * wid + r32) * ME + 8 * hi;
#define GLA_LOAD(c_) do { const int row0_ = chunk_row0(b, (c_)); \
        _Pragma("unroll") for (int i = 0; i < 2; ++i) { const int ch = tid + i * 512; sq[i] = *(const u32x4*)(T.GQ + (size_t)(row0_ + (ch >> 4)) * GDK + h * GHK + (ch & 15) * 8); \
            sk[i] = *(const u32x4*)(T.GKT + (size_t)(h * GHK + (ch >> 3)) * ME + row0_ + (ch & 7) * 8); } \
        const int uc_ = (c_) == 0 ? h * 33 : u0 + (c_); sa = *(const u32x4*)(T.AG + ((size_t)uc_ * 64 + (tid >> 3)) * 64 + (tid & 7) * 8); if (tid < 128) sd = T.DECL[(size_t)uc_ * GHK + tid]; \
        _Pragma("unroll") for (int s_ = 0; s_ < 4; ++s_) vnxt[s_] = *(const bf16x8*)(vrow + row0_ + 16 * s_); } while (0)
#define GLA_WRITE(buf) do { PG8_LAS unsigned char* L_ = lds + (buf) * S_BUF; \
        _Pragma("unroll") for (int i = 0; i < 2; ++i) { const int ch = tid + i * 512; *(PG8_LAS u32x4*)(L_ + S_Q + (ch >> 4) * 272 + (ch & 15) * 16) = sq[i]; *(PG8_LAS u32x4*)(L_ + S_K + (ch >> 3) * 144 + (ch & 7) * 16) = sk[i]; } \
        *(PG8_LAS u32x4*)(L_ + S_A + (tid >> 3) * 144 + (tid & 7) * 16) = sa; if (tid < 128) *(PG8_LAS float*)(L_ + S_D + tid * 4) = sd; } while (0)
    GLA_LOAD(0); GLA_WRITE(0);
#pragma unroll
    for (int s_ = 0; s_ < 4; ++s_) vcur[s_] = vnxt[s_];
    LDS_BARRIER();
#pragma unroll 1
    for (int c = 0; c < 33; ++c) {
        if (c + 1 < 33) GLA_LOAD(c + 1);
        PG8_LAS unsigned char* L = lds + (c & 1) * S_BUF;
        f32x16 o[2];
#pragma unroll
        for (int ib = 0; ib < 2; ++ib) { o[ib] = f32x16{};
#pragma unroll
            for (int s_ = 0; s_ < 4; ++s_) { const bf16x8 af = *(const PG8_LAS bf16x8*)(L + S_A + (32 * ib + r32) * 144 + (16 * s_ + 8 * hi) * 2);
                o[ib] = __builtin_amdgcn_mfma_f32_32x32x16_bf16(af, vcur[s_], o[ib], 0, 0, 0); } }
#pragma unroll
        for (int s_ = 0; s_ < 8; ++s_) { const int db = s_ >> 1, t8 = 8 * (s_ & 1);
            u32x4 wv; wv.x = cvtpk(S[db][t8 + 0], S[db][t8 + 1]); wv.y = cvtpk(S[db][t8 + 2], S[db][t8 + 3]); wv.z = cvtpk(S[db][t8 + 4], S[db][t8 + 5]); wv.w = cvtpk(S[db][t8 + 6], S[db][t8 + 7]);
            const bf16x8 sf = __builtin_bit_cast(bf16x8, wv);
#pragma unroll
            for (int ib = 0; ib < 2; ++ib) { const bf16x8 qf = *(const PG8_LAS bf16x8*)(L + S_Q + (32 * ib + r32) * 272 + (16 * s_ + 8 * hi) * 2);
                o[ib] = __builtin_amdgcn_mfma_f32_32x32x16_bf16(qf, sf, o[ib], 0, 0, 0); } }
        if (c > 0) { bf16_t* Ow = T.OG + (size_t)chunk_row0(b, c) * D + h * GHV + 32 * wid;
#pragma unroll
            for (int ib = 0; ib < 2; ++ib)
#pragma unroll
                for (int r = 0; r < 16; ++r) { const int orow = 32 * ib + (r & 3) + 8 * (r >> 2) + 4 * hi; const float v = o[ib][r], vn = dpp_f<0xB1>(v);
                    if ((r32 & 1) == 0) *(unsigned*)(Ow + (size_t)orow * D + r32) = cvtpk(v, vn); } }
#pragma unroll
        for (int db = 0; db < 4; ++db) {
#pragma unroll
            for (int g = 0; g < 4; ++g) { const f32x4 dv = *(const PG8_LAS f32x4*)(L + S_D + (32 * db + 8 * g + 4 * hi) * 4);
                S[db][4 * g + 0] *= dv[0]; S[db][4 * g + 1] *= dv[1]; S[db][4 * g + 2] *= dv[2]; S[db][4 * g + 3] *= dv[3]; }
#pragma unroll
            for (int s_ = 0; s_ < 4; ++s_) { const bf16x8 kf = *(const PG8_LAS bf16x8*)(L + S_K + (32 * db + r32) * 144 + (16 * s_ + 8 * hi) * 2);
                S[db] = __builtin_amdgcn_mfma_f32_32x32x16_bf16(kf, vcur[s_], S[db], 0, 0, 0); } }
        if (c + 1 < 33) { GLA_WRITE((c + 1) & 1);
#pragma unroll
            for (int s_ = 0; s_ < 4; ++s_) vcur[s_] = vnxt[s_]; }
        LDS_BARRIER();
    }
#undef GLA_LOAD
#undef GLA_WRITE
}
}


#define XB_TMO      128
#define XB_XCNT(j)  (256  + 64 * (j))
#define XB_XSUB(j)  (1280 + 64 * (j))
#define XB_XGEN(j)  (2304 + 64 * (j))
#define XB_TOP      3328
#define XB_TOPGEN   3392
#define XCD_BAR_WORDS 3456
#define XB_SPIN_CAP (1u << 18)

__device__ __forceinline__ unsigned xb_ld(unsigned* p)              { return __hip_atomic_load(p, __ATOMIC_RELAXED, __HIP_MEMORY_SCOPE_AGENT); }
__device__ __forceinline__ unsigned xb_add(unsigned* p, unsigned v) { return __hip_atomic_fetch_add(p, v, __ATOMIC_RELAXED, __HIP_MEMORY_SCOPE_AGENT); }
__device__ __forceinline__ unsigned xb_xcc_id() { return (unsigned)__builtin_amdgcn_s_getreg((3 << 11) | 20) & 0xFu; }
#define XB_SPIN(cond, bar) do { unsigned _sp = 0; while (cond) { __builtin_amdgcn_s_sleep(1); \
    if ((++_sp & 255u) == 0u) { if (xb_ld(&(bar)[XB_TMO])) break; if (_sp > XB_SPIN_CAP) { atomicAdd(&(bar)[XB_TMO], 1u); break; } } } } while (0)

struct XcdBarrier {
    int wv;
    unsigned* bar; unsigned x;
    volatile PG8_LAS unsigned* st;
};

__device__ __forceinline__ XcdBarrier xcd_barrier_post(unsigned* bar, volatile PG8_LAS unsigned* st, int wv) {
    XcdBarrier b; b.wv = wv; b.bar = bar; b.x = xb_xcc_id(); b.st = st;
    if (wv == 0 && lane_id() == 0) (void)xb_add(&bar[XB_XCNT(b.x)], 1u);
    return b;
}
__device__ __forceinline__ void xcd_barrier_complete(unsigned* bar, unsigned x, unsigned& nloc, unsigned& nx) {
    const unsigned G = gridDim.x * gridDim.y * gridDim.z;
    unsigned sum, cnt, mine, sp = 0u;
    for (;;) {
        sum = 0u; cnt = 0u; mine = 0u;
#pragma unroll
        for (unsigned j = 0; j < 16; ++j) { const unsigned c = xb_ld(&bar[XB_XCNT(j)]); sum += c; cnt += (c > 0u) ? 1u : 0u; mine = (j == x) ? c : mine; }
        if (sum == G) break;
        __builtin_amdgcn_s_sleep(1);
        if ((++sp & 255u) == 0u) { if (xb_ld(&bar[XB_TMO])) break; if (sp > XB_SPIN_CAP) { atomicAdd(&bar[XB_TMO], 1u); break; } }
    }
    nloc = mine > 0u ? mine : 1u; nx = cnt > 0u ? cnt : 1u;
}

__device__ __forceinline__ void xcd_barrier(const XcdBarrier& b) {
    asm volatile("s_waitcnt vmcnt(0)" ::: "memory");
    __syncthreads();
    if (b.wv == 0 && lane_id() == 0) {
        unsigned* bar = b.bar;
        __builtin_amdgcn_s_waitcnt(0);
        unsigned nloc = b.st[0], nx = b.st[1];
        if (nloc == 0u) { xcd_barrier_complete(bar, b.x, nloc, nx); b.st[0] = nloc; b.st[1] = nx; }
        const unsigned old = xb_add(&bar[XB_XSUB(b.x)], 1u);
        const unsigned gen = old / nloc;
        if (old + 1u == (gen + 1u) * nloc) {
            __builtin_amdgcn_fence(__ATOMIC_RELEASE, "agent");
            asm volatile("s_waitcnt vmcnt(0)" ::: "memory");
            const unsigned og = xb_add(&bar[XB_TOP], 1u);
            const unsigned tg = og / nx;
            if (og + 1u == (tg + 1u) * nx) xb_add(&bar[XB_TOPGEN], 1u);
            else XB_SPIN(xb_ld(&bar[XB_TOPGEN]) == tg, bar);
            __builtin_amdgcn_fence(__ATOMIC_ACQUIRE, "agent");
            xb_add(&bar[XB_XGEN(b.x)], 1u);
            asm volatile("s_waitcnt vmcnt(0)" ::: "memory");
        } else {
            XB_SPIN(xb_ld(&bar[XB_XGEN(b.x)]) == gen, bar);
            __builtin_amdgcn_fence(__ATOMIC_ACQUIRE, "agent");
            asm volatile("s_waitcnt vmcnt(0)" ::: "memory");
        }
    }
    __syncthreads();
}

namespace sm {
__device__ __forceinline__ void prep_x(const float* __restrict__ x, const float* __restrict__ meta, bf16_t* __restrict__ XB, float* __restrict__ R1, int gw, int nw, int lane) {
    asm volatile("" : "+v"(lane));
    for (int r0 = gw * 4; r0 < ME; r0 += nw * 4) {
        f32x4 v[4][4];
#pragma unroll
        for (int t = 0; t < 4; ++t) { const int r = r0 + t; const float* src = r < M ? x + (size_t)r * D : (r < M + NMETA ? meta + (size_t)(r - M) * D : nullptr);
#pragma unroll
            for (int j = 0; j < 4; ++j) v[t][j] = src ? *(const f32x4*)(src + 256 * j + 4 * lane) : (f32x4){0.f, 0.f, 0.f, 0.f}; }
#pragma unroll
        for (int t = 0; t < 4; ++t) { const int r = r0 + t; float ss = 0.f;
#pragma unroll
            for (int j = 0; j < 4; ++j) ss += v[t][j].x * v[t][j].x + v[t][j].y * v[t][j].y + v[t][j].z * v[t][j].z + v[t][j].w * v[t][j].w;
            ss = wsum(ss);
            if (lane == 0) R1[r] = rsqrtf(ss * (1.f / D) + EPS);
#pragma unroll
            for (int j = 0; j < 4; ++j) { unsigned long long o = (unsigned long long)pk2(v[t][j].x, v[t][j].y) | ((unsigned long long)pk2(v[t][j].z, v[t][j].w) << 32); *(unsigned long long*)(XB + (size_t)r * D + 256 * j + 4 * lane) = o; } }
    }
}
struct WDesc { const float* src; int Nsrc, K; bf16_t* dst; int Ndst; const float* gain; int gmod, mode; };
__device__ __forceinline__ void prep_w_load(const WDesc& W, int it, float (&x)[32], int lane) {
    const int nblk = W.Ndst / 32, kb = it / nblk, nb = it % nblk, k0 = 64 * kb, n0 = 32 * nb, c = map_col(W.mode, n0 + (lane & 31)), cs = c < 0 ? 0 : c;
    const float* sp = W.src + (size_t)(k0 + (lane >> 5)) * W.Nsrc + cs; const size_t st2 = (size_t)2 * W.Nsrc;
#pragma unroll
    for (int i = 0; i < 32; ++i) x[i] = sp[i * st2];
}
__device__ __forceinline__ void prep_w_fin(const WDesc& W, int it, const float (&x)[32], PG8_LAS float* scr, int lane) {
    const int nblk = W.Ndst / 32, kb = it / nblk, nb = it % nblk, k0 = 64 * kb, n0 = 32 * nb, c = map_col(W.mode, n0 + (lane & 31));
    const int cc = lane & 7;
    f32x4 g0 = (f32x4){1.f, 1.f, 1.f, 1.f}, g1 = g0;
    if (W.gain) { const float* gp = W.gain + (k0 + 8 * cc) % W.gmod; g0 = *(const f32x4*)gp; g1 = *(const f32x4*)(gp + 4); }
#pragma unroll
    for (int i = 0; i < 32; ++i) scr[(2 * i + (lane >> 5)) * 33 + (lane & 31)] = c < 0 ? 0.f : x[i];
    asm volatile("s_waitcnt lgkmcnt(0)" ::: "memory");
#pragma unroll
    for (int j = 0; j < 4; ++j) { const int n = (lane >> 3) + 8 * j; const PG8_LAS float* p = scr + (8 * cc) * 33 + n;
        u32x4 o; o.x = pk2(p[0] * g0.x, p[33] * g0.y); o.y = pk2(p[66] * g0.z, p[99] * g0.w); o.z = pk2(p[132] * g1.x, p[165] * g1.y); o.w = pk2(p[198] * g1.z, p[231] * g1.w);
        *(u32x4*)(W.dst + (size_t)(n0 + n) * W.K + k0 + 8 * cc) = o; }
    asm volatile("s_waitcnt lgkmcnt(0)" ::: "memory");
}
struct WAll { const float *w_in, *g_in, *w_uq, *g_uq, *w_ukv, *g_ukv, *w_om, *w_og, *g_og, *w_out; bf16_t *WinT, *WuqT, *WukvT, *WomT, *WogT, *WoutT; };
__device__ __forceinline__ WDesc prep_w_pick(const WAll& A, int it, int& r) {
    constexpr int n0 = (D / 64) * (WIN_ROWS / 32), n1 = (QR / 64) * (1536 / 32), n2 = (KVR / 64) * (2048 / 32), n3 = (D / 64) * (D / 32);
    r = it;
    if (r < n0) return WDesc{A.w_in, DIN, D, A.WinT, WIN_ROWS, A.g_in, D, (int)MAP_WIN}; r -= n0;
    if (r < n1) return WDesc{A.w_uq, 1536, QR, A.WuqT, 1536, A.g_uq, QR, (int)MAP_ID}; r -= n1;
    if (r < n2) return WDesc{A.w_ukv, 2048, KVR, A.WukvT, 2048, A.g_ukv, KVR, (int)MAP_UKV}; r -= n2;
    if (r < n3) return WDesc{A.w_om, D, D, A.WomT, D, (const float*)nullptr, 1, (int)MAP_ID}; r -= n3;
    if (r < n3) return WDesc{A.w_og, D, D, A.WogT, D, A.g_og, GHV, (int)MAP_ID}; r -= n3;
    return WDesc{A.w_out, D, D, A.WoutT, D, (const float*)nullptr, 1, (int)MAP_ID};
}
__device__ __forceinline__ void prep_w_all(const WAll& A, PG8_LAS float* scr, int gw, int nw, int lane) {
    asm volatile("" : "+v"(lane));
    constexpr int NIT = (D / 64) * (WIN_ROWS / 32) + (QR / 64) * (1536 / 32) + (KVR / 64) * (2048 / 32) + 3 * (D / 64) * (D / 32);
    float xa[32], xb[32]; int ra, rb;
    if (gw < NIT) { const WDesc W = prep_w_pick(A, gw, ra); prep_w_load(W, ra, xa, lane); }
    for (int it = gw; it < NIT; it += 2 * nw) {
        const int i1 = it + nw, i2 = it + 2 * nw;
        if (i1 < NIT) { const WDesc W = prep_w_pick(A, i1, rb); prep_w_load(W, rb, xb, lane); }
        { const WDesc W = prep_w_pick(A, it, ra); prep_w_fin(W, ra, xa, scr, lane); }
        if (i2 < NIT) { const WDesc W = prep_w_pick(A, i2, ra); prep_w_load(W, ra, xa, lane); }
        if (i1 < NIT) { const WDesc W = prep_w_pick(A, i1, rb); prep_w_fin(W, rb, xb, scr, lane); }
    }
}
typedef float f32x16 __attribute__((ext_vector_type(16)));
__device__ __forceinline__ void prep_ws(const float* __restrict__ wq, const float* __restrict__ keys, const float* __restrict__ gain, bf16_t* __restrict__ WsT, int gw, int nw, int lane) {
    asm volatile("" : "+v"(lane));
    const int r = lane & 31, h = lane >> 5;
    for (int blk = gw; blk < 64 * 32; blk += nw) {
        const int n0 = (blk >> 5) * 32, k0 = (blk & 31) * 32, hp = n0 >> 7;
        const float* ap = wq + (size_t)(k0 + r) * 2048 + hp * 128 + 64 * h;
        const float* bp = keys + (size_t)(hp & 1) * 128 * 128 + (size_t)((n0 & 127) + r) * 128 + 64 * h;
        f32x4 av[16], bv[16];
#pragma unroll
        for (int i = 0; i < 16; ++i) { av[i] = *(const f32x4*)(ap + 4 * i); bv[i] = *(const f32x4*)(bp + 4 * i); }
        f32x16 c;
#pragma unroll
        for (int i = 0; i < 16; ++i) c[i] = 0.f;
#pragma unroll
        for (int i = 0; i < 16; ++i)
#pragma unroll
            for (int e = 0; e < 4; ++e) c = __builtin_amdgcn_mfma_f32_32x32x2f32(av[i][e], bv[i][e], c, 0, 0, 0);
#pragma unroll
        for (int g = 0; g < 4; ++g) {
            const int k = k0 + 8 * g + 4 * h; const f32x4 gq = *(const f32x4*)(gain + k);
            const unsigned long long o = (unsigned long long)pk2(c[4 * g] * gq.x, c[4 * g + 1] * gq.y) | ((unsigned long long)pk2(c[4 * g + 2] * gq.z, c[4 * g + 3] * gq.w) << 32);
            *(unsigned long long*)(WsT + (size_t)(n0 + r) * D + k) = o; }
    }
}
__device__ __forceinline__ void prep_rope(float* __restrict__ RT, int gt, int nt) {
    for (int i = gt; i < 2064 * RH; i += nt) { const int pos = i / RH, f = i % RH; const float inv = powf(10000.f, -(float)f / (float)RH); const float ang = (float)pos * inv; RT[2 * i] = cosf(ang); RT[2 * i + 1] = sinf(ang); }
}
__device__ __forceinline__ void p0stats(const bf16_t* __restrict__ P0, const float* __restrict__ kn_pe, const float* __restrict__ RT, float* __restrict__ RQ, float* __restrict__ RKV, bf16_t* __restrict__ KPE, int gw, int nw, int lane) {
    asm volatile("" : "+v"(lane));
    const bool kl = lane >= 16 && lane < 24, hi = lane & 4; const int ke = 8 * (lane & 7);
    const f32x4 gk0 = *(const f32x4*)(kn_pe + ke), gk1 = *(const f32x4*)(kn_pe + ke + 4);
    for (int r0 = gw * 4; r0 < ME; r0 += nw * 4) {
        u32x4 A[4], B[4]; f32x4 rt[4][4];
#pragma unroll
        for (int t = 0; t < 4; ++t) { const int r = r0 + t; const bf16_t* p = P0 + (size_t)r * P0W; A[t] = *(const u32x4*)(p + 8 * lane); B[t] = *(const u32x4*)(p + 512 + 8 * (lane & 31));
            const int pos = tok_pos(r) < 2064 ? tok_pos(r) : 0; const float* q = RT + ((size_t)pos * RH + 8 * (lane & 3)) * 2;
#pragma unroll
            for (int i = 0; i < 4; ++i) rt[t][i] = *(const f32x4*)(q + 4 * i); }
#pragma unroll
        for (int t = 0; t < 4; ++t) { const int r = r0 + t;
            float fa[8], fb[8]; unpack8(A[t], fa); unpack8(B[t], fb);
            float sa = 0.f, sb = 0.f;
#pragma unroll
            for (int i = 0; i < 8; ++i) { sa += fa[i] * fa[i]; sb += fb[i] * fb[i]; }
            const float sq = wsum(lane < 48 ? sa : 0.f), skv = wsum((lane >= 48 ? sa : 0.f) + (lane < 16 ? sb : 0.f)), sk = wsum(kl ? sb : 0.f);
            if (lane == 0) { RQ[r] = rsqrtf(sq * (1.f / QR) + EPS); RKV[r] = rsqrtf(skv * (1.f / KVR) + EPS); }
            if (kl) {
                const float rn = rsqrtf(sk * (1.f / ROPE) + EPS); float y[8], o[8];
                const float gk[8] = {gk0.x, gk0.y, gk0.z, gk0.w, gk1.x, gk1.y, gk1.z, gk1.w};
                const float cs[16] = {rt[t][0].x, rt[t][0].y, rt[t][0].z, rt[t][0].w, rt[t][1].x, rt[t][1].y, rt[t][1].z, rt[t][1].w, rt[t][2].x, rt[t][2].y, rt[t][2].z, rt[t][2].w, rt[t][3].x, rt[t][3].y, rt[t][3].z, rt[t][3].w};
#pragma unroll
                for (int i = 0; i < 8; ++i) y[i] = fb[i] * rn * gk[i];
#pragma unroll
                for (int i = 0; i < 8; ++i) { const float up = dpp_f<0x114>(y[i]), dn = dpp_f<0x104>(y[i]);
                    o[i] = hi ? y[i] * cs[2 * i] + up * cs[2 * i + 1] : y[i] * cs[2 * i] - dn * cs[2 * i + 1]; }
                *(u32x4*)(KPE + (size_t)r * ROPE + ke) = pack8(o); }
        }
    }
}
__device__ __forceinline__ void meta_kv(const bf16_t* __restrict__ P0, const bf16_t* __restrict__ Wkv, const float* __restrict__ RKV, const float* __restrict__ kn_nope, bf16_t* __restrict__ KN, bf16_t* __restrict__ V, int gw, int nw, int lane) {
    asm volatile("" : "+v"(lane));
    for (int it = gw; it < NMETA * 8; it += nw) {
        const int row = M + (it >> 3), g = it & 7; const bf16_t* a = P0 + (size_t)row * P0W + S_CKV; float acc[2] = {0.f, 0.f};
#pragma unroll
        for (int t = 0; t < 2; ++t) { const bf16_t* w = Wkv + (size_t)(g * 128 + lane + 64 * t) * KVR;
            for (int k = 0; k < KVR; k += 8) { float fa[8], fw[8]; unpack8(*(const u32x4*)(a + k), fa); unpack8(*(const u32x4*)(w + k), fw);
#pragma unroll
                for (int i = 0; i < 8; ++i) acc[t] += fa[i] * fw[i]; } }
        const float sc = RKV[row]; acc[0] *= sc; acc[1] *= sc;
        if (g < 4) { const float rn = rsqrtf(wsum(acc[0] * acc[0] + acc[1] * acc[1]) * (1.f / NOPE) + EPS);
            KN[(size_t)row * 512 + g * 128 + lane] = f2bf(acc[0] * rn * kn_nope[lane]); KN[(size_t)row * 512 + g * 128 + lane + 64] = f2bf(acc[1] * rn * kn_nope[lane + 64]); }
        else { V[(size_t)row * 512 + (g - 4) * 128 + lane] = f2bf(acc[0]); V[(size_t)row * 512 + (g - 4) * 128 + lane + 64] = f2bf(acc[1]); }
    }
}
__device__ __forceinline__ void gla_post(const bf16_t* OG, const bf16_t* __restrict__ GG, bf16_t* OO, int gw, int nw, int lane) {
    asm volatile("" : "+v"(lane));
    for (int r0 = gw * 2; r0 < M; r0 += nw * 2) {
        u32x4 ow[2][2], gwv[2][2];
#pragma unroll
        for (int t = 0; t < 2; ++t) { const size_t off = (size_t)(r0 + t) * D + 16 * lane;
            ow[t][0] = *(const u32x4*)(OG + off); ow[t][1] = *(const u32x4*)(OG + off + 8); gwv[t][0] = *(const u32x4*)(GG + off); gwv[t][1] = *(const u32x4*)(GG + off + 8); }
#pragma unroll
        for (int t = 0; t < 2; ++t) { float o[16], g[16]; unpack8(ow[t][0], o); unpack8(ow[t][1], o + 8); unpack8(gwv[t][0], g); unpack8(gwv[t][1], g + 8);
            float ss = 0.f;
#pragma unroll
            for (int i = 0; i < 16; ++i) ss += o[i] * o[i];
            ss += dpp_f<0xB1>(ss); ss += dpp_f<0x4E>(ss); ss += dpp_f<0x141>(ss); ss += dpp_f<0x128>(ss);
            const float rn = rsqrtf(ss * (1.f / GHV) + EPS);
#pragma unroll
            for (int i = 0; i < 16; ++i) o[i] = o[i] * rn * g[i] * sigmoidf_(g[i]);
            const size_t off = (size_t)(r0 + t) * D + 16 * lane; *(u32x4*)(OO + off) = pack8(o); *(u32x4*)(OO + off + 8) = pack8(o + 8); }
    }
}
struct __attribute__((packed, aligned(4))) U3 { unsigned x, y, z; };
__device__ __forceinline__ unsigned enc_e2m3(float v) {
    const float t = fminf(fabsf(v) * 8.f, 60.f);
    const float m = t < 16.f ? 1.f : t < 32.f ? 0.5f : 0.25f; const unsigned b = t < 16.f ? 0u : t < 32.f ? 8u : 16u;
    return ((unsigned)(int)__builtin_rintf(t * m) + b) | (v < 0.f ? 32u : 0u);
}
__device__ __forceinline__ void conv_f6(const float* __restrict__ a, unsigned char* __restrict__ ao, float scale, const float* __restrict__ gain, int n16, int gt, int nt) {
    for (int i0 = gt; i0 < n16; i0 += 2 * nt) {
        const int i1 = i0 + nt < n16 ? i0 + nt : i0;
        f32x4 x[2][4], g[2][4];
#pragma unroll
        for (int t = 0; t < 2; ++t)
#pragma unroll
            for (int j = 0; j < 4; ++j) { const int i = t ? i1 : i0; x[t][j] = *(const f32x4*)(a + (size_t)i * 16 + 4 * j); g[t][j] = *(const f32x4*)(gain + (i & 63) * 16 + 4 * j); }
#pragma unroll
        for (int t = 0; t < 2; ++t) { const int i = t ? i1 : i0;
            unsigned c[16];
#pragma unroll
            for (int j = 0; j < 4; ++j) { const f32x4 v = x[t][j], q = g[t][j];
                c[4 * j] = enc_e2m3(v.x * q.x * scale); c[4 * j + 1] = enc_e2m3(v.y * q.y * scale); c[4 * j + 2] = enc_e2m3(v.z * q.z * scale); c[4 * j + 3] = enc_e2m3(v.w * q.w * scale); }
            unsigned long long lo = 0ull;
#pragma unroll
            for (int j = 0; j < 10; ++j) lo |= (unsigned long long)c[j] << (6 * j);
            lo |= (unsigned long long)(c[10] & 15u) << 60;
            unsigned hi = c[10] >> 4;
#pragma unroll
            for (int j = 11; j < 16; ++j) hi |= c[j] << (6 * (j - 11) + 2);
            *(U3*)(ao + (size_t)i * 12) = U3{(unsigned)lo, (unsigned)(lo >> 32), hi}; }
    }
}
__device__ __forceinline__ unsigned enc_e2m1(float v) {
    const float t = fabsf(v);
    return (unsigned)((t > 0.25f) + (t > 0.75f) + (t > 1.25f) + (t > 1.75f) + (t > 2.5f) + (t > 3.5f) + (t > 5.f)) | (v < 0.f ? 8u : 0u);
}
__device__ __forceinline__ void conv_f4(const float* __restrict__ a, unsigned char* __restrict__ ao, float scale, int n16, int gt, int nt) {
    for (int i0 = gt; i0 < n16; i0 += 2 * nt) {
        const int i1 = i0 + nt < n16 ? i0 + nt : i0;
        f32x4 x[2][4];
#pragma unroll
        for (int t = 0; t < 2; ++t)
#pragma unroll
            for (int j = 0; j < 4; ++j) x[t][j] = *(const f32x4*)(a + (size_t)(t ? i1 : i0) * 16 + 4 * j);
#pragma unroll
        for (int t = 0; t < 2; ++t) { unsigned w0 = 0u, w1 = 0u;
#pragma unroll
            for (int j = 0; j < 4; ++j) { const f32x4 v = x[t][j];
                const unsigned c = enc_e2m1(v.x * scale) | enc_e2m1(v.y * scale) << 4 | enc_e2m1(v.z * scale) << 8 | enc_e2m1(v.w * scale) << 12;
                if (j < 2) w0 |= c << (16 * j); else w1 |= c << (16 * (j - 2)); }
            *(u32x2*)(ao + (size_t)(t ? i1 : i0) * 8) = (u32x2){w0, w1}; }
    }
}
__device__ __forceinline__ unsigned enc_s4(float v) { return (unsigned)(int)fminf(fmaxf(__builtin_rintf(v), -8.f), 7.f) & 15u; }
__device__ __forceinline__ void conv_s4g(const float* __restrict__ a, unsigned char* __restrict__ ao, float scale, const float* __restrict__ gain, int n16, int gt, int nt) {
    for (int i0 = gt; i0 < n16; i0 += 2 * nt) {
        const int i1 = i0 + nt < n16 ? i0 + nt : i0;
        f32x4 x[2][4], g[2][4];
#pragma unroll
        for (int t = 0; t < 2; ++t)
#pragma unroll
            for (int j = 0; j < 4; ++j) { const int i = t ? i1 : i0; x[t][j] = *(const f32x4*)(a + (size_t)i * 16 + 4 * j); g[t][j] = *(const f32x4*)(gain + (i & 63) * 16 + 4 * j); }
#pragma unroll
        for (int t = 0; t < 2; ++t) { unsigned w0 = 0u, w1 = 0u;
#pragma unroll
            for (int j = 0; j < 4; ++j) { const f32x4 v = x[t][j], q = g[t][j];
                const unsigned c = enc_s4(v.x * q.x * scale) | enc_s4(v.y * q.y * scale) << 4 | enc_s4(v.z * q.z * scale) << 8 | enc_s4(v.w * q.w * scale) << 12;
                if (j < 2) w0 |= c << (16 * j); else w1 |= c << (16 * (j - 2)); }
            *(u32x2*)(ao + (size_t)(t ? i1 : i0) * 8) = (u32x2){w0, w1}; }
    }
}
}

#ifndef REP_G
#define REP_G 1
#endif
#ifndef REP_A
#define REP_A 1
#endif
#ifndef REP_GA
#define REP_GA 1
#endif
#ifndef REP_P
#define REP_P 1
#endif
#ifndef REP_R
#define REP_R 1
#endif
#ifndef REP_SY
#define REP_SY 1
#endif
#ifndef REP_T
#define REP_T 1
#endif
#ifndef REP_U
#define REP_U 1
#endif
#ifndef PREP_VAR
#define PREP_VAR 0
#endif
#ifndef REP_S
#define REP_S 1
#endif
constexpr int MEGA_THREADS = 512, MEGA_LDS = 147456;
struct MegaArgs {
    const float* in[23]; float* out; char* ws; int ph_lo, ph_hi, coop, pad;
};
enum { PH_PREP = 0, PH_PROJ = 1, PH_STATS = 2, PH_UP = 3, PH_ATT = 4, PH_GLAPOST = 7, PH_MIX = 8, PH_OUT = 9, PH_SCORE = 10, PH_GATHER = 11, PH_N = 12 };

struct SchedProj { const char* XB; const char* WinT; int G, c;
    __device__ __forceinline__ bool next(int i, pg8::Unit& u) const {
        const int L = i * G + c; constexpr int NNAT = 129 * 17, NTR = 6 * 129;
        if (L >= NNAT + NTR) return false;
        if (L < NNAT) { pg8::tile_of(L, 129, 17, u.pm, u.pn); u.gid = 0; u.A = XB + (size_t)u.pm * 256 * D * 2; u.B = WinT + (size_t)u.pn * 256 * D * 2; }
        else { pg8::tile_of(L - NNAT, 6, 129, u.pm, u.pn); u.gid = 1; u.A = WinT + (size_t)(WIN_NAT + u.pm * 256) * D * 2; u.B = XB + (size_t)u.pn * 256 * D * 2; }
        return true; }
};
struct EpiProj { static constexpr bool XFORM = false, ROWSTAT = false, PRE = true, AUX = false; EpiProjNat n; EpiProjTr t;
    __device__ __forceinline__ void pre(int gid, int row0, int col0, float (&rs)[2][4], f32x4 (&cs)[2][2]) const {
        if (gid == 0) {
#pragma unroll
            for (int ai = 0; ai < 2; ++ai)
#pragma unroll
                for (int m = 0; m < 4; ++m) rs[ai][m] = n.R1[row0 + ai * 128 + m * 16]; }
        else {
#pragma unroll
            for (int bj = 0; bj < 2; ++bj) { cs[bj][0] = *(const f32x4*)(t.R1 + col0 + bj * 128); cs[bj][1] = *(const f32x4*)(t.R1 + col0 + bj * 128 + 4); } } }
    __device__ __forceinline__ void operator()(int gid, int row, int col, const float* v, float rsv, const f32x4 (&csv)[2]) const { if (gid == 0) n(row, col, v, rsv); else t(row, col, v, csv); } };
struct SchedSimple { const char* A; const char* B; size_t sA, sB; int nM, nN, G, c, gid;
    __device__ __forceinline__ bool next(int i, pg8::Unit& u) const {
        const int L = i * G + c; if (L >= nM * nN) return false;
        pg8::tile_of(L, nM, nN, u.pm, u.pn); u.gid = gid; u.A = A + (size_t)u.pm * sA; u.B = B + (size_t)u.pn * sB; return true; }
};
struct EpiUp { static constexpr bool XFORM = false, ROWSTAT = true, PRE = true, AUX = false; EpiUq q; EpiUkv kv; const float* kn_nope;
    __device__ __forceinline__ bool want_stat(int gid, int pn) const { return gid == 1 && pn < 2; }
    __device__ __forceinline__ void pre(int gid, int row0, int col0, float (&rs)[2][4], f32x4 (&cs)[2][2]) const {
        const float* R = gid == 0 ? q.RQ : kv.RKV;
#pragma unroll
        for (int ai = 0; ai < 2; ++ai)
#pragma unroll
            for (int m = 0; m < 4; ++m) rs[ai][m] = R[row0 + ai * 128 + m * 16];
        cs[0][0] = *(const f32x4*)(kn_nope + (col0 & 127)); cs[0][1] = *(const f32x4*)(kn_nope + (col0 & 127) + 4); cs[1][0] = cs[0][0]; cs[1][1] = cs[0][1]; }
    __device__ __forceinline__ void operator()(int gid, int row, int col, const float* v, float ss, float s, const f32x4 (&g)[2]) const {
        if (gid == 0) { q(row, col, v, s); return; }
        if (col < 512) {
            const float rn = s * rsqrtf(s * s * ss * (1.f / NOPE) + EPS);
            const float o[8] = {v[0] * rn * g[0].x, v[1] * rn * g[0].y, v[2] * rn * g[0].z, v[3] * rn * g[0].w, v[4] * rn * g[1].x, v[5] * rn * g[1].y, v[6] * rn * g[1].z, v[7] * rn * g[1].w};
            *(u32x4*)(kv.KN + (size_t)row * 512 + col) = pack8(o); }
        else kv(row, col, v, s); }
};
template <class E1> struct EpiWrap { static constexpr bool XFORM = false, ROWSTAT = false, PRE = false, AUX = false; E1 e;
    __device__ __forceinline__ void operator()(int, int row, int col, const float* v) const { e(row, col, v); } };
struct SchedMix { const char* YA; const char* YB; const char* W1; const char* W2; int G, c;
    __device__ __forceinline__ bool next(int i, pg8::Unit& u) const {
        const int L = (i >> 1) * G + c; if (L >= 128 * 4) return false;
        pg8::tile_of(L, 128, 4, u.pm, u.pn); u.gid = i & 1;
        u.A = (u.gid ? YB : YA) + (size_t)u.pm * 256 * D * 2; u.B = (u.gid ? W2 : W1) + (size_t)u.pn * 256 * D * 2; return true; }
};
struct EpiMix { static constexpr bool XFORM = false, ROWSTAT = false, PRE = false, AUX = true; const bf16_t* __restrict__ GA; const bf16_t* __restrict__ GB; bf16_t* __restrict__ MIX;
    __device__ __forceinline__ bool keep(int gid) const { return gid == 0; }
    __device__ __forceinline__ void aux(int gid, int row, int col, u32x4 (&ax)[2]) const { ax[1] = *(const u32x4*)(GB + (size_t)row * D + col); if (gid == 0) ax[0] = *(const u32x4*)(GA + (size_t)row * D + col); }
    __device__ __forceinline__ bool apply(int gid, int row, int col, float* v, const u32x4 (&ax)[2]) const {
        float gb[8]; unpack8(ax[1], gb);
        if (gid == 0) { float ga[8]; unpack8(ax[0], ga);
#pragma unroll
            for (int i = 0; i < 8; ++i) v[i] *= (1.f + __expf(-gb[i])) / (1.f + __expf(-ga[i]));
            return true; }
        float o[8];
#pragma unroll
        for (int i = 0; i < 8; ++i) o[i] = v[i] * sigmoidf_(gb[i]);
        *(u32x4*)(MIX + (size_t)row * D + col) = pack8(o); return false; }
};

__global__ void __launch_bounds__(MEGA_THREADS, 2) mega(MegaArgs a) {
    extern __shared__ __attribute__((aligned(16))) unsigned char lds_raw[];
    PG8_LAS unsigned char* lds = (PG8_LAS unsigned char*)lds_raw;
    cg::grid_group grid = cg::this_grid();
    char* ws = a.ws;
    const int G = gridDim.x, bx = blockIdx.x, nw = G * 8, nt = G * MEGA_THREADS;
    const int wid_s = __builtin_amdgcn_readfirstlane((int)threadIdx.x >> 6);
#define TIDS int lane = lane_id(); asm volatile("" : "+v"(lane)); const int wid = wid_s, tid = wid * 64 + lane, gw = bx * 8 + wid, gt = bx * MEGA_THREADS + tid; (void)lane; (void)gw; (void)gt; (void)wid
    bf16_t *WinT = (bf16_t*)(ws + O_WIN), *XB = (bf16_t*)(ws + O_XB), *P0 = (bf16_t*)(ws + O_P0), *GQ = (bf16_t*)(ws + O_GQ), *GKT = (bf16_t*)(ws + O_GKT), *GVT = (bf16_t*)(ws + O_GVT), *GG = (bf16_t*)(ws + O_GG);
    float *R1 = (float*)(ws + O_R1), *RQ = (float*)(ws + O_RQ), *RKV = (float*)(ws + O_RKV), *SC = (float*)(ws + O_S), *RT = (float*)(ws + O_ROPE);
    bf16_t *WuqT = (bf16_t*)(ws + O_WUQ), *WukvT = (bf16_t*)(ws + O_WUKV), *WomT = (bf16_t*)(ws + O_WOM), *WogT = (bf16_t*)(ws + O_WOG), *WoutT = (bf16_t*)(ws + O_WOUT), *WsT = (bf16_t*)(ws + O_WS);
    bf16_t *QC = (bf16_t*)(ws + O_QC), *KN = (bf16_t*)(ws + O_KN), *V = (bf16_t*)(ws + O_V), *YA = (bf16_t*)(ws + O_YA), *YB = (bf16_t*)(ws + O_YB), *MIX = (bf16_t*)(ws + O_MIX), *HN2 = (bf16_t*)(ws + O_HN2);
    bf16_t *GA = (bf16_t*)a.out, *GB = (bf16_t*)a.out + (size_t)M * D; bf16_t* KPE = (bf16_t*)(ws + O_KPE);
#define IN(k) (a.ph_lo <= (k) && (k) < a.ph_hi)
    volatile PG8_LAS unsigned* MISC = (volatile PG8_LAS unsigned*)(lds + 131072 + 320);
    { TIDS; if (tid < 128) ((PG8_LAS unsigned*)(lds + 131072))[tid] = 0u; }
    __syncthreads();
    const XcdBarrier xbar = xcd_barrier_post((unsigned*)(ws + O_BAR), MISC + 8, wid_s);
    if (a.coop == 2) grid.sync();
#define SEAM(k) do { if (a.coop && (k) + 1 < a.ph_hi) xcd_barrier(xbar); } while (0)
    if (IN(PH_PREP)) { for (int rep = 0; rep < REP_P; ++rep) { TIDS;
        sm::prep_x(a.in[0], a.in[1], XB, R1, gw, nw, lane);
        PG8_LAS float* scr = (PG8_LAS float*)(lds + wid * 16384);
        sm::prep_w_all(sm::WAll{a.in[3], a.in[2], a.in[5], a.in[4], a.in[7], a.in[6], a.in[15], a.in[16], a.in[14], a.in[17], WinT, WuqT, WukvT, WomT, WogT, WoutT}, scr, gw, nw, lane);
        sm::prep_ws(a.in[19], a.in[20], a.in[18], WsT, gw, nw, lane);
        sm::prep_rope(RT, gt, nt); __syncthreads(); }
        SEAM(PH_PREP);
    }
    if (IN(PH_PROJ)) {
        SchedProj S{(const char*)XB, (const char*)WinT, G, bx};
        EpiProj E{EpiProjNat{R1, P0, GQ, GG, GA, GB}, EpiProjTr{R1, GKT, GVT}};
        for (int rep = 0; rep < REP_G; ++rep) pg8::gemm_phase(lds, pg8::Fam{D, D, D}, S, E, wid_s);
        SEAM(PH_PROJ);
    }
    if (IN(PH_STATS)) { TIDS;
        for (int rep = 0; rep < REP_R; ++rep) sm::p0stats(P0, a.in[11], RT, RQ, RKV, KPE, gw, nw, lane);
        for (int i = gt; i < 48 * 512 / 8; i += nt) { *(u32x4*)(KN + (size_t)(M + NMETA) * 512 + (size_t)i * 8) = (u32x4){0u, 0u, 0u, 0u}; *(u32x4*)(V + (size_t)(M + NMETA) * 512 + (size_t)i * 8) = (u32x4){0u, 0u, 0u, 0u}; }
        for (int rep = 0; rep < REP_U; ++rep) { const bool dm = rep + 1 < REP_U; const gla::Tens GT{GQ, GKT, GVT, dm ? QC : GQ, dm ? QC + (size_t)ME * 512 : GKT, dm ? PREP_VAR : 0, P0, a.in[12], a.in[13], (bf16_t*)(ws + O_AG), (float*)(ws + O_DECL), YB};
          gla::prep_phase(lds, GT, G, bx, wid_s); }
        SEAM(PH_STATS);
    }
#define ROUND_BODY(r) do { \
        if (IN(PH_UP + 2 * r)) { TIDS; \
            const int Gh = G >> 1; const bool isq = bx < Gh; \
            SchedSimple S{(const char*)(isq ? P0 : P0 + S_CKV), (const char*)(isq ? WuqT + (size_t)r * 768 * QR : WukvT + (size_t)r * 1024 * KVR), (size_t)256 * P0W * 2, (size_t)256 * (isq ? QR : KVR) * 2, 128, isq ? 3 : 4, isq ? Gh : G - Gh, isq ? bx : bx - Gh, isq ? 0 : 1}; \
            for (int rep = 0; rep < REP_G; ++rep) pg8::gemm_phase(lds, pg8::Fam{P0W, isq ? QR : KVR, isq ? QR : KVR}, S, EpiUp{EpiUq{RQ, QC}, EpiUkv{RKV, KN, V}, a.in[10]}, wid_s); \
            sm::meta_kv(P0, WukvT + (size_t)r * 1024 * KVR, RKV, a.in[10], KN, V, gw, nw, lane); \
            SEAM(PH_UP + 2 * r); \
        } \
        if (IN(PH_ATT + 2 * r)) { \
            if (r == 0) att::attn_phase(lds, att::Tens{QC, KN, KPE, V, YA, a.in[8], a.in[9], RT}, r, G, bx, wid_s); \
            else { \
                if (bx < NB * 4) { const gla::Tens GT{GQ, GKT, GVT, GQ, GKT, 0, P0, a.in[12], a.in[13], (bf16_t*)(ws + O_AG), (float*)(ws + O_DECL), YB}; \
                    for (int u = bx; u < NB * 4; u += G) gla::scan_wg(lds, GT, u >> 2, u & 3, wid_s); } \
                att::attn_phase_dyn(lds, att::Tens{QC, KN, KPE, V, YA, a.in[8], a.in[9], RT}, r, (unsigned*)(ws + O_BAR) + 3584, MISC, wid_s); } \
            SEAM(PH_ATT + 2 * r); } \
    } while (0)
    ROUND_BODY(0);
    ROUND_BODY(1);
#undef ROUND_BODY
    if (IN(PH_GLAPOST)) { TIDS; for (int rep = 0; rep < REP_R; ++rep) { sm::gla_post(YB, GG, rep + 1 < REP_R ? GVT : YB, gw, nw, lane);
        sm::conv_s4g(a.in[21], (unsigned char*)(ws + O_UB), peer::PEER_SU, a.in[18], 16384 * D / 16, gt, nt);
        sm::conv_f4(a.in[22], (unsigned char*)(ws + O_VB), peer::PEER_SV, 16384 * D / 16, gt, nt); }
        SEAM(PH_GLAPOST); }
    if (IN(PH_MIX)) {
        SchedMix S{(const char*)YA, (const char*)YB, (const char*)WomT, (const char*)WogT, G, bx};
        for (int rep = 0; rep < REP_G; ++rep) pg8::gemm_phase(lds, pg8::Fam{D, D, D}, S, EpiMix{GA, GB, MIX}, wid_s);
        SEAM(PH_MIX);
    }
    if (IN(PH_OUT)) {
        SchedSimple S{(const char*)MIX, (const char*)WoutT, (size_t)256 * D * 2, (size_t)256 * D * 2, 128, 4, G, bx, 0};
        for (int rep = 0; rep < REP_G; ++rep) pg8::gemm_phase(lds, pg8::Fam{D, D, D}, S, EpiOut{a.in[0], a.out, HN2, (float*)(ws + O_SSQ)}, wid_s);
        SEAM(PH_OUT);
    }
    if (IN(PH_SCORE)) {
        SchedSimple S{(const char*)HN2, (const char*)WsT, (size_t)256 * D * 2, (size_t)256 * D * 2, 128, 8, G, bx, 0};
        for (int rep = 0; rep < REP_G; ++rep) pg8::gemm_phase(lds, pg8::Fam{D, D, D}, S, EpiWrap<EpiScore>{EpiScore{(bf16_t*)SC}}, wid_s);
        { TIDS; PG8_LAS float* wl = (PG8_LAS float*)(lds + wid * peer::TK_WAVE_LDS); pg8::Unit u; int nu = 0; while (S.next(nu, u)) ++nu;
          for (int t = wid; t < nu * 4; t += 8) { S.next(t >> 2, u); peer::topk64(wl, (const bf16_t*)SC, (const float*)(ws + O_SSQ), (int*)(ws + O_IDX), (float*)(ws + O_GATE), u.pm * 256 + (t & 3) * 64, u.pn, true, lane); } }
        SEAM(PH_SCORE);
    }
    if (IN(PH_GATHER)) for (int rep = 0; rep < REP_GA; ++rep) peer::gather1s_phase(lds, HN2, (const int*)(ws + O_IDX), (const float*)(ws + O_GATE), (const unsigned char*)(ws + O_UB), (const unsigned char*)(ws + O_VB), (const float*)(ws + O_SSQ), rep + 1 < REP_GA ? SC : a.out, G, bx, wid_s);
}

extern "C" void kernel_launch(void* const* d_in, const int* in_sizes, int n_in, void* d_out, int out_size, void* d_ws, size_t ws_size, hipStream_t st) {
    (void)in_sizes; (void)out_size;
    static int grid = 0;
    if (grid == 0) {
        if (n_in != 23 || ws_size < O_WSEND) { fprintf(stderr, "kernel_launch: unexpected inputs (%d) or workspace %zu < %zu\n", n_in, ws_size, (size_t)O_WSEND); grid = -1; return; }
        int dev = 0, cus = 0, per_cu = 0;
        if (hipGetDevice(&dev) != hipSuccess || hipDeviceGetAttribute(&cus, hipDeviceAttributeMultiprocessorCount, dev) != hipSuccess) cus = 256;
        if (hipFuncSetAttribute((const void*)mega, hipFuncAttributeMaxDynamicSharedMemorySize, MEGA_LDS) != hipSuccess) { fprintf(stderr, "kernel_launch: hipFuncSetAttribute failed\n"); grid = -1; return; }
        if (hipOccupancyMaxActiveBlocksPerMultiprocessor(&per_cu, (const void*)mega, MEGA_THREADS, MEGA_LDS) != hipSuccess || per_cu < 1) { fprintf(stderr, "kernel_launch: occupancy query failed (%d)\n", per_cu); per_cu = 1; }
        (void)hipGetLastError();
        grid = cus * 1;
        if (per_cu < 1) grid = -1;
    }
    if (grid < 0) return;
    MegaArgs ma{};
    for (int i = 0; i < 23; ++i) ma.in[i] = (const float*)d_in[i];
    ma.out = (float*)d_out; ma.ws = (char*)d_ws; ma.ph_lo = 0; ma.ph_hi = PH_N; ma.coop = 1; ma.pad = 0;
    if (hipMemsetAsync((char*)d_ws + O_BAR, 0, BAR_BYTES, st) != hipSuccess) { fprintf(stderr, "kernel_launch: memset failed\n"); return; }
    void* args[] = {&ma};
    hipError_t e = hipLaunchCooperativeKernel((const void*)mega, dim3(grid), dim3(MEGA_THREADS), args, MEGA_LDS, st);
    if (e != hipSuccess) fprintf(stderr, "kernel_launch: cooperative launch failed: %s (grid %d)\n", hipGetErrorString(e), grid);
}
```

```cpp
#include <hip/hip_runtime.h>
#include <hip/hip_cooperative_groups.h>
namespace cg = cooperative_groups;
#include <cstdint>
#include <cstdio>

typedef unsigned short bf16_t;
typedef unsigned u32x4 __attribute__((ext_vector_type(4)));
typedef unsigned u32x2 __attribute__((ext_vector_type(2)));
typedef float f32x4 __attribute__((ext_vector_type(4)));

constexpr int D = 1024, NB = 16, SEQ = 2048, M = NB * SEQ, ME = M + 256, NMETA = 16;
constexpr float EPS = 1e-6f;
constexpr int QR = 384, KVR = 256, NOPE = 128, ROPE = 64, RH = 32, QKD = 192;
constexpr int GDK = 512, GDV = 1024, GHK = 128, GHV = 256, GR = 16;
constexpr int DIN = 5840;
constexpr int S_CQ = 0, S_CKV = 384, S_KPE = 640, S_GQ = 704, S_GK = 1216, S_GV = 1728, S_GA = 2752, S_GG = 2768, S_A = 3792, S_B = 4816;
constexpr int WIN_ROWS = 5888, WIN_NAT = 4352, P0W = 768;
constexpr float SCL2 = 0.07216878364870323f * 1.4426950408889634f;
constexpr float GLA_QS = 0.08838834764831845f;
constexpr float SW_IN = 4.5f / 32.f / 127.f;

constexpr size_t MiB = 1u << 20;
constexpr size_t al(size_t x) { return (x + 255) / 256 * 256; }
constexpr size_t O_WIN = 0;
constexpr size_t O_WUQ = O_WIN + al((size_t)WIN_ROWS * D * 2);
constexpr size_t O_WUKV = O_WUQ + al((size_t)1536 * QR * 2);
constexpr size_t O_WOM = O_WUKV + al((size_t)2048 * KVR * 2);
constexpr size_t O_WOG = O_WOM + al((size_t)D * D * 2);
constexpr size_t O_WOUT = O_WOG + al((size_t)D * D * 2);
constexpr size_t O_WS = O_WOUT + al((size_t)D * D * 2);
constexpr size_t O_ROPE = O_WS + al((size_t)2048 * D * 2);
constexpr size_t O_R1 = O_ROPE + al((size_t)2064 * RH * 2 * 4);
constexpr size_t O_RQ = O_R1 + al((size_t)ME * 4);
constexpr size_t O_RKV = O_RQ + al((size_t)ME * 4);
constexpr size_t O_KPE = O_RKV + al((size_t)ME * 4);
constexpr size_t O_XB = O_KPE + al((size_t)ME * ROPE * 2);
constexpr size_t O_POOL = O_XB + al((size_t)ME * D * 2);
constexpr size_t O_GKT = O_POOL;
constexpr size_t O_GQ = O_GKT + al((size_t)ME * GDK * 2);
constexpr size_t O_P0 = O_GQ + al((size_t)ME * GDK * 2);
constexpr size_t O_GK = O_P0 + al((size_t)ME * P0W * 2);
constexpr size_t O_GVT = O_GK + al((size_t)ME * GDK * 2);
constexpr size_t O_GG = O_GVT + al((size_t)ME * GDV * 2);
constexpr size_t O_QC = O_GG + al((size_t)M * D * 2);
constexpr size_t O_KN = O_QC + al((size_t)M * 768 * 2);
constexpr size_t O_V = O_KN + al((size_t)ME * 512 * 2);
constexpr size_t O_END = O_V + al((size_t)ME * 512 * 2);
constexpr int GLA_NU = NB * 4 * 33;
constexpr size_t O_AG = O_END;
constexpr size_t O_DECL = O_AG + al((size_t)GLA_NU * 64 * 64 * 2);
constexpr size_t O_BAR = O_DECL + al((size_t)GLA_NU * 128 * 4);
constexpr size_t BAR_BYTES = 16384;
constexpr size_t O_SSQ = O_BAR + BAR_BYTES;
constexpr size_t O_WSEND = O_SSQ + al((size_t)M * 32 * 4);
static_assert(O_WSEND <= 512 * MiB, "ws");
constexpr size_t O_YA = O_XB;
constexpr size_t O_YB = O_P0;
static_assert(O_YB + (size_t)M * D * 2 <= O_GVT, "YB overlay");
constexpr size_t O_MIX = O_GVT;
constexpr size_t O_HN2 = O_XB;
constexpr size_t O_S = O_POOL;
constexpr size_t O_IDX = O_QC;
static_assert(O_S + (size_t)M * 2048 * 4 <= O_QC, "S overlay");
constexpr size_t O_GATE = O_IDX + al((size_t)M * 128 * 4);
constexpr size_t O_UB = O_GATE + al((size_t)M * 128 * 4);
constexpr size_t O_VB = O_UB + al((size_t)16384 * D * 2);
static_assert(O_VB + (size_t)16384 * D * 2 <= O_END, "tables overlay");

__device__ __forceinline__ float bf2f(bf16_t u) { return __uint_as_float((unsigned)u << 16); }
__device__ __forceinline__ bf16_t f2bf(float f) { unsigned u = __float_as_uint(f); return (bf16_t)((u + 0x7fffu + ((u >> 16) & 1u)) >> 16); }
__device__ __forceinline__ unsigned pk2(float lo, float hi) { return (unsigned)f2bf(lo) | ((unsigned)f2bf(hi) << 16); }
__device__ __forceinline__ void unpack8(u32x4 w, float* f) {
#pragma unroll
    for (int i = 0; i < 4; ++i) { f[2 * i] = __uint_as_float(w[i] << 16); f[2 * i + 1] = __uint_as_float(w[i] & 0xffff0000u); }
}
__device__ __forceinline__ u32x4 pack8(const float* f) { u32x4 w; w.x = pk2(f[0], f[1]); w.y = pk2(f[2], f[3]); w.z = pk2(f[4], f[5]); w.w = pk2(f[6], f[7]); return w; }
__device__ __forceinline__ float swap_add32(float a, float b) { const u32x2 r = __builtin_amdgcn_permlane32_swap(__float_as_uint(a), __float_as_uint(b), false, false); return __uint_as_float(r.x) + __uint_as_float(r.y); }
__device__ __forceinline__ float swap_add16(float a, float b) { const u32x2 r = __builtin_amdgcn_permlane16_swap(__float_as_uint(a), __float_as_uint(b), false, false); return __uint_as_float(r.x) + __uint_as_float(r.y); }
template <int CTRL> __device__ __forceinline__ float dpp_f(float x) { return __builtin_bit_cast(float, __builtin_amdgcn_update_dpp(0, __builtin_bit_cast(int, x), CTRL, 0xf, 0xf, true)); }
__device__ __forceinline__ float wsum(float v) {
    const float h = swap_add32(v, v); float s = swap_add16(h, h);
    s += dpp_f<0x128>(s); s += dpp_f<0xB1>(s); s += dpp_f<0x4E>(s); s += dpp_f<0x141>(s); return s;
}
__device__ __forceinline__ float wmax(float v) {
#pragma unroll
    for (int o = 32; o >= 1; o >>= 1) v = fmaxf(v, __shfl_xor(v, o));
    return v;
}
__device__ __forceinline__ int lane_id() { return (int)__builtin_amdgcn_mbcnt_hi(~0u, __builtin_amdgcn_mbcnt_lo(~0u, 0u)); }
__device__ __forceinline__ float sigmoidf_(float x) { return 1.f / (1.f + __expf(-x)); }
__device__ __forceinline__ int tok_pos(int row) { return row < M ? (row & (SEQ - 1)) + NMETA : row - M; }

enum { MAP_ID = 0, MAP_WIN = 1, MAP_UKV = 2 };
__device__ __forceinline__ int map_col(int mode, int n) {
    if (mode == MAP_ID) return n;
    if (mode == MAP_WIN) {
        if (n < 704) return n;
        if (n < 720) return S_GA + (n - 704);
        if (n < 768) return -1;
        if (n < 1280) return S_GQ + (n - 768);
        if (n < 2304) return S_GG + (n - 1280);
        if (n < 3328) return S_A + (n - 2304);
        if (n < 4352) return S_B + (n - 3328);
        if (n < 4864) return S_GK + (n - 4352);
        return S_GV + (n - 4864);
    }
    const int r = n >> 10, j = n & 1023;
    if (j < 512) return (4 * r + (j >> 7)) * 256 + (j & 127);
    return (4 * r + ((j - 512) >> 7)) * 256 + 128 + ((j - 512) & 127);
}
struct EpiProjNat {
    const float* R1; bf16_t *P0, *GQ, *GG, *GA, *GB;
    __device__ __forceinline__ void operator()(int row, int col, const float* v, float s) const {
        float o[8];
#pragma unroll
        for (int i = 0; i < 8; ++i) o[i] = v[i] * s;
        bf16_t* dst;
        if (col < 768) dst = P0 + (size_t)row * P0W + col;
        else if (col < 1280) dst = GQ + (size_t)row * GDK + (col - 768);
        else { if (row >= M) return;
            if (col < 2304) dst = GG + (size_t)row * D + (col - 1280);
            else if (col < 3328) dst = GA + (size_t)row * D + (col - 2304);
            else dst = GB + (size_t)row * D + (col - 3328); }
        *(u32x4*)dst = pack8(o);
    }
};
struct EpiProjTr {
    const float* R1; bf16_t *GKT, *GVT;
    __device__ __forceinline__ void operator()(int row, int col, const float* v, const f32x4 (&c)[2]) const {
        const float o[8] = {v[0] * c[0].x, v[1] * c[0].y, v[2] * c[0].z, v[3] * c[0].w, v[4] * c[1].x, v[5] * c[1].y, v[6] * c[1].z, v[7] * c[1].w};
        bf16_t* dst = row < 512 ? GKT + (size_t)row * ME + col : GVT + (size_t)(row - 512) * ME + col;
        *(u32x4*)dst = pack8(o);
    }
};
struct EpiUq {
    const float* RQ; bf16_t* QC;
    __device__ __forceinline__ void operator()(int row, int col, const float* v, float s) const {
        if (row >= M) return;
        float o[8];
#pragma unroll
        for (int i = 0; i < 8; ++i) o[i] = v[i] * s;
        *(u32x4*)(QC + (size_t)row * 768 + col) = pack8(o);
    }
};
struct EpiUkv {
    const float* RKV; bf16_t *KN, *V; int roff = 0, pad = 0;
    __device__ __forceinline__ void operator()(int row, int col, const float* v, float s) const {
        row += roff; float o[8];
#pragma unroll
        for (int i = 0; i < 8; ++i) o[i] = v[i] * s;
        bf16_t* dst = col < 512 ? KN + (size_t)row * 512 + col : V + (size_t)row * 512 + (col - 512);
        *(u32x4*)dst = pack8(o);
    }
};
struct EpiOut { static constexpr bool XFORM = false, ROWSTAT = false, PRE = false, AUX = true;
    const float* __restrict__ x; float* __restrict__ out; bf16_t* __restrict__ HB; float* __restrict__ SSQ;
    __device__ __forceinline__ bool keep(int) const { return false; }
    __device__ __forceinline__ void aux(int, int row, int col, u32x4 (&ax)[2]) const { ax[0] = *(const u32x4*)(x + (size_t)row * D + col); ax[1] = *(const u32x4*)(x + (size_t)row * D + col + 4); }
    __device__ __forceinline__ bool apply(int, int row, int col, float* v, const u32x4 (&ax)[2]) const {
        const f32x4 a = __builtin_bit_cast(f32x4, ax[0]), b = __builtin_bit_cast(f32x4, ax[1]);
        const float h[8] = {a.x + v[0], a.y + v[1], a.z + v[2], a.w + v[3], b.x + v[4], b.y + v[5], b.z + v[6], b.w + v[7]};
        *(u32x4*)(HB + (size_t)row * D + col) = pack8(h);
        float ss = (h[0] * h[0] + h[1] * h[1]) + (h[2] * h[2] + h[3] * h[3]) + (h[4] * h[4] + h[5] * h[5]) + (h[6] * h[6] + h[7] * h[7]);
        ss = swap_add16(ss, ss); ss = swap_add32(ss, ss);
        if (((col >> 3) & 3) == 0) SSQ[(size_t)row * 32 + (col >> 5)] = ss;
        return false; }
};
struct EpiScore { bf16_t* S;
    __device__ __forceinline__ void operator()(int row, int col, const float* v) const { *(u32x4*)(S + (size_t)row * 2048 + col) = pack8(v); }
};

namespace pg8 {
#define PG8_LAS __attribute__((address_space(3)))
typedef short bf16x8 __attribute__((ext_vector_type(8)));
constexpr int BM = 256, BK = 64, HALF = 128, HTB = HALF * BK * 2, STAGE_BYTES = 8 * HTB, NXCD = 8, WGM = 8;
__host__ __device__ __forceinline__ int lds_byte(int r, int c) { const int st = (r >> 4) * 2 + (c >> 5), rr = r & 15, cc = c & 31, ob = rr * 64 + cc * 2; return st * 1024 + (ob ^ (((ob >> 9) & 1) << 5)); }
__host__ __device__ __forceinline__ void stage_rc(int b, int& R, int& C) { const int st = b / 1024, sb = b % 1024, swz = sb ^ (((sb >> 9) & 1) << 5); R = (st >> 1) * 16 + swz / 64; C = (st & 1) * 32 + (swz % 64) / 2; }
__host__ __device__ __forceinline__ int perm32(int rho) { const int n = rho >> 4, i = rho & 15; return 8 * (i >> 2) + 4 * n + (i & 3); }
struct Unit { const char* A; const char* B; int pm, pn, gid; };
struct Fam { int lda, ldb, K; };
__device__ __forceinline__ void tile_of(int L, int nM, int nN, int& pm, int& pn) {
    const int nwg = nM * nN; int wgid = L; { const int q = nwg / NXCD, r = nwg % NXCD, xcd = wgid % NXCD, off = wgid / NXCD; wgid = (xcd < r ? xcd * (q + 1) : r * (q + 1) + (xcd - r) * q) + off; }
    const int nig = WGM * nN, gid = wgid / nig, fm = gid * WGM, gsz = (nM - fm) < WGM ? (nM - fm) : WGM;
    pm = fm + ((wgid % nig) % gsz); pn = (wgid % nig) / gsz;
}
typedef int i32x4 __attribute__((ext_vector_type(4)));
template <bool I8> __device__ __forceinline__ f32x4 mma16(bf16x8 b, bf16x8 a, f32x4 c) {
    if constexpr (I8) return __builtin_bit_cast(f32x4, __builtin_amdgcn_mfma_i32_16x16x64_i8(__builtin_bit_cast(i32x4, b), __builtin_bit_cast(i32x4, a), __builtin_bit_cast(i32x4, c), 0, 0, 0));
    else return __builtin_amdgcn_mfma_f32_16x16x32_bf16(b, a, c, 0, 0, 0); }
template <bool I8> __device__ __forceinline__ f32x4 acc_f(f32x4 a) { if constexpr (I8) { const i32x4 q = __builtin_bit_cast(i32x4, a); return (f32x4){(float)q.x, (float)q.y, (float)q.z, (float)q.w}; } else return a; }
template <class Epi, class Sched, bool I8 = false>
__device__ __forceinline__ void gemm_phase(PG8_LAS unsigned char* lds, const Fam f, const Sched& S, const Epi& E, int wv) {
    int tid_ = wv * 64 + lane_id(); asm volatile("" : "+v"(tid_));
    const int tid = tid_, wid = __builtin_amdgcn_readfirstlane(tid >> 6), lane = tid & 63, wr = wid >> 2, wc = wid & 3, fr = lane & 15, fq = lane >> 4;
    const int nt = f.K / BK;
    unsigned voffA[2], voffB[2];
#pragma unroll
    for (int i = 0; i < 2; ++i) { int R, C; stage_rc(tid * 16 + i * 8192, R, C); const int Rb = (R & ~31) + perm32(R & 31);
        voffA[i] = (unsigned)(R * f.lda + C) * 2u; voffB[i] = (unsigned)(Rb * f.ldb + C) * 2u; }
    const size_t kstep = (size_t)(BK * 2);
    const size_t hstepA = (size_t)HALF * f.lda * 2, hstepB = (size_t)HALF * f.ldb * 2;
    const unsigned ldsw = (unsigned)wid * 1024u;
    const int aoff = lds_byte(wr * 64 + fr, fq * 8), boff = lds_byte(wc * 32 + fr, fq * 8);
#define PG8_SA(b, h) (((b) * 2 + (h)) * HTB)
#define PG8_SB(b, h) ((4 + (b) * 2 + (h)) * HTB)
#define PG8_STAGE(bufoff, gbase, voff) do { _Pragma("unroll") for (int _i = 0; _i < 2; ++_i) \
        __builtin_amdgcn_global_load_lds((const unsigned*)((const char*)(gbase) + (voff)[_i]), (PG8_LAS unsigned*)(lds + (bufoff) + ldsw + _i * 8192), 16, 0, 0); } while (0)
#define PG8_LDA(dst, b, h) do { _Pragma("unroll") for (int m = 0; m < 4; ++m) _Pragma("unroll") for (int k = 0; k < 2; ++k) dst[m][k] = *(const PG8_LAS bf16x8*)(lds + PG8_SA(b, h) + aoff + m * 2048 + k * 1024); } while (0)
#define PG8_LDB(dst, b, h) do { _Pragma("unroll") for (int n = 0; n < 2; ++n) _Pragma("unroll") for (int k = 0; k < 2; ++k) dst[n][k] = *(const PG8_LAS bf16x8*)(lds + PG8_SB(b, h) + boff + n * 2048 + k * 1024); } while (0)
#define PG8_MMA(ai, bj, At, Bt) do { __builtin_amdgcn_s_setprio(1); _Pragma("unroll") for (int m = 0; m < 4; ++m) _Pragma("unroll") for (int n = 0; n < 2; ++n) _Pragma("unroll") for (int k = 0; k < 2; ++k) \
        acc[ai][bj][m][n] = mma16<I8>(Bt[n][k], At[m][k], acc[ai][bj][m][n]); __builtin_amdgcn_s_setprio(0); } while (0)
#define PG8_WAIT_V(n) asm volatile("s_waitcnt vmcnt(" #n ")" ::: "memory")
#define PG8_WAIT_L(n) asm volatile("s_waitcnt lgkmcnt(" #n ")" ::: "memory")
#define PG8_BAR __builtin_amdgcn_s_barrier()
#define PG8_SCHED __builtin_amdgcn_sched_barrier(0)
    Unit cur, nxt; int ui = 0;
    if (!S.next(0, cur)) return;
    f32x4 acc[2][2][4][2];
#pragma unroll
    for (int a = 0; a < 2; ++a)
#pragma unroll
        for (int b = 0; b < 2; ++b)
#pragma unroll
            for (int m = 0; m < 4; ++m)
#pragma unroll
                for (int n = 0; n < 2; ++n) acc[a][b][m][n] = (f32x4){0.f, 0.f, 0.f, 0.f};
    bf16x8 At[4][2], B0[2][2], B1[2][2];
    const char* cA = cur.A; const char* cB = cur.B;
    PG8_STAGE(PG8_SB(0, 0), cB, voffB); PG8_STAGE(PG8_SB(0, 1), cB + hstepB, voffB); PG8_STAGE(PG8_SA(0, 0), cA, voffA); PG8_STAGE(PG8_SA(0, 1), cA + hstepA, voffA);
    if (wr == 1) PG8_BAR;
    PG8_WAIT_V(2); PG8_BAR;
    PG8_STAGE(PG8_SB(1, 0), cB + kstep, voffB); PG8_STAGE(PG8_SA(1, 0), cA + kstep, voffA); PG8_STAGE(PG8_SB(1, 1), cB + hstepB + kstep, voffB);
    PG8_WAIT_V(6); PG8_BAR;
    for (;;) {
        const bool has_next = S.next(ui + 1, nxt);
        const char* nA = has_next ? nxt.A : cA; const char* nB = has_next ? nxt.B : cB;
        for (int t = 0; t < nt; t += 2) {
            const bool last = (t == nt - 2);
            const char* a1 = cA + (size_t)(t + 1) * kstep;
            const char* a2 = last ? nA : cA + (size_t)(t + 2) * kstep; const char* b2 = last ? nB : cB + (size_t)(t + 2) * kstep;
            const char* a3 = a2 + kstep; const char* b3 = b2 + kstep;
            PG8_LDB(B0, 0, 0); PG8_LDB(B1, 0, 1); PG8_SCHED; PG8_LDA(At, 0, 0); PG8_STAGE(PG8_SA(1, 1), a1 + hstepA, voffA);
            PG8_WAIT_V(8); PG8_WAIT_L(0); PG8_BAR; PG8_MMA(0, 0, At, B0); PG8_MMA(0, 1, At, B1); PG8_BAR; PG8_SCHED;
            PG8_LDA(At, 0, 1); PG8_STAGE(PG8_SB(0, 0), b2, voffB); PG8_STAGE(PG8_SB(0, 1), b2 + hstepB, voffB); PG8_STAGE(PG8_SA(0, 0), a2, voffA);
            PG8_WAIT_V(8); PG8_WAIT_L(0); PG8_BAR; PG8_MMA(1, 0, At, B0); PG8_MMA(1, 1, At, B1); PG8_BAR; PG8_SCHED;
            PG8_LDB(B0, 1, 0); PG8_LDB(B1, 1, 1); PG8_SCHED; PG8_LDA(At, 1, 0); PG8_STAGE(PG8_SA(0, 1), a2 + hstepA, voffA);
            PG8_WAIT_V(8); PG8_WAIT_L(0); PG8_BAR; PG8_MMA(0, 0, At, B0); PG8_MMA(0, 1, At, B1); PG8_BAR; PG8_SCHED;
            PG8_LDA(At, 1, 1); PG8_STAGE(PG8_SB(1, 0), b3, voffB); PG8_STAGE(PG8_SB(1, 1), b3 + hstepB, voffB); PG8_STAGE(PG8_SA(1, 0), a3, voffA);
            PG8_WAIT_V(8); PG8_WAIT_L(0); PG8_BAR; PG8_MMA(1, 0, At, B0); PG8_MMA(1, 1, At, B1); PG8_BAR; PG8_SCHED;
        }
        if (wr == 0) PG8_BAR;
        {
            const int row0 = cur.pm * BM + wr * 64 + fr, col0 = cur.pn * BM + wc * 32 + 8 * fq;
            float rs[2][4]; f32x4 cs[2][2];
            if constexpr (Epi::PRE) E.pre(cur.gid, row0, col0, rs, cs);
            bool stat = false; PG8_LAS float* XS = (PG8_LAS float*)(lds + 131072 + 512);
            if constexpr (Epi::ROWSTAT) { if (E.want_stat(cur.gid, cur.pn)) {
                stat = true;
#pragma unroll
                for (int ai = 0; ai < 2; ++ai)
#pragma unroll
                    for (int m = 0; m < 4; ++m)
#pragma unroll
                        for (int bj = 0; bj < 2; ++bj) { const f32x4 v0 = acc_f<I8>(acc[ai][bj][m][0]), v1 = acc_f<I8>(acc[ai][bj][m][1]);
                            float ss = (v0[0] * v0[0] + v0[1] * v0[1]) + (v0[2] * v0[2] + v0[3] * v0[3]) + (v1[0] * v1[0] + v1[1] * v1[1]) + (v1[2] * v1[2] + v1[3] * v1[3]);
                            ss = swap_add16(ss, ss); ss = swap_add32(ss, ss);
                            if (fq == 0) XS[(wc * 256 + ai * 128 + wr * 64 + m * 16 + fr) * 2 + bj] = ss; }
                asm volatile("s_waitcnt lgkmcnt(0)" ::: "memory"); __builtin_amdgcn_s_barrier(); asm volatile("" ::: "memory");
            } }
            if constexpr (Epi::AUX) {
                u32x4 axn[2]; E.aux(cur.gid, row0, col0, axn);
#pragma unroll
                for (int k = 0; k < 16; ++k) { const int ai = k >> 3, m = (k >> 1) & 3, bj = k & 1; u32x4 ax[2] = {axn[0], axn[1]};
                    if (k + 1 < 16) E.aux(cur.gid, row0 + ((k + 1) >> 3) * HALF + (((k + 1) >> 1) & 3) * 16, col0 + ((k + 1) & 1) * HALF, axn);
                    const f32x4 v0 = acc_f<I8>(acc[ai][bj][m][0]), v1 = acc_f<I8>(acc[ai][bj][m][1]);
                    float v[8] = {v0[0], v0[1], v0[2], v0[3], v1[0], v1[1], v1[2], v1[3]};
                    if (E.apply(cur.gid, row0 + ai * HALF + m * 16, col0 + bj * HALF, v, ax)) { acc[ai][bj][m][0] = (f32x4){v[0], v[1], v[2], v[3]}; acc[ai][bj][m][1] = (f32x4){v[4], v[5], v[6], v[7]}; } }
            } else
#pragma unroll
            for (int ai = 0; ai < 2; ++ai)
#pragma unroll
                for (int m = 0; m < 4; ++m)
#pragma unroll
                    for (int bj = 0; bj < 2; ++bj) {
                        const f32x4 v0 = acc_f<I8>(acc[ai][bj][m][0]), v1 = acc_f<I8>(acc[ai][bj][m][1]);
                        float v[8] = {v0[0], v0[1], v0[2], v0[3], v1[0], v1[1], v1[2], v1[3]};
                        if constexpr (Epi::XFORM) { if (E.xform(cur.gid, row0 + ai * HALF + m * 16, col0 + bj * HALF, v)) {
                            acc[ai][bj][m][0] = (f32x4){v[0], v[1], v[2], v[3]}; acc[ai][bj][m][1] = (f32x4){v[4], v[5], v[6], v[7]}; } }
                        else if constexpr (Epi::ROWSTAT) { float ss = 0.f; if (stat) { const int rl = (ai * 128 + wr * 64 + m * 16 + fr) * 2 + bj; ss = (XS[rl] + XS[512 + rl]) + (XS[1024 + rl] + XS[1536 + rl]); }
                            E(cur.gid, row0 + ai * HALF + m * 16, col0 + bj * HALF, v, ss, rs[ai][m], cs[bj]); }
                        else if constexpr (Epi::PRE) E(cur.gid, row0 + ai * HALF + m * 16, col0 + bj * HALF, v, rs[ai][m], cs[bj]);
                        else E(cur.gid, row0 + ai * HALF + m * 16, col0 + bj * HALF, v);
                    }
        }
        if (!has_next) break;
        bool keep = false; if constexpr (Epi::XFORM || Epi::AUX) keep = E.keep(cur.gid);
        if (!keep) {
#pragma unroll
        for (int a = 0; a < 2; ++a)
#pragma unroll
            for (int b = 0; b < 2; ++b)
#pragma unroll
                for (int m = 0; m < 4; ++m)
#pragma unroll
                    for (int n = 0; n < 2; ++n) acc[a][b][m][n] = (f32x4){0.f, 0.f, 0.f, 0.f};
        }
        cur = nxt; cA = nA; cB = nB; ++ui;
        if (wr == 1) PG8_BAR;
    }
    PG8_WAIT_V(0);
    PG8_BAR;
#undef PG8_SA
#undef PG8_SB
#undef PG8_STAGE
#undef PG8_LDA
#undef PG8_LDB
#undef PG8_MMA
#undef PG8_WAIT_V
#undef PG8_WAIT_L
#undef PG8_BAR
#undef PG8_SCHED
}
}


namespace att {
typedef short bf16x8 __attribute__((ext_vector_type(8)));
typedef short s16x4 __attribute__((ext_vector_type(4)));
typedef float f32x16 __attribute__((ext_vector_type(16)));
typedef PG8_LAS const char* lptr;
constexpr int KROWB = 384, SHM_K = 64 * KROWB, SHM_V = 64 * 256;
constexpr int L_K = 0, L_V = 2 * SHM_K, L_WS = L_V + 2 * SHM_V, L_END = L_WS + 8 * 256;
constexpr float THRL = 11.5f;
__device__ __forceinline__ int crow(int r, int hi) { return (r & 3) + 8 * (r >> 2) + 4 * hi; }
__device__ __forceinline__ unsigned cvtpk(float lo, float hi) { unsigned r; asm volatile("v_cvt_pk_bf16_f32 %0, %1, %2" : "=v"(r) : "v"(lo), "v"(hi)); return r; }
__device__ __forceinline__ int v_rd_base(int lane) { return ((lane & 3) << 3) | (((lane >> 2) & 3) << 6) | (((lane >> 4) & 1) << 5) | (((lane >> 5) & 1) << 8); }
constexpr int v_rd_off(int d0, int ks, int half) { return d0 * 512 + ks * 4096 + half * 2048; }
__device__ __forceinline__ void partialSM(f32x16& p0, f32x16& p1, float& m_reg, float& alpha) {
    float pmax = p0[0];
#pragma unroll
    for (int r = 1; r < 16; ++r) pmax = fmaxf(pmax, p0[r]);
#pragma unroll
    for (int r = 0; r < 16; ++r) pmax = fmaxf(pmax, p1[r]);
    { auto rr = __builtin_amdgcn_permlane32_swap(__float_as_uint(pmax), __float_as_uint(pmax), false, false); pmax = fmaxf(__uint_as_float(rr[0]), __uint_as_float(rr[1])); }
    float mn;
    if (__builtin_expect(__all(pmax - m_reg <= THRL), 1)) { mn = m_reg; alpha = 1.f; }
    else { mn = fmaxf(m_reg, pmax); alpha = __builtin_amdgcn_exp2f(m_reg - mn); m_reg = mn; }
#pragma unroll
    for (int r = 0; r < 16; ++r) { p0[r] = __builtin_amdgcn_exp2f(p0[r] - mn); p1[r] = __builtin_amdgcn_exp2f(p1[r] - mn); }
}
__device__ __forceinline__ void finishSM(const f32x16& p0, const f32x16& p1, float alpha, float& l_reg, bf16x8& pa0, bf16x8& pa1, bf16x8& pa2, bf16x8& pa3) {
    float ps = 0.f;
#pragma unroll
    for (int r = 0; r < 16; ++r) ps += p0[r] + p1[r];
    { auto rr = __builtin_amdgcn_permlane32_swap(__float_as_uint(ps), __float_as_uint(ps), false, false); ps = __uint_as_float(rr[0]) + __uint_as_float(rr[1]); }
    l_reg = l_reg * alpha + ps;
#define PK4(P, B_, OUT) do { unsigned a0 = cvtpk(P[B_+0], P[B_+1]), a1 = cvtpk(P[B_+2], P[B_+3]); unsigned b0 = cvtpk(P[B_+4], P[B_+5]), b1 = cvtpk(P[B_+6], P[B_+7]); \
        auto r0 = __builtin_amdgcn_permlane32_swap(a0, b0, false, false); auto r1 = __builtin_amdgcn_permlane32_swap(a1, b1, false, false); \
        u32x4 w = {r0[0], r1[0], r0[1], r1[1]}; OUT = __builtin_bit_cast(bf16x8, w); } while (0)
    PK4(p0, 0, pa0); PK4(p0, 8, pa1); PK4(p1, 0, pa2); PK4(p1, 8, pa3);
#undef PK4
}
template <int KB>
__device__ __forceinline__ void qkt(f32x16& p0, f32x16& p1, lptr K_lds, int r32, int hi, const bf16x8* qr) {
    p0 = f32x16{}; p1 = f32x16{};
    lptr kb[4];
#pragma unroll
    for (int dd = 0; dd < 4; ++dd) kb[dd] = K_lds + KB * SHM_K + r32 * KROWB + (((dd * 16 + hi * 8) * 2) ^ ((r32 & 7) << 4));
#pragma unroll
    for (int d0 = 0; d0 < 12; ++d0) { lptr a = kb[d0 & 3] + (d0 >> 2) * 128;
        const bf16x8 b0 = *(const PG8_LAS bf16x8*)a, b1 = *(const PG8_LAS bf16x8*)(a + 32 * KROWB);
        p0 = __builtin_amdgcn_mfma_f32_32x32x16_bf16(b0, qr[d0], p0, 0, 0, 0);
        p1 = __builtin_amdgcn_mfma_f32_32x32x16_bf16(b1, qr[d0], p1, 0, 0, 0); }
}
template <int VB>
__device__ __forceinline__ void pv_tile(f32x16* o, int vb0, bf16x8 pa0, bf16x8 pa1, bf16x8 pa2, bf16x8 pa3) {
#define TRRD(dst, off) asm volatile("ds_read_b64_tr_b16 %0, %1 offset:%2" : "=&v"(dst) : "v"(vb0), "i"(off) : "memory")
#define PV_D0(d0) do { s16x4 l0, l1, l2, l3, h0, h1, h2, h3; constexpr int b_ = VB * SHM_V + v_rd_off(d0, 0, 0); \
        TRRD(l0, b_); TRRD(h0, b_ + 2048); TRRD(l1, b_ + 4096); TRRD(h1, b_ + 6144); TRRD(l2, b_ + 8192); TRRD(h2, b_ + 10240); TRRD(l3, b_ + 12288); TRRD(h3, b_ + 14336); \
        asm volatile("s_waitcnt lgkmcnt(0)" ::: "memory"); __builtin_amdgcn_sched_barrier(0); \
        o[d0] = __builtin_amdgcn_mfma_f32_32x32x16_bf16(pa0, (bf16x8){l0[0], l0[1], l0[2], l0[3], h0[0], h0[1], h0[2], h0[3]}, o[d0], 0, 0, 0); \
        o[d0] = __builtin_amdgcn_mfma_f32_32x32x16_bf16(pa1, (bf16x8){l1[0], l1[1], l1[2], l1[3], h1[0], h1[1], h1[2], h1[3]}, o[d0], 0, 0, 0); \
        o[d0] = __builtin_amdgcn_mfma_f32_32x32x16_bf16(pa2, (bf16x8){l2[0], l2[1], l2[2], l2[3], h2[0], h2[1], h2[2], h2[3]}, o[d0], 0, 0, 0); \
        o[d0] = __builtin_amdgcn_mfma_f32_32x32x16_bf16(pa3, (bf16x8){l3[0], l3[1], l3[2], l3[3], h3[0], h3[1], h3[2], h3[3]}, o[d0], 0, 0, 0); } while (0)
    PV_D0(0); PV_D0(1); PV_D0(2); PV_D0(3);
#undef PV_D0
#undef TRRD
}
struct Tens { const bf16_t* QC; const bf16_t* KN; const bf16_t* KPE; const bf16_t* V; bf16_t* YA; const float* qn_nope; const float* qn_pe; const float* RT; };
__device__ __forceinline__ void attn_unit(PG8_LAS unsigned char* lds, const Tens& T, int b, int hh, int qb, int round, int wv) {
    int tid_ = wv * 64 + lane_id(); asm volatile("" : "+v"(tid_));
    const int tid = tid_, wid = __builtin_amdgcn_readfirstlane(tid >> 6), lane = tid & 63, r32 = lane & 31, hi = lane >> 5;
    const int NT = 4 * qb + 5, last_act = 4 * qb + (wid >> 1) + 1;
    unsigned koff[3]; bool kpe[3]; unsigned voff[2];
#pragma unroll
    for (int i = 0; i < 3; ++i) { const int p16 = (i * 8 + wid) * 64 + lane, row = p16 / 24, cp = p16 % 24, c = (cp & ~7) | ((cp & 7) ^ (row & 7));
        kpe[i] = c >= 16; koff[i] = kpe[i] ? (unsigned)(row * ROPE + (c - 16) * 8) * 2u : (unsigned)(row * 512 + hh * NOPE + c * 8) * 2u; }
#pragma unroll
    for (int i = 0; i < 2; ++i) { const int p16 = (i * 8 + wid) * 64 + lane, sub = p16 >> 5, kk = (sub >> 2) * 8 + ((p16 >> 2) & 7), cc = (sub & 3) * 32 + (p16 & 3) * 8;
        const int k = (kk & ~0xC) | ((kk & 4) << 1) | ((kk & 8) >> 1); voff[i] = (unsigned)(k * 512 + hh * 128 + cc) * 2u; }
    const unsigned ldsw = (unsigned)wid * 1024u;
#define ATT_DMA(jt, buf) do { const int kbase_ = (jt) == 0 ? M : b * SEQ + 64 * ((jt) - 1); \
        const char* kn_ = (const char*)(T.KN + (size_t)kbase_ * 512); const char* kp_ = (const char*)(T.KPE + (size_t)kbase_ * ROPE); const char* vv_ = (const char*)(T.V + (size_t)kbase_ * 512); \
        _Pragma("unroll") for (int i_ = 0; i_ < 3; ++i_) __builtin_amdgcn_global_load_lds((const unsigned*)((kpe[i_] ? kp_ : kn_) + koff[i_]), (PG8_LAS unsigned*)(lds + L_K + (buf) * SHM_K + ldsw + i_ * 8192), 16, 0, 0); \
        _Pragma("unroll") for (int i_ = 0; i_ < 2; ++i_) __builtin_amdgcn_global_load_lds((const unsigned*)(vv_ + voff[i_]), (PG8_LAS unsigned*)(lds + L_V + (buf) * SHM_V + ldsw + i_ * 8192), 16, 0, 0); } while (0)
    ATT_DMA(0, 0);
    const bf16_t* Qw = T.QC + (size_t)(b * SEQ + qb * 256 + wid * 32 + r32) * 768 + hh * QKD + hi * 8;
    bf16x8 qr[12];
#pragma unroll
    for (int d0 = 0; d0 < 12; ++d0) qr[d0] = *(const bf16x8*)(Qw + d0 * 16);
    {
        float ssn = 0.f, ssp = 0.f;
#pragma unroll
        for (int d0 = 0; d0 < 12; ++d0) { float f[8]; unpack8(__builtin_bit_cast(u32x4, qr[d0]), f); float t = 0.f;
#pragma unroll
            for (int j = 0; j < 8; ++j) t += f[j] * f[j];
            if (d0 < 8) ssn += t; else ssp += t; }
        ssn = swap_add32(ssn, ssn); ssp = swap_add32(ssp, ssp);
        const float rn = rsqrtf(ssn * (1.f / NOPE) + EPS) * SCL2, rp = rsqrtf(ssp * (1.f / ROPE) + EPS) * SCL2;
#pragma unroll
        for (int d0 = 0; d0 < 8; ++d0) { float f[8]; unpack8(__builtin_bit_cast(u32x4, qr[d0]), f);
            const f32x4 g0 = *(const f32x4*)(T.qn_nope + d0 * 16 + hi * 8), g1 = *(const f32x4*)(T.qn_nope + d0 * 16 + hi * 8 + 4);
            f[0] *= rn * g0.x; f[1] *= rn * g0.y; f[2] *= rn * g0.z; f[3] *= rn * g0.w; f[4] *= rn * g1.x; f[5] *= rn * g1.y; f[6] *= rn * g1.z; f[7] *= rn * g1.w;
            qr[d0] = __builtin_bit_cast(bf16x8, pack8(f)); }
        const int pos = qb * 256 + wid * 32 + r32 + NMETA;
#pragma unroll
        for (int dd = 0; dd < 2; ++dd) { float x1[8], x2[8]; unpack8(__builtin_bit_cast(u32x4, qr[8 + dd]), x1); unpack8(__builtin_bit_cast(u32x4, qr[10 + dd]), x2);
            const int c0 = dd * 16 + hi * 8;
#pragma unroll
            for (int j = 0; j < 8; ++j) { const float y1 = x1[j] * rp * T.qn_pe[c0 + j], y2 = x2[j] * rp * T.qn_pe[c0 + j + 32];
                const float cs = T.RT[(pos * RH + c0 + j) * 2], sn = T.RT[(pos * RH + c0 + j) * 2 + 1];
                x1[j] = y1 * cs - y2 * sn; x2[j] = y2 * cs + y1 * sn; }
            qr[8 + dd] = __builtin_bit_cast(bf16x8, pack8(x1)); qr[10 + dd] = __builtin_bit_cast(bf16x8, pack8(x2)); }
    }
    float m_reg = -1e30f, l_reg = 0.f; f32x16 o[4] = {};
    PG8_LAS float* wsf = (PG8_LAS float*)(lds + L_WS) + wid * 64;
    const lptr K_lds = (lptr)(lds + L_K);
    const int vb0 = (int)(uintptr_t)(lds + L_V) + v_rd_base(lane);
    asm volatile("s_waitcnt vmcnt(0)" ::: "memory"); __builtin_amdgcn_s_barrier(); asm volatile("" ::: "memory");
#define ATT_TILE(KB, t) do { if ((t) + 1 < NT) ATT_DMA((t) + 1, 1 - (KB)); \
        if ((t) <= last_act) { f32x16 p0, p1; qkt<KB>(p0, p1, K_lds, r32, hi, qr); \
            if ((t) == 0) { const float NEG = -__builtin_inff(); _Pragma("unroll") for (int r = 0; r < 16; ++r) { if (crow(r, hi) >= NMETA) p0[r] = NEG; p1[r] = NEG; } } \
            float alpha; partialSM(p0, p1, m_reg, alpha); \
            if (__any(alpha < 1.f)) { if (hi == 0) wsf[r32] = alpha; asm volatile("s_waitcnt lgkmcnt(0)" ::: "memory"); \
                _Pragma("unroll") for (int d_ = 0; d_ < 4; ++d_) _Pragma("unroll") for (int r = 0; r < 16; ++r) o[d_][r] *= wsf[crow(r, hi)]; } \
            bf16x8 pa0, pa1, pa2, pa3; finishSM(p0, p1, alpha, l_reg, pa0, pa1, pa2, pa3); __builtin_amdgcn_sched_barrier(0); \
            pv_tile<KB>(o, vb0, pa0, pa1, pa2, pa3); } \
        asm volatile("s_waitcnt vmcnt(0) lgkmcnt(0)" ::: "memory"); __builtin_amdgcn_s_barrier(); asm volatile("" ::: "memory"); } while (0)
    for (int t = 0; t < NT; t += 2) { ATT_TILE(0, t); if (t + 1 < NT) ATT_TILE(1, t + 1); }
#undef ATT_TILE
#undef ATT_DMA
    if (hi == 0) wsf[32 + r32] = l_reg; asm volatile("s_waitcnt lgkmcnt(0)" ::: "memory");
    bf16_t* Ow = T.YA + (size_t)(b * SEQ + qb * 256 + wid * 32) * D + (round * 4 + hh) * 128;
#pragma unroll
    for (int r = 0; r < 16; ++r) { const int orow = crow(r, hi); const float rl = __builtin_amdgcn_rcpf(wsf[32 + orow]);
#pragma unroll
        for (int d0 = 0; d0 < 4; ++d0) { const float v = o[d0][r] * rl, vn = dpp_f<0xB1>(v);
            if ((r32 & 1) == 0) *(unsigned*)(Ow + (size_t)orow * D + d0 * 32 + r32) = cvtpk(v, vn); } }
    asm volatile("s_waitcnt lgkmcnt(0)" ::: "memory"); __builtin_amdgcn_s_barrier(); asm volatile("" ::: "memory");
}
__device__ __forceinline__ void attn_phase(PG8_LAS unsigned char* lds, const Tens& T, int round, int G, int c, int wv) {
    for (int p = c; p < 256; p += G) {
        const int xcd = p & 7, j = p >> 3, x = j & 3, g = (j >> 2) * 8 + xcd, b = g >> 2, hh = g & 3;
        attn_unit(lds, T, b, hh, 7 - x, round, wv);
        attn_unit(lds, T, b, hh, x, round, wv);
    }
}
__device__ __forceinline__ void attn_phase_dyn(PG8_LAS unsigned char* lds, const Tens& T, int round, unsigned* ticket, volatile PG8_LAS unsigned* slot, int wv) {
    for (;;) {
        if (wv == 0 && lane_id() == 0) *slot = __hip_atomic_fetch_add(ticket, 1u, __ATOMIC_RELAXED, __HIP_MEMORY_SCOPE_AGENT);
        __syncthreads();
        const int u = (int)*slot;
        if (u >= 512) break;
        attn_unit(lds, T, (u & 63) >> 2, u & 3, 7 - (u >> 6), round, wv);
    }
}
}


namespace peer {
typedef _Float16 h2 __attribute__((ext_vector_type(2)));
__device__ __forceinline__ h2 as_h2(unsigned w) { return __builtin_bit_cast(h2, w); }
__device__ __forceinline__ void ins16(float (&t)[16], float x) {
#pragma unroll
    for (int i = 15; i >= 1; --i) t[i] = __builtin_amdgcn_fmed3f(t[i - 1], t[i], x);
    t[0] = fmaxf(t[0], x);
}
constexpr int TK_WAVE_LDS = 16384;
__device__ __forceinline__ void topk64(PG8_LAS float* wl, const bf16_t* __restrict__ S, const float* __restrict__ SSQ, int* __restrict__ IDX, float* __restrict__ GATE, int m0, int hd, bool tile, int lane) {
    {
        float ta[16], tb[16];
#pragma unroll
        for (int p = 0; p < 2; ++p) {
            float t[16];
#pragma unroll
            for (int i = 0; i < 16; ++i) t[i] = -__builtin_inff();
#pragma unroll 1
            for (int q = 0; q < 2; ++q) {
                u32x4 st[8];
#pragma unroll
                for (int j = 0; j < 8; ++j) { const int list = j * 8 + (lane >> 3);
                    st[j] = *(const u32x4*)(S + (size_t)(tile ? m0 + list : m0 + (list >> 3)) * 2048 + (tile ? hd : (list & 7)) * 256 + p * 128 + q * 64 + (lane & 7) * 8); }
#pragma unroll
                for (int j = 0; j < 8; ++j) { float f[8]; unpack8(st[j], f); PG8_LAS float* wp = wl + (j * 8 + (lane >> 3)) * 64 + (lane & 7) * 8;
                    *(PG8_LAS f32x4*)wp = (f32x4){f[0], f[1], f[2], f[3]}; *(PG8_LAS f32x4*)(wp + 4) = (f32x4){f[4], f[5], f[6], f[7]}; }
                asm volatile("s_waitcnt lgkmcnt(0)" ::: "memory");
#pragma unroll 8
                for (int i = 0; i < 64; ++i) { const int e = (i + lane) & 63; const float x = wl[lane * 64 + e];
                    ins16(t, __uint_as_float((__float_as_uint(x) & ~127u) | (unsigned)(q * 64 + e))); }
                asm volatile("s_waitcnt lgkmcnt(0)" ::: "memory");
            }
#pragma unroll
            for (int i = 0; i < 16; ++i) { if (p == 0) ta[i] = t[i]; else tb[i] = t[i]; }
        }
        PG8_LAS int* wi = (PG8_LAS int*)wl + lane * 33;
#pragma unroll
        for (int i = 0; i < 16; ++i) { wi[i] = (int)(__float_as_uint(ta[i]) & 127u); wi[16 + i] = (int)(__float_as_uint(tb[i]) & 127u);
            ta[i] = __uint_as_float(__float_as_uint(ta[i]) & ~127u); tb[i] = __uint_as_float(__float_as_uint(tb[i]) & ~127u); }
        float tc[16];
#pragma unroll
        for (int i = 0; i < 16; ++i) tc[i] = -__builtin_inff();
#pragma unroll
        for (int i = 0; i < 16; ++i)
#pragma unroll
            for (int j = 0; j < 16; ++j) if ((i + 1) * (j + 1) <= 16) ins16(tc, __uint_as_float((__float_as_uint(ta[i] + tb[j]) & ~255u) | (unsigned)(i * 16 + j)));
        asm volatile("s_waitcnt lgkmcnt(0)" ::: "memory");
        float g[16]; int id[16]; float sum = 0.f;
        const float mx = __uint_as_float(__float_as_uint(tc[0]) & ~255u);
        const int mtok = tile ? m0 + lane : m0 + (lane >> 3), mhd = tile ? hd : (lane & 7);
        float r2; { const float* sp = SSQ + (size_t)mtok * 32; float t = 0.f;
#pragma unroll
            for (int i = 0; i < 8; ++i) { const f32x4 q = *(const f32x4*)(sp + 4 * i); t += (q.x + q.y) + (q.z + q.w); }
            r2 = rsqrtf(t * (1.f / D) + EPS); }
#pragma unroll
        for (int k = 0; k < 16; ++k) { const unsigned key = __float_as_uint(tc[k]); const int pos = (int)(key & 255u);
            id[k] = wi[pos >> 4] * 128 + wi[16 + (pos & 15)]; g[k] = __expf((__uint_as_float(key & ~255u) - mx) * r2); sum += g[k]; }
        const float inv = 1.f / sum;
        const size_t o = ((size_t)mtok * 8 + mhd) * 16;
#pragma unroll
        for (int k = 0; k < 16; k += 4) { *(f32x4*)(GATE + o + k) = (f32x4){g[k] * inv, g[k + 1] * inv, g[k + 2] * inv, g[k + 3] * inv};
            *(u32x4*)(IDX + o + k) = (u32x4){(unsigned)id[k], (unsigned)id[k + 1], (unsigned)id[k + 2], (unsigned)id[k + 3]}; }
        asm volatile("s_waitcnt lgkmcnt(0)" ::: "memory");
    }
}
constexpr float PEER_SU = 94.4f, PEER_SV = 5.883f;
struct __attribute__((packed, aligned(4))) U3 { unsigned x, y, z; };
typedef unsigned u32x6 __attribute__((ext_vector_type(6)));
typedef float f32x32 __attribute__((ext_vector_type(32)));
typedef float f32x2 __attribute__((ext_vector_type(2)));
__device__ __forceinline__ float gelu_erf(float x) {
    const float z = fabsf(x) * 0.70710678118654752f, t = __builtin_amdgcn_rcpf(fmaf(0.3275911f, z, 1.f));
    const float pl = t * fmaf(t, fmaf(t, fmaf(t, fmaf(t, 1.061405429f, -1.453152027f), 1.421413741f), -0.284496736f), 0.254829592f);
    const float e = 1.f - pl * __expf(-z * z);
    return 0.5f * x * (1.f + (x < 0.f ? -e : e));
}
__device__ __forceinline__ int row3(int idx) { int t; asm("v_lshl_add_u32 %0, %1, 1, %1" : "=v"(t) : "v"(idx)); return t << 8; }
__device__ __forceinline__ void gather1s_phase(PG8_LAS unsigned char* lds, const bf16_t* __restrict__ HN, const int* __restrict__ IDX, const float* __restrict__ GATE, const unsigned char* __restrict__ U8, const unsigned char* __restrict__ V8, const float* __restrict__ SSQ, float* out, int G, int c, int wv) {
    int tid_ = wv * 64 + lane_id(); asm volatile("" : "+v"(tid_));
    const int lane = tid_ & 63, wid = wv;
    typedef unsigned u32x2_ __attribute__((ext_vector_type(2)));
    PG8_LAS u32x2_* LW = (PG8_LAS u32x2_*)(lds + wid * 2048);
#pragma unroll
    for (int i = 0; i < 4; ++i) LW[64 * i + lane] = (u32x2_){0u, 0u};
    const int m0 = c * 8 + wid, mstep = G * 8, l12 = 12 * lane, l8 = 8 * lane;
    if (m0 >= M) return;
#define LOAD_TOK(mm, lane) do { pi0 = IDX[(size_t)(mm) * 128 + lane]; pi1 = IDX[(size_t)(mm) * 128 + 64 + lane]; pg0 = GATE[(size_t)(mm) * 128 + lane]; pg1 = GATE[(size_t)(mm) * 128 + 64 + lane]; } while (0)
#define LOAD_HN(mm, lane) do { hp0 = *(const u32x4*)(HN + (size_t)(mm) * D + 16 * lane); hp1 = *(const u32x4*)(HN + (size_t)(mm) * D + 16 * lane + 8); pss = lane < 32 ? SSQ[(size_t)(mm) * 32 + lane] : 0.f; } while (0)
#define BUILD_LIST(base) do { const int i0_ = pi0, i1_ = pi1; const float g0_ = pg0, g1_ = pg1; \
          int cnt = (base); \
          _Pragma("unroll 1") for (int sl = 0; sl < 16; ++sl) { \
              const bool q0 = (i0_ >> 10) == sl, q1 = (i1_ >> 10) == sl; const unsigned long long k0 = __ballot(q0), k1 = __ballot(q1); \
              if (q0) LW[cnt + (int)__builtin_amdgcn_mbcnt_hi((unsigned)(k0 >> 32), __builtin_amdgcn_mbcnt_lo((unsigned)k0, 0u))] = (u32x2_){(unsigned)i0_, __float_as_uint(g0_)}; \
              cnt += __builtin_popcountll(k0); \
              if (q1) LW[cnt + (int)__builtin_amdgcn_mbcnt_hi((unsigned)(k1 >> 32), __builtin_amdgcn_mbcnt_lo((unsigned)k1, 0u))] = (u32x2_){(unsigned)i1_, __float_as_uint(g1_)}; \
              cnt += __builtin_popcountll(k1); } \
          asm volatile("s_waitcnt lgkmcnt(0)" ::: "memory"); } while (0)
#define LOAD_ROWS(dst, TAB, e) do { _Pragma("unroll") for (int j = 0; j < 8; ++j) dst[j] = *(const U3*)(TAB + (size_t)(unsigned)(row3((int)LW[(e) + j].x) + l12)); asm volatile("" ::: "memory"); } while (0)
    int pi0, pi1; float pg0, pg1, pss; u32x4 hp0, hp1;
    LOAD_TOK(m0, lane); BUILD_LIST(0); LOAD_HN(m0, lane);
    if (m0 + mstep < M) LOAD_TOK(m0 + mstep, lane);
    #define LOAD_ROWS4(dst, TAB, e) do { _Pragma("unroll") for (int j = 0; j < 8; ++j) dst[j] = *(const u32x2_*)(TAB + (size_t)(unsigned)(__mul24((int)LW[(e) + j].x, 512) + l8)); asm volatile("" ::: "memory"); } while (0)
    u32x2_ ub0[8], ub1[8], vb0[8];
    LOAD_ROWS4(ub0, U8, 0); LOAD_ROWS4(vb0, V8, 0); LOAD_ROWS4(ub1, U8, 8);
    int ring = 0;
#pragma unroll 1
    for (int m = m0; m < M; m += mstep) {
        f32x2 hn[8], acc[8]; unsigned hq1[2], hq2[2]; float hs1, hs2;
        int ln = lane; asm volatile("" : "+v"(ln));
        const float ssq = pss;
        { float f[16]; unpack8(hp0, f); unpack8(hp1, f + 8);
#pragma unroll
          for (int i = 0; i < 8; ++i) { hn[i] = (f32x2){f[2 * i], f[2 * i + 1]}; acc[i] = (f32x2){0.f, 0.f}; }
          float am = 0.f;
#pragma unroll
          for (int i = 0; i < 16; ++i) am = fmaxf(am, fabsf(f[i]));
          { const u32x2 r_ = __builtin_amdgcn_permlane32_swap(__float_as_uint(am), __float_as_uint(am), false, false); am = fmaxf(__uint_as_float(r_.x), __uint_as_float(r_.y)); }
          { const u32x2 r_ = __builtin_amdgcn_permlane16_swap(__float_as_uint(am), __float_as_uint(am), false, false); am = fmaxf(__uint_as_float(r_.x), __uint_as_float(r_.y)); }
          am = fmaxf(am, dpp_f<0x128>(am)); am = fmaxf(am, dpp_f<0xB1>(am)); am = fmaxf(am, dpp_f<0x4E>(am)); am = fmaxf(am, dpp_f<0x141>(am));
          hs1 = fmaxf(am, 1e-20f) * (1.f / 7.5f); hs2 = hs1 * (1.f / 16.f); const float i1_ = 1.f / hs1, i2_ = 1.f / hs2;
          hq1[0] = hq1[1] = hq2[0] = hq2[1] = 0u;
#pragma unroll
          for (int i = 0; i < 16; ++i) { const float q1 = fminf(fmaxf(__builtin_rintf(f[i] * i1_), -8.f), 7.f), rr = f[i] - q1 * hs1, q2 = fminf(fmaxf(__builtin_rintf(rr * i2_), -8.f), 7.f);
              hq1[i >> 3] |= ((unsigned)(int)q1 & 15u) << (4 * (i & 7)); hq2[i >> 3] |= ((unsigned)(int)q2 & 15u) << (4 * (i & 7)); } }
        float sq = swap_add16(swap_add32(ssq, ssq), swap_add32(ssq, ssq)); sq += dpp_f<0x128>(sq); sq += dpp_f<0xB1>(sq); sq += dpp_f<0x4E>(sq); sq += dpp_f<0x141>(sq);
        const float r2su = rsqrtf(sq * (1.f / D) + EPS) * (1.f / PEER_SU);
        if (m + mstep < M) { BUILD_LIST(ring ^ 128); LOAD_HN(m + mstep, ln); if (m + 2 * mstep < M) LOAD_TOK(m + 2 * mstep, ln); }
#define F4ACC(vb, b) { acc[4 * w + b] = __builtin_elementwise_fma((f32x2){a, a}, __builtin_amdgcn_cvt_scalef32_pk_f32_fp4(vb[j][w], 1.0f, b), acc[4 * w + b]); }
#define ACC_ROWS(vb, ap, j0, j1) do { _Pragma("unroll") for (int j = j0; j < j1; ++j) { const float a = __builtin_bit_cast(float, __builtin_amdgcn_readlane(__builtin_bit_cast(int, ap), j * 8)); \
                _Pragma("unroll") for (int w = 0; w < 2; ++w) { F4ACC(vb, 0) F4ACC(vb, 1) F4ACC(vb, 2) F4ACC(vb, 3) } } } while (0)
#define DOT8(ub, d) do { _Pragma("unroll") for (int j = 0; j < 8; ++j) {     \
                const int d1_ = __builtin_amdgcn_sdot8((int)ub[j].y, (int)hq1[1], __builtin_amdgcn_sdot8((int)ub[j].x, (int)hq1[0], 0, false), false); \
                const int d2_ = __builtin_amdgcn_sdot8((int)ub[j].y, (int)hq2[1], __builtin_amdgcn_sdot8((int)ub[j].x, (int)hq2[0], 0, false), false); \
                d[j] = fmaf((float)d2_, hs2, (float)d1_ * hs1); } } while (0)
#define GSTEP(ub, vb, k, HAVE_PREV) do { const int e0 = ring + (k) * 8, e2 = (e0 + 16) & 255, e1 = (e0 + 8) & 255; \
            float d[8]; DOT8(ub, d); \
            asm volatile("" ::: "memory"); \
            LOAD_ROWS4(ub, U8, e2); \
            float s4[4], s2[2], s1; \
            if (HAVE_PREV) ACC_ROWS(vb, actp, 0, 1); \
            _Pragma("unroll") for (int j = 0; j < 4; ++j) s4[j] = swap_add32(d[j], d[j + 4]); \
            if (HAVE_PREV) ACC_ROWS(vb, actp, 1, 2); \
            _Pragma("unroll") for (int j = 0; j < 2; ++j) s2[j] = swap_add16(s4[j], s4[j + 2]); \
            if (HAVE_PREV) ACC_ROWS(vb, actp, 2, 3); \
            { const bool up = lane & 8; const float keep = up ? s2[1] : s2[0], send = up ? s2[0] : s2[1]; s1 = keep + dpp_f<0x128>(send); } \
            if (HAVE_PREV) ACC_ROWS(vb, actp, 3, 4); \
            s1 += dpp_f<0xB1>(s1); s1 += dpp_f<0x4E>(s1); s1 += dpp_f<0x141>(s1); \
            s1 *= r2su; \
            if (HAVE_PREV) ACC_ROWS(vb, actp, 4, 5); \
            const float actn = gelu_erf(s1) * __uint_as_float(LW[e0 + (lane >> 3)].y) * (1.f / PEER_SV); \
            if (HAVE_PREV) { ACC_ROWS(vb, actp, 5, 8); \
                asm volatile("" ::: "memory"); \
                LOAD_ROWS4(vb, V8, e0); } \
            actp = actn; \
        } while (0)
        float actp;
        GSTEP(ub0, vb0, 0, false);
#pragma unroll 1
        for (int k = 1; k < 15; k += 2) { GSTEP(ub1, vb0, k, true); GSTEP(ub0, vb0, k + 1, true); }
        GSTEP(ub1, vb0, 15, true);
        ACC_ROWS(vb0, actp, 0, 8);
        asm volatile("" ::: "memory");
        LOAD_ROWS4(vb0, V8, (ring + 128) & 255);
#undef GSTEP
#undef DOT8
#undef ACC_ROWS
#undef F4ACC
        int lo_ = lane; asm volatile("" : "+v"(lo_));
        float* o = out + (size_t)m * D + 16 * lo_;
#pragma unroll
        for (int i = 0; i < 4; ++i) *(f32x4*)(o + 4 * i) = (f32x4){hn[2 * i].x + acc[2 * i].x, hn[2 * i].y + acc[2 * i].y, hn[2 * i + 1].x + acc[2 * i + 1].x, hn[2 * i + 1].y + acc[2 * i + 1].y};
        ring ^= 128;
    }
#undef LOAD_ROWS
#undef LOAD_ROWS4
#undef BUILD_LIST
#undef LOAD_TOK
#undef LOAD_HN
    asm volatile("s_waitcnt lgkmcnt(0)" ::: "memory");
}
}
namespace gla {
#define LDS_BARRIER() do { asm volatile("s_waitcnt lgkmcnt(0)" ::: "memory"); __builtin_amdgcn_s_barrier(); asm volatile("" ::: "memory"); } while (0)
typedef short bf16x8 __attribute__((ext_vector_type(8)));
typedef float f32x16 __attribute__((ext_vector_type(16)));
__device__ __forceinline__ int chunk_row0(int b, int c) { return c == 0 ? M : b * SEQ + 64 * (c - 1); }
__device__ __forceinline__ int ppos(int d) { const int g = (d >> 2) & 3; return (d & ~12) | ((g == 1 ? 2 : (g == 2 ? 1 : g)) << 2); }
__device__ __forceinline__ unsigned cvtpk(float lo, float hi) { unsigned r; asm volatile("v_cvt_pk_bf16_f32 %0, %1, %2" : "=v"(r) : "v"(lo), "v"(hi)); return r; }
struct Tens { bf16_t* GQ; bf16_t* GKT; const bf16_t* GVT; bf16_t* GQo; bf16_t* GKTo; int var; const bf16_t* P0; const float* w_a2; const float* b_a; bf16_t* AG; float* DECL; bf16_t* OG; };
constexpr int PQROW = 136;
constexpr int BMROW = 132;
constexpr int P_GAL = 0, P_TOT = 2048, P_BM = 4096, P_QL = P_BM + 64 * BMROW * 4, P_KL = P_QL + 64 * PQROW * 2, P_END = P_KL + 64 * PQROW * 2;
struct PrepIn { u32x4 ga, kt0, kt1, q0, q1; };
__device__ __forceinline__ void prep_load(PrepIn& I, const Tens& T, int u, int tid) {
    const int b = u / 132, h = (u / 33) & 3, c = u % 33, row0 = chunk_row0(b, c), d = tid & 127, jq = tid >> 7, j = tid >> 3, c16 = tid & 7;
    I.ga = tid < 128 ? *(const u32x4*)(T.P0 + (size_t)(row0 + (tid >> 1)) * P0W + 704 + (tid & 1) * 8) : (u32x4){0u, 0u, 0u, 0u};
    const bf16_t* kt = T.GKT + (size_t)(h * GHK + d) * ME + row0 + jq * 16; I.kt0 = *(const u32x4*)kt; I.kt1 = *(const u32x4*)(kt + 8);
    const size_t g = (size_t)(row0 + j) * GDK + h * GHK + c16 * 16;
    I.q0 = *(const u32x4*)(T.GQ + g); I.q1 = *(const u32x4*)(T.GQ + g + 8);
}
__device__ __forceinline__ void prep_compute(PG8_LAS unsigned char* lds, const Tens& T, const PrepIn& I, const float (&w)[GR], float ba, int u, int tid, int wid, int lane) {
    const int b = u / 132, h = (u / 33) & 3, c = u % 33, row0 = chunk_row0(b, c), d = tid & 127, jq = tid >> 7, j = tid >> 3, c16 = tid & 7;
    PG8_LAS bf16_t* GAL = (PG8_LAS bf16_t*)(lds + P_GAL); PG8_LAS float* TOT = (PG8_LAS float*)(lds + P_TOT); PG8_LAS float* BM = (PG8_LAS float*)(lds + P_BM);
    PG8_LAS bf16_t* QL = (PG8_LAS bf16_t*)(lds + P_QL); PG8_LAS bf16_t* KL = (PG8_LAS bf16_t*)(lds + P_KL);
    if (tid < 128) *(PG8_LAS u32x4*)(GAL + (tid >> 1) * 16 + (tid & 1) * 8) = I.ga;
    LDS_BARRIER();
    float Bv[16]; float run = 0.f;
#pragma unroll
    for (int jj = 0; jj < 16; ++jj) { const int jt = jq * 16 + jj; float x = ba;
        const u32x4 g0 = *(const PG8_LAS u32x4*)(GAL + jt * 16), g1 = *(const PG8_LAS u32x4*)(GAL + jt * 16 + 8); float gf[16]; unpack8(g0, gf); unpack8(g1, gf + 8);
#pragma unroll
        for (int r = 0; r < GR; ++r) x += gf[r] * w[r];
        float la = (fminf(x, 0.f) - __logf(1.f + __expf(-fabsf(x)))) * (1.f / 16.f);
        if (c == 0 && jt >= NMETA) la = 0.f;
        run += la; Bv[jj] = run; }
    TOT[jq * 128 + d] = run;
    LDS_BARRIER();
    float base = 0.f, blast = 0.f;
#pragma unroll
    for (int g = 0; g < 4; ++g) { const float t = TOT[g * 128 + d]; blast += t; if (g < jq) base += t; }
#pragma unroll
    for (int jj = 0; jj < 16; ++jj) BM[(jq * 16 + jj) * BMROW + d] = base + Bv[jj];
    { float kf[16]; unpack8(I.kt0, kf); unpack8(I.kt1, kf + 8);
      const int pd = ppos(d);
#pragma unroll
      for (int jj = 0; jj < 16; ++jj) { const float e = __expf(-(base + Bv[jj])); KL[(jq * 16 + jj) * PQROW + pd] = f2bf(kf[jj] * e); kf[jj] *= e * __expf(blast); }
      bf16_t* kto = T.GKTo + (size_t)(h * GHK + d) * ME + row0 + jq * 16; if (T.var == 0) { *(u32x4*)kto = pack8(kf); *(u32x4*)(kto + 8) = pack8(kf + 8); } else if (kf[3] == 1.2345f) T.DECL[1] = 1.f; }
    if (jq == 0) T.DECL[(size_t)u * GHK + d] = __expf(blast);
    LDS_BARRIER();
    {
        float qf[16], bv[16]; unpack8(I.q0, qf); unpack8(I.q1, qf + 8);
#pragma unroll
        for (int i = 0; i < 4; ++i) { const f32x4 t = *(const PG8_LAS f32x4*)(BM + j * BMROW + c16 * 16 + 4 * i); bv[4 * i] = t.x; bv[4 * i + 1] = t.y; bv[4 * i + 2] = t.z; bv[4 * i + 3] = t.w; }
        float qo[16];
#pragma unroll
        for (int i = 0; i < 16; ++i) { const int p = (i & 3) | ((((i >> 2) == 1) ? 2 : ((i >> 2) == 2 ? 1 : (i >> 2))) << 2); qo[p] = qf[i] * GLA_QS * __expf(bv[i]); }
        const u32x4 qa = pack8(qo), qb = pack8(qo + 8);
        *(PG8_LAS u32x4*)(QL + j * PQROW + c16 * 16) = qa; *(PG8_LAS u32x4*)(QL + j * PQROW + c16 * 16 + 8) = qb;
        bf16_t* go = T.GQo + (size_t)(row0 + j) * GDK + h * GHK + c16 * 16; if (T.var == 0) { *(u32x4*)go = qa; *(u32x4*)(go + 8) = qb; } }
    LDS_BARRIER();
    { const int bi = wid >> 1, fr = lane & 15, fq = lane >> 4;
#pragma unroll
      for (int t = 0; t < 2; ++t) { const int bj = 2 * (wid & 1) + t; f32x4 acc = {0.f, 0.f, 0.f, 0.f};
#pragma unroll
        for (int s_ = 0; s_ < 4; ++s_) { const bf16x8 af = *(const PG8_LAS bf16x8*)(QL + (16 * bi + fr) * PQROW + 32 * s_ + 8 * fq), bf = *(const PG8_LAS bf16x8*)(KL + (16 * bj + fr) * PQROW + 32 * s_ + 8 * fq);
            acc = __builtin_amdgcn_mfma_f32_16x16x32_bf16(af, bf, acc, 0, 0, 0); }
#pragma unroll
        for (int r = 0; r < 4; ++r) { const int i = 16 * bi + fq * 4 + r, jc = 16 * bj + fr; if (T.var == 0) T.AG[((size_t)u * 64 + i) * 64 + jc] = f2bf(jc <= i ? acc[r] : 0.f); else if (acc[r] == 1.2345f) T.DECL[2] = 1.f; } } }
    LDS_BARRIER();
}
__device__ __forceinline__ int prep_unit_id(int k) { return k < NB * 4 * 32 ? (k >> 5) * 33 + 1 + (k & 31) : (k - NB * 4 * 32) * 33; }
__device__ __forceinline__ void prep_phase(PG8_LAS unsigned char* lds, const Tens& T, int G, int c, int wv) {
    int tid_ = wv * 64 + lane_id(); asm volatile("" : "+v"(tid_));
    const int tid = tid_, lane = tid & 63, wid = wv; constexpr int NK = NB * 4 * 32 + 4;
    if (c >= NK) return;
    PrepIn cur, nxt; prep_load(cur, T, prep_unit_id(c), tid);
    float w[GR], ba = 0.f; int hcur = -1;
#pragma unroll 1
    for (int k = c; k < NK; k += G) {
        const bool more = k + G < NK; const int u = prep_unit_id(k), h = (u / 33) & 3;
        if (more) prep_load(nxt, T, prep_unit_id(k + G), tid);
        if (h != hcur) { hcur = h; const int d = tid & 127;
#pragma unroll
            for (int r = 0; r < GR; ++r) w[r] = T.w_a2[r * GDK + h * GHK + d];
            ba = T.b_a[h * GHK + d]; }
        prep_compute(lds, T, cur, w, ba, u, tid, wid, lane);
        if (more) cur = nxt;
    }
}
constexpr int S_Q = 0, S_A = 64 * 272, S_K = S_A + 64 * 144, S_D = S_K + 128 * 144, S_BUF = S_D + 512;
__device__ __forceinline__ void scan_wg(PG8_LAS unsigned char* lds, const Tens& T, int b, int h, int wv) {
    int tid_ = wv * 64 + lane_id(); asm volatile("" : "+v"(tid_));
    const int tid = tid_, wid = __builtin_amdgcn_readfirstlane(tid >> 6), lane = tid & 63, r32 = lane & 31, hi = lane >> 5;
    f32x16 S[4];
#pragma unroll
    for (int i = 0; i < 4; ++i) S[i] = f32x16{};
    const int u0 = (b * 4 + h) * 33;
    u32x4 sq[2], sa, sk[2]; float sd = 0.f; bf16x8 vcur[4], vnxt[4];
    const bf16_t* vrow = T.GVT + (size_t)(h * GHV + 32 * wid + r32) * ME + 8 * hi;
#define GLA_LOAD(c_) do { const int row0_ = chunk_row0(b, (c_)); \
        _Pragma("unroll") for (int i = 0; i < 2; ++i) { const int ch = tid + i * 512; sq[i] = *(const u32x4*)(T.GQ + (size_t)(row0_ + (ch >> 4)) * GDK + h * GHK + (ch & 15) * 8); \
            sk[i] = *(const u32x4*)(T.GKT + (size_t)(h * GHK + (ch >> 3)) * ME + row0_ + (ch & 7) * 8); } \
        const int uc_ = (c_) == 0 ? h * 33 : u0 + (c_); sa = *(const u32x4*)(T.AG + ((size_t)uc_ * 64 + (tid >> 3)) * 64 + (tid & 7) * 8); if (tid < 128) sd = T.DECL[(size_t)uc_ * GHK + tid]; \
        _Pragma("unroll") for (int s_ = 0; s_ < 4; ++s_) vnxt[s_] = *(const bf16x8*)(vrow + row0_ + 16 * s_); } while (0)
#define GLA_WRITE(buf) do { PG8_LAS unsigned char* L_ = lds + (buf) * S_BUF; \
        _Pragma("unroll") for (int i = 0; i < 2; ++i) { const int ch = tid + i * 512; *(PG8_LAS u32x4*)(L_ + S_Q + (ch >> 4) * 272 + (ch & 15) * 16) = sq[i]; *(PG8_LAS u32x4*)(L_ + S_K + (ch >> 3) * 144 + (ch & 7) * 16) = sk[i]; } \
        *(PG8_LAS u32x4*)(L_ + S_A + (tid >> 3) * 144 + (tid & 7) * 16) = sa; if (tid < 128) *(PG8_LAS float*)(L_ + S_D + tid * 4) = sd; } while (0)
    GLA_LOAD(0); GLA_WRITE(0);
#pragma unroll
    for (int s_ = 0; s_ < 4; ++s_) vcur[s_] = vnxt[s_];
    LDS_BARRIER();
#pragma unroll 1
    for (int c = 0; c < 33; ++c) {
        if (c + 1 < 33) GLA_LOAD(c + 1);
        PG8_LAS unsigned char* L = lds + (c & 1) * S_BUF;
        f32x16 o[2];
#pragma unroll
        for (int ib = 0; ib < 2; ++ib) { o[ib] = f32x16{};
#pragma unroll
            for (int s_ = 0; s_ < 4; ++s_) { const bf16x8 af = *(const PG8_LAS bf16x8*)(L + S_A + (32 * ib + r32) * 144 + (16 * s_ + 8 * hi) * 2);
                o[ib] = __builtin_amdgcn_mfma_f32_32x32x16_bf16(af, vcur[s_], o[ib], 0, 0, 0); } }
#pragma unroll
        for (int s_ = 0; s_ < 8; ++s_) { const int db = s_ >> 1, t8 = 8 * (s_ & 1);
            u32x4 wv; wv.x = cvtpk(S[db][t8 + 0], S[db][t8 + 1]); wv.y = cvtpk(S[db][t8 + 2], S[db][t8 + 3]); wv.z = cvtpk(S[db][t8 + 4], S[db][t8 + 5]); wv.w = cvtpk(S[db][t8 + 6], S[db][t8 + 7]);
            const bf16x8 sf = __builtin_bit_cast(bf16x8, wv);
#pragma unroll
            for (int ib = 0; ib < 2; ++ib) { const bf16x8 qf = *(const PG8_LAS bf16x8*)(L + S_Q + (32 * ib + r32) * 272 + (16 * s_ + 8 * hi) * 2);
                o[ib] = __builtin_amdgcn_mfma_f32_32x32x16_bf16(qf, sf, o[ib], 0, 0, 0); } }
        if (c > 0) { bf16_t* Ow = T.OG + (size_t)chunk_row0(b, c) * D + h * GHV + 32 * wid;
#pragma unroll
            for (int ib = 0; ib < 2; ++ib)
#pragma unroll
                for (int r = 0; r < 16; ++r) { const int orow = 32 * ib + (r & 3) + 8 * (r >> 2) + 4 * hi; const float v = o[ib][r], vn = dpp_f<0xB1>(v);
                    if ((r32 & 1) == 0) *(unsigned*)(Ow + (size_t)orow * D + r32) = cvtpk(v, vn); } }
#pragma unroll
        for (int db = 0; db < 4; ++db) {
#pragma unroll
            for (int g = 0; g < 4; ++g) { const f32x4 dv = *(const PG8_LAS f32x4*)(L + S_D + (32 * db + 8 * g + 4 * hi) * 4);
                S[db][4 * g + 0] *= dv[0]; S[db][4 * g + 1] *= dv[1]; S[db][4 * g + 2] *= dv[2]; S[db][4 * g + 3] *= dv[3]; }
#pragma unroll
            for (int s_ = 0; s_ < 4; ++s_) { const bf16x8 kf = *(const PG8_LAS bf16x8*)(L + S_K + (32 * db + r32) * 144 + (16 * s_ + 8 * hi) * 2);
                S[db] = __builtin_amdgcn_mfma_f32_32x32x16_bf16(kf, vcur[s_], S[db], 0, 0, 0); } }
        if (c + 1 < 33) { GLA_WRITE((c + 1) & 1);
#pragma unroll
            for (int s_ = 0; s_ < 4; ++s_) vcur[s_] = vnxt[s_]; }
        LDS_BARRIER();
    }
#undef GLA_LOAD
#undef GLA_WRITE
}
}


#define XB_TMO      128
#define XB_XCNT(j)  (256  + 64 * (j))
#define XB_XSUB(j)  (1280 + 64 * (j))
#define XB_XGEN(j)  (2304 + 64 * (j))
#define XB_TOP      3328
#define XB_TOPGEN   3392
#define XCD_BAR_WORDS 3456
#define XB_SPIN_CAP (1u << 18)

__device__ __forceinline__ unsigned xb_ld(unsigned* p)              { return __hip_atomic_load(p, __ATOMIC_RELAXED, __HIP_MEMORY_SCOPE_AGENT); }
__device__ __forceinline__ unsigned xb_add(unsigned* p, unsigned v) { return __hip_atomic_fetch_add(p, v, __ATOMIC_RELAXED, __HIP_MEMORY_SCOPE_AGENT); }
__device__ __forceinline__ unsigned xb_xcc_id() { return (unsigned)__builtin_amdgcn_s_getreg((3 << 11) | 20) & 0xFu; }
#define XB_SPIN(cond, bar) do { unsigned _sp = 0; while (cond) { __builtin_amdgcn_s_sleep(1); \
    if ((++_sp & 255u) == 0u) { if (xb_ld(&(bar)[XB_TMO])) break; if (_sp > XB_SPIN_CAP) { atomicAdd(&(bar)[XB_TMO], 1u); break; } } } } while (0)

struct XcdBarrier {
    int wv;
    unsigned* bar; unsigned x;
    volatile PG8_LAS unsigned* st;
};

__device__ __forceinline__ XcdBarrier xcd_barrier_post(unsigned* bar, volatile PG8_LAS unsigned* st, int wv) {
    XcdBarrier b; b.wv = wv; b.bar = bar; b.x = xb_xcc_id(); b.st = st;
    if (wv == 0 && lane_id() == 0) (void)xb_add(&bar[XB_XCNT(b.x)], 1u);
    return b;
}
__device__ __forceinline__ void xcd_barrier_complete(unsigned* bar, unsigned x, unsigned& nloc, unsigned& nx) {
    const unsigned G = gridDim.x * gridDim.y * gridDim.z;
    unsigned sum, cnt, mine, sp = 0u;
    for (;;) {
        sum = 0u; cnt = 0u; mine = 0u;
#pragma unroll
        for (unsigned j = 0; j < 16; ++j) { const unsigned c = xb_ld(&bar[XB_XCNT(j)]); sum += c; cnt += (c > 0u) ? 1u : 0u; mine = (j == x) ? c : mine; }
        if (sum == G) break;
        __builtin_amdgcn_s_sleep(1);
        if ((++sp & 255u) == 0u) { if (xb_ld(&bar[XB_TMO])) break; if (sp > XB_SPIN_CAP) { atomicAdd(&bar[XB_TMO], 1u); break; } }
    }
    nloc = mine > 0u ? mine : 1u; nx = cnt > 0u ? cnt : 1u;
}

__device__ __forceinline__ void xcd_barrier(const XcdBarrier& b) {
    asm volatile("s_waitcnt vmcnt(0)" ::: "memory");
    __syncthreads();
    if (b.wv == 0 && lane_id() == 0) {
        unsigned* bar = b.bar;
        __builtin_amdgcn_s_waitcnt(0);
        unsigned nloc = b.st[0], nx = b.st[1];
        if (nloc == 0u) { xcd_barrier_complete(bar, b.x, nloc, nx); b.st[0] = nloc; b.st[1] = nx; }
        const unsigned old = xb_add(&bar[XB_XSUB(b.x)], 1u);
        const unsigned gen = old / nloc;
        if (old + 1u == (gen + 1u) * nloc) {
            __builtin_amdgcn_fence(__ATOMIC_RELEASE, "agent");
            asm volatile("s_waitcnt vmcnt(0)" ::: "memory");
            const unsigned og = xb_add(&bar[XB_TOP], 1u);
            const unsigned tg = og / nx;
            if (og + 1u == (tg + 1u) * nx) xb_add(&bar[XB_TOPGEN], 1u);
            else XB_SPIN(xb_ld(&bar[XB_TOPGEN]) == tg, bar);
            __builtin_amdgcn_fence(__ATOMIC_ACQUIRE, "agent");
            xb_add(&bar[XB_XGEN(b.x)], 1u);
            asm volatile("s_waitcnt vmcnt(0)" ::: "memory");
        } else {
            XB_SPIN(xb_ld(&bar[XB_XGEN(b.x)]) == gen, bar);
            __builtin_amdgcn_fence(__ATOMIC_ACQUIRE, "agent");
            asm volatile("s_waitcnt vmcnt(0)" ::: "memory");
        }
    }
    __syncthreads();
}

namespace sm {
__device__ __forceinline__ void prep_x(const float* __restrict__ x, const float* __restrict__ meta, bf16_t* __restrict__ XB, float* __restrict__ R1, int gw, int nw, int lane) {
    asm volatile("" : "+v"(lane));
    unsigned char* XQ = (unsigned char*)XB;
    for (int r0 = gw * 4; r0 < ME; r0 += nw * 4) {
        f32x4 v[4][4];
#pragma unroll
        for (int t = 0; t < 4; ++t) { const int r = r0 + t; const float* src = r < M ? x + (size_t)r * D : (r < M + NMETA ? meta + (size_t)(r - M) * D : nullptr);
#pragma unroll
            for (int j = 0; j < 4; ++j) v[t][j] = src ? *(const f32x4*)(src + 16 * lane + 4 * j) : (f32x4){0.f, 0.f, 0.f, 0.f}; }
#pragma unroll
        for (int t = 0; t < 4; ++t) { const int r = r0 + t; float ss = 0.f, am = 0.f;
#pragma unroll
            for (int j = 0; j < 4; ++j) { ss += v[t][j].x * v[t][j].x + v[t][j].y * v[t][j].y + v[t][j].z * v[t][j].z + v[t][j].w * v[t][j].w;
                am = fmaxf(fmaxf(am, fmaxf(fabsf(v[t][j].x), fabsf(v[t][j].y))), fmaxf(fabsf(v[t][j].z), fabsf(v[t][j].w))); }
            ss = wsum(ss);
            { const u32x2 q_ = __builtin_amdgcn_permlane32_swap(__float_as_uint(am), __float_as_uint(am), false, false); am = fmaxf(__uint_as_float(q_.x), __uint_as_float(q_.y)); }
            { const u32x2 q_ = __builtin_amdgcn_permlane16_swap(__float_as_uint(am), __float_as_uint(am), false, false); am = fmaxf(__uint_as_float(q_.x), __uint_as_float(q_.y)); }
            am = fmaxf(am, dpp_f<0x128>(am)); am = fmaxf(am, dpp_f<0xB1>(am)); am = fmaxf(am, dpp_f<0x4E>(am)); am = fmaxf(am, dpp_f<0x141>(am));
            const float rn = rsqrtf(ss * (1.f / D) + EPS), qs = am > 0.f ? 127.f / am : 0.f;
            if (lane == 0) R1[r] = am * rn * (1.f / 127.f) * SW_IN;
            u32x4 o;
#pragma unroll
            for (int j = 0; j < 4; ++j) { const int a0 = (int)__builtin_rintf(v[t][j].x * qs), a1 = (int)__builtin_rintf(v[t][j].y * qs), a2 = (int)__builtin_rintf(v[t][j].z * qs), a3 = (int)__builtin_rintf(v[t][j].w * qs);
                o[j] = (unsigned)(a0 & 255) | (unsigned)(a1 & 255) << 8 | (unsigned)(a2 & 255) << 16 | (unsigned)(a3 & 255) << 24; }
            *(u32x4*)(XQ + (size_t)r * D + 16 * lane) = o; }
    }
}
struct WDesc { const float* src; int Nsrc, K; bf16_t* dst; int Ndst; const float* gain; int gmod, mode; float qs; };
__device__ __forceinline__ void prep_w_load(const WDesc& W, int it, float (&x)[32], int lane) {
    const int nblk = W.Ndst / 32, kb = it / nblk, nb = it % nblk, k0 = 64 * kb, n0 = 32 * nb, c = map_col(W.mode, n0 + (lane & 31)), cs = c < 0 ? 0 : c;
    const float* sp = W.src + (size_t)(k0 + (lane >> 5)) * W.Nsrc + cs; const size_t st2 = (size_t)2 * W.Nsrc;
#pragma unroll
    for (int i = 0; i < 32; ++i) x[i] = sp[i * st2];
}
__device__ __forceinline__ void prep_w_fin(const WDesc& W, int it, const float (&x)[32], PG8_LAS float* scr, int lane) {
    const int nblk = W.Ndst / 32, kb = it / nblk, nb = it % nblk, k0 = 64 * kb, n0 = 32 * nb, c = map_col(W.mode, n0 + (lane & 31));
    const int cc = lane & 7;
    f32x4 g0 = (f32x4){1.f, 1.f, 1.f, 1.f}, g1 = g0;
    if (W.gain) { const float* gp = W.gain + (k0 + 8 * cc) % W.gmod; g0 = *(const f32x4*)gp; g1 = *(const f32x4*)(gp + 4); }
#pragma unroll
    for (int i = 0; i < 32; ++i) scr[(2 * i + (lane >> 5)) * 33 + (lane & 31)] = c < 0 ? 0.f : x[i];
    asm volatile("s_waitcnt lgkmcnt(0)" ::: "memory");
#pragma unroll
    for (int j = 0; j < 4; ++j) { const int n = (lane >> 3) + 8 * j; const PG8_LAS float* p = scr + (8 * cc) * 33 + n;
        if (W.qs > 0.f) { const float f_[8] = {p[0] * g0.x, p[33] * g0.y, p[66] * g0.z, p[99] * g0.w, p[132] * g1.x, p[165] * g1.y, p[198] * g1.z, p[231] * g1.w}; unsigned w_[2] = {0u, 0u};
#pragma unroll
            for (int e = 0; e < 8; ++e) w_[e >> 2] |= (unsigned)((int)fminf(fmaxf(__builtin_rintf(f_[e] * W.qs), -127.f), 127.f) & 255) << (8 * (e & 3));
            *(u32x2*)((unsigned char*)W.dst + (size_t)(n0 + n) * W.K + k0 + 8 * cc) = (u32x2){w_[0], w_[1]}; }
        else { u32x4 o; o.x = pk2(p[0] * g0.x, p[33] * g0.y); o.y = pk2(p[66] * g0.z, p[99] * g0.w); o.z = pk2(p[132] * g1.x, p[165] * g1.y); o.w = pk2(p[198] * g1.z, p[231] * g1.w);
            *(u32x4*)(W.dst + (size_t)(n0 + n) * W.K + k0 + 8 * cc) = o; } }
    asm volatile("s_waitcnt lgkmcnt(0)" ::: "memory");
}
struct WAll { const float *w_in, *g_in, *w_uq, *g_uq, *w_ukv, *g_ukv, *w_om, *w_og, *g_og, *w_out; bf16_t *WinT, *WuqT, *WukvT, *WomT, *WogT, *WoutT; };
__device__ __forceinline__ WDesc prep_w_pick(const WAll& A, int it, int& r) {
    constexpr int n0 = (D / 64) * (WIN_ROWS / 32), n1 = (QR / 64) * (1536 / 32), n2 = (KVR / 64) * (2048 / 32), n3 = (D / 64) * (D / 32);
    r = it;
    if (r < n0) return WDesc{A.w_in, DIN, D, A.WinT, WIN_ROWS, A.g_in, D, (int)MAP_WIN, 1.f / SW_IN}; r -= n0;
    if (r < n1) return WDesc{A.w_uq, 1536, QR, A.WuqT, 1536, A.g_uq, QR, (int)MAP_ID, 0.f}; r -= n1;
    if (r < n2) return WDesc{A.w_ukv, 2048, KVR, A.WukvT, 2048, A.g_ukv, KVR, (int)MAP_UKV, 0.f}; r -= n2;
    if (r < n3) return WDesc{A.w_om, D, D, A.WomT, D, (const float*)nullptr, 1, (int)MAP_ID, 0.f}; r -= n3;
    if (r < n3) return WDesc{A.w_og, D, D, A.WogT, D, A.g_og, GHV, (int)MAP_ID, 0.f}; r -= n3;
    return WDesc{A.w_out, D, D, A.WoutT, D, (const float*)nullptr, 1, (int)MAP_ID, 0.f};
}
__device__ __forceinline__ void prep_w_all(const WAll& A, PG8_LAS float* scr, int gw, int nw, int lane) {
    asm volatile("" : "+v"(lane));
    constexpr int NIT = (D / 64) * (WIN_ROWS / 32) + (QR / 64) * (1536 / 32) + (KVR / 64) * (2048 / 32) + 3 * (D / 64) * (D / 32);
    float xa[32], xb[32]; int ra, rb;
    if (gw < NIT) { const WDesc W = prep_w_pick(A, gw, ra); prep_w_load(W, ra, xa, lane); }
    for (int it = gw; it < NIT; it += 2 * nw) {
        const int i1 = it + nw, i2 = it + 2 * nw;
        if (i1 < NIT) { const WDesc W = prep_w_pick(A, i1, rb); prep_w_load(W, rb, xb, lane); }
        { const WDesc W = prep_w_pick(A, it, ra); prep_w_fin(W, ra, xa, scr, lane); }
        if (i2 < NIT) { const WDesc W = prep_w_pick(A, i2, ra); prep_w_load(W, ra, xa, lane); }
        if (i1 < NIT) { const WDesc W = prep_w_pick(A, i1, rb); prep_w_fin(W, rb, xb, scr, lane); }
    }
}
typedef float f32x16 __attribute__((ext_vector_type(16)));
__device__ __forceinline__ void prep_ws(const float* __restrict__ wq, const float* __restrict__ keys, const float* __restrict__ gain, bf16_t* __restrict__ WsT, int gw, int nw, int lane) {
    asm volatile("" : "+v"(lane));
    const int r = lane & 31, h = lane >> 5;
    for (int blk = gw; blk < 64 * 32; blk += nw) {
        const int n0 = (blk >> 5) * 32, k0 = (blk & 31) * 32, hp = n0 >> 7;
        const float* ap = wq + (size_t)(k0 + r) * 2048 + hp * 128 + 64 * h;
        const float* bp = keys + (size_t)(hp & 1) * 128 * 128 + (size_t)((n0 & 127) + r) * 128 + 64 * h;
        f32x4 av[16], bv[16];
#pragma unroll
        for (int i = 0; i < 16; ++i) { av[i] = *(const f32x4*)(ap + 4 * i); bv[i] = *(const f32x4*)(bp + 4 * i); }
        f32x16 c;
#pragma unroll
        for (int i = 0; i < 16; ++i) c[i] = 0.f;
#pragma unroll
        for (int i = 0; i < 16; ++i)
#pragma unroll
            for (int e = 0; e < 4; ++e) c = __builtin_amdgcn_mfma_f32_32x32x2f32(av[i][e], bv[i][e], c, 0, 0, 0);
#pragma unroll
        for (int g = 0; g < 4; ++g) {
            const int k = k0 + 8 * g + 4 * h; const f32x4 gq = *(const f32x4*)(gain + k);
            const unsigned long long o = (unsigned long long)pk2(c[4 * g] * gq.x, c[4 * g + 1] * gq.y) | ((unsigned long long)pk2(c[4 * g + 2] * gq.z, c[4 * g + 3] * gq.w) << 32);
            *(unsigned long long*)(WsT + (size_t)(n0 + r) * D + k) = o; }
    }
}
__device__ __forceinline__ void prep_rope(float* __restrict__ RT, int gt, int nt) {
    for (int i = gt; i < 2064 * RH; i += nt) { const int pos = i / RH, f = i % RH; const float inv = powf(10000.f, -(float)f / (float)RH); const float ang = (float)pos * inv; RT[2 * i] = cosf(ang); RT[2 * i + 1] = sinf(ang); }
}
__device__ __forceinline__ void p0stats(const bf16_t* __restrict__ P0, const float* __restrict__ kn_pe, const float* __restrict__ RT, float* __restrict__ RQ, float* __restrict__ RKV, bf16_t* __restrict__ KPE, int gw, int nw, int lane) {
    asm volatile("" : "+v"(lane));
    const bool kl = lane >= 16 && lane < 24, hi = lane & 4; const int ke = 8 * (lane & 7);
    const f32x4 gk0 = *(const f32x4*)(kn_pe + ke), gk1 = *(const f32x4*)(kn_pe + ke + 4);
    for (int r0 = gw * 4; r0 < ME; r0 += nw * 4) {
        u32x4 A[4], B[4]; f32x4 rt[4][4];
#pragma unroll
        for (int t = 0; t < 4; ++t) { const int r = r0 + t; const bf16_t* p = P0 + (size_t)r * P0W; A[t] = *(const u32x4*)(p + 8 * lane); B[t] = *(const u32x4*)(p + 512 + 8 * (lane & 31));
            const int pos = tok_pos(r) < 2064 ? tok_pos(r) : 0; const float* q = RT + ((size_t)pos * RH + 8 * (lane & 3)) * 2;
#pragma unroll
            for (int i = 0; i < 4; ++i) rt[t][i] = *(const f32x4*)(q + 4 * i); }
#pragma unroll
        for (int t = 0; t < 4; ++t) { const int r = r0 + t;
            float fa[8], fb[8]; unpack8(A[t], fa); unpack8(B[t], fb);
            float sa = 0.f, sb = 0.f;
#pragma unroll
            for (int i = 0; i < 8; ++i) { sa += fa[i] * fa[i]; sb += fb[i] * fb[i]; }
            const float sq = wsum(lane < 48 ? sa : 0.f), skv = wsum((lane >= 48 ? sa : 0.f) + (lane < 16 ? sb : 0.f)), sk = wsum(kl ? sb : 0.f);
            if (lane == 0) { RQ[r] = rsqrtf(sq * (1.f / QR) + EPS); RKV[r] = rsqrtf(skv * (1.f / KVR) + EPS); }
            if (kl) {
                const float rn = rsqrtf(sk * (1.f / ROPE) + EPS); float y[8], o[8];
                const float gk[8] = {gk0.x, gk0.y, gk0.z, gk0.w, gk1.x, gk1.y, gk1.z, gk1.w};
                const float cs[16] = {rt[t][0].x, rt[t][0].y, rt[t][0].z, rt[t][0].w, rt[t][1].x, rt[t][1].y, rt[t][1].z, rt[t][1].w, rt[t][2].x, rt[t][2].y, rt[t][2].z, rt[t][2].w, rt[t][3].x, rt[t][3].y, rt[t][3].z, rt[t][3].w};
#pragma unroll
                for (int i = 0; i < 8; ++i) y[i] = fb[i] * rn * gk[i];
#pragma unroll
                for (int i = 0; i < 8; ++i) { const float up = dpp_f<0x114>(y[i]), dn = dpp_f<0x104>(y[i]);
                    o[i] = hi ? y[i] * cs[2 * i] + up * cs[2 * i + 1] : y[i] * cs[2 * i] - dn * cs[2 * i + 1]; }
                *(u32x4*)(KPE + (size_t)r * ROPE + ke) = pack8(o); }
        }
    }
}
__device__ __forceinline__ void meta_kv(const bf16_t* __restrict__ P0, const bf16_t* __restrict__ Wkv, const float* __restrict__ RKV, const float* __restrict__ kn_nope, bf16_t* __restrict__ KN, bf16_t* __restrict__ V, int gw, int nw, int lane) {
    asm volatile("" : "+v"(lane));
    for (int it = gw; it < NMETA * 8; it += nw) {
        const int row = M + (it >> 3), g = it & 7; const bf16_t* a = P0 + (size_t)row * P0W + S_CKV; float acc[2] = {0.f, 0.f};
#pragma unroll
        for (int t = 0; t < 2; ++t) { const bf16_t* w = Wkv + (size_t)(g * 128 + lane + 64 * t) * KVR;
            for (int k = 0; k < KVR; k += 8) { float fa[8], fw[8]; unpack8(*(const u32x4*)(a + k), fa); unpack8(*(const u32x4*)(w + k), fw);
#pragma unroll
                for (int i = 0; i < 8; ++i) acc[t] += fa[i] * fw[i]; } }
        const float sc = RKV[row]; acc[0] *= sc; acc[1] *= sc;
        if (g < 4) { const float rn = rsqrtf(wsum(acc[0] * acc[0] + acc[1] * acc[1]) * (1.f / NOPE) + EPS);
            KN[(size_t)row * 512 + g * 128 + lane] = f2bf(acc[0] * rn * kn_nope[lane]); KN[(size_t)row * 512 + g * 128 + lane + 64] = f2bf(acc[1] * rn * kn_nope[lane + 64]); }
        else { V[(size_t)row * 512 + (g - 4) * 128 + lane] = f2bf(acc[0]); V[(size_t)row * 512 + (g - 4) * 128 + lane + 64] = f2bf(acc[1]); }
    }
}
__device__ __forceinline__ void gla_post(const bf16_t* OG, const bf16_t* __restrict__ GG, bf16_t* OO, int gw, int nw, int lane) {
    asm volatile("" : "+v"(lane));
    for (int r0 = gw * 2; r0 < M; r0 += nw * 2) {
        u32x4 ow[2][2], gwv[2][2];
#pragma unroll
        for (int t = 0; t < 2; ++t) { const size_t off = (size_t)(r0 + t) * D + 16 * lane;
            ow[t][0] = *(const u32x4*)(OG + off); ow[t][1] = *(const u32x4*)(OG + off + 8); gwv[t][0] = *(const u32x4*)(GG + off); gwv[t][1] = *(const u32x4*)(GG + off + 8); }
#pragma unroll
        for (int t = 0; t < 2; ++t) { float o[16], g[16]; unpack8(ow[t][0], o); unpack8(ow[t][1], o + 8); unpack8(gwv[t][0], g); unpack8(gwv[t][1], g + 8);
            float ss = 0.f;
#pragma unroll
            for (int i = 0; i < 16; ++i) ss += o[i] * o[i];
            ss += dpp_f<0xB1>(ss); ss += dpp_f<0x4E>(ss); ss += dpp_f<0x141>(ss); ss += dpp_f<0x128>(ss);
            const float rn = rsqrtf(ss * (1.f / GHV) + EPS);
#pragma unroll
            for (int i = 0; i < 16; ++i) o[i] = o[i] * rn * g[i] * sigmoidf_(g[i]);
            const size_t off = (size_t)(r0 + t) * D + 16 * lane; *(u32x4*)(OO + off) = pack8(o); *(u32x4*)(OO + off + 8) = pack8(o + 8); }
    }
}
struct __attribute__((packed, aligned(4))) U3 { unsigned x, y, z; };
__device__ __forceinline__ unsigned enc_e2m3(float v) {
    const float t = fminf(fabsf(v) * 8.f, 60.f);
    const float m = t < 16.f ? 1.f : t < 32.f ? 0.5f : 0.25f; const unsigned b = t < 16.f ? 0u : t < 32.f ? 8u : 16u;
    return ((unsigned)(int)__builtin_rintf(t * m) + b) | (v < 0.f ? 32u : 0u);
}
__device__ __forceinline__ void conv_f6(const float* __restrict__ a, unsigned char* __restrict__ ao, float scale, const float* __restrict__ gain, int n16, int gt, int nt) {
    for (int i0 = gt; i0 < n16; i0 += 2 * nt) {
        const int i1 = i0 + nt < n16 ? i0 + nt : i0;
        f32x4 x[2][4], g[2][4];
#pragma unroll
        for (int t = 0; t < 2; ++t)
#pragma unroll
            for (int j = 0; j < 4; ++j) { const int i = t ? i1 : i0; x[t][j] = *(const f32x4*)(a + (size_t)i * 16 + 4 * j); g[t][j] = *(const f32x4*)(gain + (i & 63) * 16 + 4 * j); }
#pragma unroll
        for (int t = 0; t < 2; ++t) { const int i = t ? i1 : i0;
            unsigned c[16];
#pragma unroll
            for (int j = 0; j < 4; ++j) { const f32x4 v = x[t][j], q = g[t][j];
                c[4 * j] = enc_e2m3(v.x * q.x * scale); c[4 * j + 1] = enc_e2m3(v.y * q.y * scale); c[4 * j + 2] = enc_e2m3(v.z * q.z * scale); c[4 * j + 3] = enc_e2m3(v.w * q.w * scale); }
            unsigned long long lo = 0ull;
#pragma unroll
            for (int j = 0; j < 10; ++j) lo |= (unsigned long long)c[j] << (6 * j);
            lo |= (unsigned long long)(c[10] & 15u) << 60;
            unsigned hi = c[10] >> 4;
#pragma unroll
            for (int j = 11; j < 16; ++j) hi |= c[j] << (6 * (j - 11) + 2);
            *(U3*)(ao + (size_t)i * 12) = U3{(unsigned)lo, (unsigned)(lo >> 32), hi}; }
    }
}
__device__ __forceinline__ unsigned enc_e2m1(float v) {
    const float t = fabsf(v);
    return (unsigned)((t > 0.25f) + (t > 0.75f) + (t > 1.25f) + (t > 1.75f) + (t > 2.5f) + (t > 3.5f) + (t > 5.f)) | (v < 0.f ? 8u : 0u);
}
__device__ __forceinline__ void conv_f4(const float* __restrict__ a, unsigned char* __restrict__ ao, float scale, int n16, int gt, int nt) {
    for (int i0 = gt; i0 < n16; i0 += 2 * nt) {
        const int i1 = i0 + nt < n16 ? i0 + nt : i0;
        f32x4 x[2][4];
#pragma unroll
        for (int t = 0; t < 2; ++t)
#pragma unroll
            for (int j = 0; j < 4; ++j) x[t][j] = *(const f32x4*)(a + (size_t)(t ? i1 : i0) * 16 + 4 * j);
#pragma unroll
        for (int t = 0; t < 2; ++t) { unsigned w0 = 0u, w1 = 0u;
#pragma unroll
            for (int j = 0; j < 4; ++j) { const f32x4 v = x[t][j];
                const unsigned c = enc_e2m1(v.x * scale) | enc_e2m1(v.y * scale) << 4 | enc_e2m1(v.z * scale) << 8 | enc_e2m1(v.w * scale) << 12;
                if (j < 2) w0 |= c << (16 * j); else w1 |= c << (16 * (j - 2)); }
            *(u32x2*)(ao + (size_t)(t ? i1 : i0) * 8) = (u32x2){w0, w1}; }
    }
}
__device__ __forceinline__ unsigned enc_s4(float v) { return (unsigned)(int)fminf(fmaxf(__builtin_rintf(v), -8.f), 7.f) & 15u; }
__device__ __forceinline__ void conv_s4g(const float* __restrict__ a, unsigned char* __restrict__ ao, float scale, const float* __restrict__ gain, int n16, int gt, int nt) {
    for (int i0 = gt; i0 < n16; i0 += 2 * nt) {
        const int i1 = i0 + nt < n16 ? i0 + nt : i0;
        f32x4 x[2][4], g[2][4];
#pragma unroll
        for (int t = 0; t < 2; ++t)
#pragma unroll
            for (int j = 0; j < 4; ++j) { const int i = t ? i1 : i0; x[t][j] = *(const f32x4*)(a + (size_t)i * 16 + 4 * j); g[t][j] = *(const f32x4*)(gain + (i & 63) * 16 + 4 * j); }
#pragma unroll
        for (int t = 0; t < 2; ++t) { unsigned w0 = 0u, w1 = 0u;
#pragma unroll
            for (int j = 0; j < 4; ++j) { const f32x4 v = x[t][j], q = g[t][j];
                const unsigned c = enc_s4(v.x * q.x * scale) | enc_s4(v.y * q.y * scale) << 4 | enc_s4(v.z * q.z * scale) << 8 | enc_s4(v.w * q.w * scale) << 12;
                if (j < 2) w0 |= c << (16 * j); else w1 |= c << (16 * (j - 2)); }
            *(u32x2*)(ao + (size_t)(t ? i1 : i0) * 8) = (u32x2){w0, w1}; }
    }
}
}

#ifndef REP_G
#define REP_G 1
#endif
#ifndef REP_A
#define REP_A 1
#endif
#ifndef REP_GA
#define REP_GA 1
#endif
#ifndef REP_P
#define REP_P 1
#endif
#ifndef REP_R
#define REP_R 1
#endif
#ifndef REP_SY
#define REP_SY 1
#endif
#ifndef REP_T
#define REP_T 1
#endif
#ifndef REP_U
#define REP_U 1
#endif
#ifndef PREP_VAR
#define PREP_VAR 0
#endif
#ifndef REP_S
#define REP_S 1
#endif
constexpr int MEGA_THREADS = 512, MEGA_LDS = 147456;
struct MegaArgs {
    const float* in[23]; float* out; char* ws; int ph_lo, ph_hi, coop, pad;
};
enum { PH_PREP = 0, PH_PROJ = 1, PH_STATS = 2, PH_UP = 3, PH_ATT = 4, PH_GLAPOST = 7, PH_MIX = 8, PH_OUT = 9, PH_SCORE = 10, PH_GATHER = 11, PH_N = 12 };

struct SchedProj { const char* XB; const char* WinT; int G, c;
    __device__ __forceinline__ bool next(int i, pg8::Unit& u) const {
        const int L = i * G + c; constexpr int NNAT = 129 * 17, NTR = 6 * 129;
        if (L >= NNAT + NTR) return false;
        if (L < NNAT) { pg8::tile_of(L, 129, 17, u.pm, u.pn); u.gid = 0; u.A = XB + (size_t)u.pm * 256 * D; u.B = WinT + (size_t)u.pn * 256 * D; }
        else { pg8::tile_of(L - NNAT, 6, 129, u.pm, u.pn); u.gid = 1; u.A = WinT + (size_t)(WIN_NAT + u.pm * 256) * D; u.B = XB + (size_t)u.pn * 256 * D; }
        return true; }
};
struct EpiProj { static constexpr bool XFORM = false, ROWSTAT = false, PRE = true, AUX = false; EpiProjNat n; EpiProjTr t;
    __device__ __forceinline__ void pre(int gid, int row0, int col0, float (&rs)[2][4], f32x4 (&cs)[2][2]) const {
        if (gid == 0) {
#pragma unroll
            for (int ai = 0; ai < 2; ++ai)
#pragma unroll
                for (int m = 0; m < 4; ++m) rs[ai][m] = n.R1[row0 + ai * 128 + m * 16]; }
        else {
#pragma unroll
            for (int bj = 0; bj < 2; ++bj) { cs[bj][0] = *(const f32x4*)(t.R1 + col0 + bj * 128); cs[bj][1] = *(const f32x4*)(t.R1 + col0 + bj * 128 + 4); } } }
    __device__ __forceinline__ void operator()(int gid, int row, int col, const float* v, float rsv, const f32x4 (&csv)[2]) const { if (gid == 0) n(row, col, v, rsv); else t(row, col, v, csv); } };
struct SchedSimple { const char* A; const char* B; size_t sA, sB; int nM, nN, G, c, gid;
    __device__ __forceinline__ bool next(int i, pg8::Unit& u) const {
        const int L = i * G + c; if (L >= nM * nN) return false;
        pg8::tile_of(L, nM, nN, u.pm, u.pn); u.gid = gid; u.A = A + (size_t)u.pm * sA; u.B = B + (size_t)u.pn * sB; return true; }
};
struct EpiUp { static constexpr bool XFORM = false, ROWSTAT = true, PRE = true, AUX = false; EpiUq q; EpiUkv kv; const float* kn_nope;
    __device__ __forceinline__ bool want_stat(int gid, int pn) const { return gid == 1 && pn < 2; }
    __device__ __forceinline__ void pre(int gid, int row0, int col0, float (&rs)[2][4], f32x4 (&cs)[2][2]) const {
        const float* R = gid == 0 ? q.RQ : kv.RKV;
#pragma unroll
        for (int ai = 0; ai < 2; ++ai)
#pragma unroll
            for (int m = 0; m < 4; ++m) rs[ai][m] = R[row0 + ai * 128 + m * 16];
        cs[0][0] = *(const f32x4*)(kn_nope + (col0 & 127)); cs[0][1] = *(const f32x4*)(kn_nope + (col0 & 127) + 4); cs[1][0] = cs[0][0]; cs[1][1] = cs[0][1]; }
    __device__ __forceinline__ void operator()(int gid, int row, int col, const float* v, float ss, float s, const f32x4 (&g)[2]) const {
        if (gid == 0) { q(row, col, v, s); return; }
        if (col < 512) {
            const float rn = s * rsqrtf(s * s * ss * (1.f / NOPE) + EPS);
            const float o[8] = {v[0] * rn * g[0].x, v[1] * rn * g[0].y, v[2] * rn * g[0].z, v[3] * rn * g[0].w, v[4] * rn * g[1].x, v[5] * rn * g[1].y, v[6] * rn * g[1].z, v[7] * rn * g[1].w};
            *(u32x4*)(kv.KN + (size_t)row * 512 + col) = pack8(o); }
        else kv(row, col, v, s); }
};
template <class E1> struct EpiWrap { static constexpr bool XFORM = false, ROWSTAT = false, PRE = false, AUX = false; E1 e;
    __device__ __forceinline__ void operator()(int, int row, int col, const float* v) const { e(row, col, v); } };
struct SchedMix { const char* YA; const char* YB; const char* W1; const char* W2; int G, c;
    __device__ __forceinline__ bool next(int i, pg8::Unit& u) const {
        const int L = (i >> 1) * G + c; if (L >= 128 * 4) return false;
        pg8::tile_of(L, 128, 4, u.pm, u.pn); u.gid = i & 1;
        u.A = (u.gid ? YB : YA) + (size_t)u.pm * 256 * D * 2; u.B = (u.gid ? W2 : W1) + (size_t)u.pn * 256 * D * 2; return true; }
};
struct EpiMix { static constexpr bool XFORM = false, ROWSTAT = false, PRE = false, AUX = true; const bf16_t* __restrict__ GA; const bf16_t* __restrict__ GB; bf16_t* __restrict__ MIX;
    __device__ __forceinline__ bool keep(int gid) const { return gid == 0; }
    __device__ __forceinline__ void aux(int gid, int row, int col, u32x4 (&ax)[2]) const { ax[1] = *(const u32x4*)(GB + (size_t)row * D + col); if (gid == 0) ax[0] = *(const u32x4*)(GA + (size_t)row * D + col); }
    __device__ __forceinline__ bool apply(int gid, int row, int col, float* v, const u32x4 (&ax)[2]) const {
        float gb[8]; unpack8(ax[1], gb);
        if (gid == 0) { float ga[8]; unpack8(ax[0], ga);
#pragma unroll
            for (int i = 0; i < 8; ++i) v[i] *= (1.f + __expf(-gb[i])) / (1.f + __expf(-ga[i]));
            return true; }
        float o[8];
#pragma unroll
        for (int i = 0; i < 8; ++i) o[i] = v[i] * sigmoidf_(gb[i]);
        *(u32x4*)(MIX + (size_t)row * D + col) = pack8(o); return false; }
};

__global__ void __launch_bounds__(MEGA_THREADS, 2) mega(MegaArgs a) {
    extern __shared__ __attribute__((aligned(16))) unsigned char lds_raw[];
    PG8_LAS unsigned char* lds = (PG8_LAS unsigned char*)lds_raw;
    cg::grid_group grid = cg::this_grid();
    char* ws = a.ws;
    const int G = gridDim.x, bx = blockIdx.x, nw = G * 8, nt = G * MEGA_THREADS;
    const int wid_s = __builtin_amdgcn_readfirstlane((int)threadIdx.x >> 6);
#define TIDS int lane = lane_id(); asm volatile("" : "+v"(lane)); const int wid = wid_s, tid = wid * 64 + lane, gw = bx * 8 + wid, gt = bx * MEGA_THREADS + tid; (void)lane; (void)gw; (void)gt; (void)wid
    bf16_t *WinT = (bf16_t*)(ws + O_WIN), *XB = (bf16_t*)(ws + O_XB), *P0 = (bf16_t*)(ws + O_P0), *GQ = (bf16_t*)(ws + O_GQ), *GKT = (bf16_t*)(ws + O_GKT), *GVT = (bf16_t*)(ws + O_GVT), *GG = (bf16_t*)(ws + O_GG);
    float *R1 = (float*)(ws + O_R1), *RQ = (float*)(ws + O_RQ), *RKV = (float*)(ws + O_RKV), *SC = (float*)(ws + O_S), *RT = (float*)(ws + O_ROPE);
    bf16_t *WuqT = (bf16_t*)(ws + O_WUQ), *WukvT = (bf16_t*)(ws + O_WUKV), *WomT = (bf16_t*)(ws + O_WOM), *WogT = (bf16_t*)(ws + O_WOG), *WoutT = (bf16_t*)(ws + O_WOUT), *WsT = (bf16_t*)(ws + O_WS);
    bf16_t *QC = (bf16_t*)(ws + O_QC), *KN = (bf16_t*)(ws + O_KN), *V = (bf16_t*)(ws + O_V), *YA = (bf16_t*)(ws + O_YA), *YB = (bf16_t*)(ws + O_YB), *MIX = (bf16_t*)(ws + O_MIX), *HN2 = (bf16_t*)(ws + O_HN2);
    bf16_t *GA = (bf16_t*)a.out, *GB = (bf16_t*)a.out + (size_t)M * D; bf16_t* KPE = (bf16_t*)(ws + O_KPE);
#define IN(k) (a.ph_lo <= (k) && (k) < a.ph_hi)
    volatile PG8_LAS unsigned* MISC = (volatile PG8_LAS unsigned*)(lds + 131072 + 320);
    { TIDS; if (tid < 128) ((PG8_LAS unsigned*)(lds + 131072))[tid] = 0u; }
    __syncthreads();
    const XcdBarrier xbar = xcd_barrier_post((unsigned*)(ws + O_BAR), MISC + 8, wid_s);
    if (a.coop == 2) grid.sync();
#define SEAM(k) do { if (a.coop && (k) + 1 < a.ph_hi) xcd_barrier(xbar); } while (0)
    if (IN(PH_PREP)) { for (int rep = 0; rep < REP_P; ++rep) { TIDS;
        sm::prep_x(a.in[0], a.in[1], XB, R1, gw, nw, lane);
        PG8_LAS float* scr = (PG8_LAS float*)(lds + wid * 16384);
        sm::prep_w_all(sm::WAll{a.in[3], a.in[2], a.in[5], a.in[4], a.in[7], a.in[6], a.in[15], a.in[16], a.in[14], a.in[17], WinT, WuqT, WukvT, WomT, WogT, WoutT}, scr, gw, nw, lane);
        sm::prep_ws(a.in[19], a.in[20], a.in[18], WsT, gw, nw, lane);
        sm::prep_rope(RT, gt, nt); __syncthreads(); }
        SEAM(PH_PREP);
    }
    if (IN(PH_PROJ)) {
        SchedProj S{(const char*)XB, (const char*)WinT, G, bx};
        EpiProj E{EpiProjNat{R1, P0, GQ, GG, GA, GB}, EpiProjTr{R1, GKT, GVT}};
        for (int rep = 0; rep < REP_G; ++rep) pg8::gemm_phase<EpiProj, SchedProj, true>(lds, pg8::Fam{D / 2, D / 2, D / 2}, S, E, wid_s);
        SEAM(PH_PROJ);
    }
    if (IN(PH_STATS)) { TIDS;
        for (int rep = 0; rep < REP_R; ++rep) sm::p0stats(P0, a.in[11], RT, RQ, RKV, KPE, gw, nw, lane);
        for (int i = gt; i < 48 * 512 / 8; i += nt) { *(u32x4*)(KN + (size_t)(M + NMETA) * 512 + (size_t)i * 8) = (u32x4){0u, 0u, 0u, 0u}; *(u32x4*)(V + (size_t)(M + NMETA) * 512 + (size_t)i * 8) = (u32x4){0u, 0u, 0u, 0u}; }
        for (int rep = 0; rep < REP_U; ++rep) { const bool dm = rep + 1 < REP_U; const gla::Tens GT{GQ, GKT, GVT, dm ? QC : GQ, dm ? QC + (size_t)ME * 512 : GKT, dm ? PREP_VAR : 0, P0, a.in[12], a.in[13], (bf16_t*)(ws + O_AG), (float*)(ws + O_DECL), YB};
          gla::prep_phase(lds, GT, G, bx, wid_s); }
        SEAM(PH_STATS);
    }
#define ROUND_BODY(r) do { \
        if (IN(PH_UP + 2 * r)) { TIDS; \
            const int Gh = G >> 1; const bool isq = bx < Gh; \
            SchedSimple S{(const char*)(isq ? P0 : P0 + S_CKV), (const char*)(isq ? WuqT + (size_t)r * 768 * QR : WukvT + (size_t)r * 1024 * KVR), (size_t)256 * P0W * 2, (size_t)256 * (isq ? QR : KVR) * 2, 128, isq ? 3 : 4, isq ? Gh : G - Gh, isq ? bx : bx - Gh, isq ? 0 : 1}; \
            for (int rep = 0; rep < REP_G; ++rep) pg8::gemm_phase(lds, pg8::Fam{P0W, isq ? QR : KVR, isq ? QR : KVR}, S, EpiUp{EpiUq{RQ, QC}, EpiUkv{RKV, KN, V}, a.in[10]}, wid_s); \
            sm::meta_kv(P0, WukvT + (size_t)r * 1024 * KVR, RKV, a.in[10], KN, V, gw, nw, lane); \
            SEAM(PH_UP + 2 * r); \
        } \
        if (IN(PH_ATT + 2 * r)) { \
            if (r == 0) att::attn_phase(lds, att::Tens{QC, KN, KPE, V, YA, a.in[8], a.in[9], RT}, r, G, bx, wid_s); \
            else { \
                if (bx < NB * 4) { const gla::Tens GT{GQ, GKT, GVT, GQ, GKT, 0, P0, a.in[12], a.in[13], (bf16_t*)(ws + O_AG), (float*)(ws + O_DECL), YB}; \
                    for (int u = bx; u < NB * 4; u += G) gla::scan_wg(lds, GT, u >> 2, u & 3, wid_s); } \
                att::attn_phase_dyn(lds, att::Tens{QC, KN, KPE, V, YA, a.in[8], a.in[9], RT}, r, (unsigned*)(ws + O_BAR) + 3584, MISC, wid_s); } \
            SEAM(PH_ATT + 2 * r); } \
    } while (0)
    ROUND_BODY(0);
    ROUND_BODY(1);
#undef ROUND_BODY
    if (IN(PH_GLAPOST)) { TIDS; for (int rep = 0; rep < REP_R; ++rep) { sm::gla_post(YB, GG, rep + 1 < REP_R ? GVT : YB, gw, nw, lane);
        sm::conv_s4g(a.in[21], (unsigned char*)(ws + O_UB), peer::PEER_SU, a.in[18], 16384 * D / 16, gt, nt);
        sm::conv_f4(a.in[22], (unsigned char*)(ws + O_VB), peer::PEER_SV, 16384 * D / 16, gt, nt); }
        SEAM(PH_GLAPOST); }
    if (IN(PH_MIX)) {
        SchedMix S{(const char*)YA, (const char*)YB, (const char*)WomT, (const char*)WogT, G, bx};
        for (int rep = 0; rep < REP_G; ++rep) pg8::gemm_phase(lds, pg8::Fam{D, D, D}, S, EpiMix{GA, GB, MIX}, wid_s);
        SEAM(PH_MIX);
    }
    if (IN(PH_OUT)) {
        SchedSimple S{(const char*)MIX, (const char*)WoutT, (size_t)256 * D * 2, (size_t)256 * D * 2, 128, 4, G, bx, 0};
        for (int rep = 0; rep < REP_G; ++rep) pg8::gemm_phase(lds, pg8::Fam{D, D, D}, S, EpiOut{a.in[0], a.out, HN2, (float*)(ws + O_SSQ)}, wid_s);
        SEAM(PH_OUT);
    }
    if (IN(PH_SCORE)) {
        SchedSimple S{(const char*)HN2, (const char*)WsT, (size_t)256 * D * 2, (size_t)256 * D * 2, 128, 8, G, bx, 0};
        for (int rep = 0; rep < REP_G; ++rep) pg8::gemm_phase(lds, pg8::Fam{D, D, D}, S, EpiWrap<EpiScore>{EpiScore{(bf16_t*)SC}}, wid_s);
        { TIDS; PG8_LAS float* wl = (PG8_LAS float*)(lds + wid * peer::TK_WAVE_LDS); pg8::Unit u; int nu = 0; while (S.next(nu, u)) ++nu;
          for (int t = wid; t < nu * 4; t += 8) { S.next(t >> 2, u); peer::topk64(wl, (const bf16_t*)SC, (const float*)(ws + O_SSQ), (int*)(ws + O_IDX), (float*)(ws + O_GATE), u.pm * 256 + (t & 3) * 64, u.pn, true, lane); } }
        SEAM(PH_SCORE);
    }
    if (IN(PH_GATHER)) for (int rep = 0; rep < REP_GA; ++rep) peer::gather1s_phase(lds, HN2, (const int*)(ws + O_IDX), (const float*)(ws + O_GATE), (const unsigned char*)(ws + O_UB), (const unsigned char*)(ws + O_VB), (const float*)(ws + O_SSQ), rep + 1 < REP_GA ? SC : a.out, G, bx, wid_s);
}

extern "C" void kernel_launch(void* const* d_in, const int* in_sizes, int n_in, void* d_out, int out_size, void* d_ws, size_t ws_size, hipStream_t st) {
    (void)in_sizes; (void)out_size;
    static int grid = 0;
    if (grid == 0) {
        if (n_in != 23 || ws_size < O_WSEND) { fprintf(stderr, "kernel_launch: unexpected inputs (%d) or workspace %zu < %zu\n", n_in, ws_size, (size_t)O_WSEND); grid = -1; return; }
        int dev = 0, cus = 0, per_cu = 0;
        if (hipGetDevice(&dev) != hipSuccess || hipDeviceGetAttribute(&cus, hipDeviceAttributeMultiprocessorCount, dev) != hipSuccess) cus = 256;
        if (hipFuncSetAttribute((const void*)mega, hipFuncAttributeMaxDynamicSharedMemorySize, MEGA_LDS) != hipSuccess) { fprintf(stderr, "kernel_launch: hipFuncSetAttribute failed\n"); grid = -1; return; }
        if (hipOccupancyMaxActiveBlocksPerMultiprocessor(&per_cu, (const void*)mega, MEGA_THREADS, MEGA_LDS) != hipSuccess || per_cu < 1) { fprintf(stderr, "kernel_launch: occupancy query failed (%d)\n", per_cu); per_cu = 1; }
        (void)hipGetLastError();
        grid = cus * 1;
        if (per_cu < 1) grid = -1;
    }
    if (grid < 0) return;
    MegaArgs ma{};
    for (int i = 0; i < 23; ++i) ma.in[i] = (const float*)d_in[i];
    ma.out = (float*)d_out; ma.ws = (char*)d_ws; ma.ph_lo = 0; ma.ph_hi = PH_N; ma.coop = 1; ma.pad = 0;
    if (hipMemsetAsync((char*)d_ws + O_BAR, 0, BAR_BYTES, st) != hipSuccess) { fprintf(stderr, "kernel_launch: memset failed\n"); return; }
    void* args[] = {&ma};
    hipError_t e = hipLaunchCooperativeKernel((const void*)mega, dim3(grid), dim3(MEGA_THREADS), args, MEGA_LDS, st);
    if (e != hipSuccess) fprintf(stderr, "kernel_launch: cooperative launch failed: %s (grid %d)\n", hipGetErrorString(e), grid);
}
```

```cpp
#include <hip/hip_runtime.h>
#include <hip/hip_cooperative_groups.h>
namespace cg = cooperative_groups;
#include <cstdint>
#include <cstdio>

typedef unsigned short bf16_t;
typedef unsigned u32x4 __attribute__((ext_vector_type(4)));
typedef unsigned u32x2 __attribute__((ext_vector_type(2)));
typedef float f32x4 __attribute__((ext_vector_type(4)));

constexpr int D = 1024, NB = 16, SEQ = 2048, M = NB * SEQ, ME = M + 256, NMETA = 16;
constexpr float EPS = 1e-6f;
constexpr int QR = 384, KVR = 256, NOPE = 128, ROPE = 64, RH = 32, QKD = 192;
constexpr int GDK = 512, GDV = 1024, GHK = 128, GHV = 256, GR = 16;
constexpr int DIN = 5840;
constexpr int S_CQ = 0, S_CKV = 384, S_KPE = 640, S_GQ = 704, S_GK = 1216, S_GV = 1728, S_GA = 2752, S_GG = 2768, S_A = 3792, S_B = 4816;
constexpr int WIN_ROWS = 5888, WIN_NAT = 4352, P0W = 768;
constexpr float SCL2 = 0.07216878364870323f * 1.4426950408889634f;
constexpr float GLA_QS = 0.08838834764831845f;
constexpr float SW_IN = 4.5f / 32.f / 127.f;

constexpr size_t MiB = 1u << 20;
constexpr size_t al(size_t x) { return (x + 255) / 256 * 256; }
constexpr size_t O_WIN = 0;
constexpr size_t O_WUQ = O_WIN + al((size_t)WIN_ROWS * D * 2);
constexpr size_t O_WUKV = O_WUQ + al((size_t)1536 * QR * 2);
constexpr size_t O_WOM = O_WUKV + al((size_t)2048 * KVR * 2);
constexpr size_t O_WOG = O_WOM + al((size_t)D * D * 2);
constexpr size_t O_WOUT = O_WOG + al((size_t)D * D * 2);
constexpr size_t O_WS = O_WOUT + al((size_t)D * D * 2);
constexpr size_t O_ROPE = O_WS + al((size_t)2048 * D * 2);
constexpr size_t O_R1 = O_ROPE + al((size_t)2064 * RH * 2 * 4);
constexpr size_t O_RQ = O_R1 + al((size_t)ME * 4);
constexpr size_t O_RKV = O_RQ + al((size_t)ME * 4);
constexpr size_t O_KPE = O_RKV + al((size_t)ME * 4);
constexpr size_t O_XB = O_KPE + al((size_t)ME * ROPE * 2);
constexpr size_t O_POOL = O_XB + al((size_t)ME * D * 2);
constexpr size_t O_GKT = O_POOL;
constexpr size_t O_GQ = O_GKT + al((size_t)ME * GDK * 2);
constexpr size_t O_P0 = O_GQ + al((size_t)ME * GDK * 2);
constexpr size_t O_GK = O_P0 + al((size_t)ME * P0W * 2);
constexpr size_t O_GVT = O_GK + al((size_t)ME * GDK * 2);
constexpr size_t O_GG = O_GVT + al((size_t)ME * GDV * 2);
constexpr size_t O_QC = O_GG + al((size_t)M * D * 2);
constexpr size_t O_KN = O_QC + al((size_t)M * 768 * 2);
constexpr size_t O_V = O_KN + al((size_t)ME * 512 * 2);
constexpr size_t O_END = O_V + al((size_t)ME * 512 * 2);
constexpr int GLA_NU = NB * 4 * 33;
constexpr size_t O_AG = O_END;
constexpr size_t O_DECL = O_AG + al((size_t)GLA_NU * 64 * 64 * 2);
constexpr size_t O_BAR = O_DECL + al((size_t)GLA_NU * 128 * 4);
constexpr size_t BAR_BYTES = 16384;
constexpr size_t O_SSQ = O_BAR + BAR_BYTES;
constexpr size_t O_WSEND = O_SSQ + al((size_t)M * 32 * 4);
static_assert(O_WSEND <= 512 * MiB, "ws");
constexpr size_t O_YA = O_XB;
constexpr size_t O_YB = O_P0;
static_assert(O_YB + (size_t)M * D * 2 <= O_GVT, "YB overlay");
constexpr size_t O_MIX = O_GVT;
constexpr size_t O_HN2 = O_XB;
constexpr size_t O_S = O_POOL;
constexpr size_t O_IDX = O_QC;
static_assert(O_S + (size_t)M * 2048 * 4 <= O_QC, "S overlay");
constexpr size_t O_GATE = O_IDX + al((size_t)M * 128 * 4);
constexpr size_t O_UB = O_GATE + al((size_t)M * 128 * 4);
constexpr size_t O_VB = O_UB + al((size_t)16384 * D * 2);
static_assert(O_VB + (size_t)16384 * D * 2 <= O_END, "tables overlay");

__device__ __forceinline__ float bf2f(bf16_t u) { return __uint_as_float((unsigned)u << 16); }
__device__ __forceinline__ bf16_t f2bf(float f) { unsigned u = __float_as_uint(f); return (bf16_t)((u + 0x7fffu + ((u >> 16) & 1u)) >> 16); }
__device__ __forceinline__ unsigned pk2(float lo, float hi) { return (unsigned)f2bf(lo) | ((unsigned)f2bf(hi) << 16); }
__device__ __forceinline__ void unpack8(u32x4 w, float* f) {
#pragma unroll
    for (int i = 0; i < 4; ++i) { f[2 * i] = __uint_as_float(w[i] << 16); f[2 * i + 1] = __uint_as_float(w[i] & 0xffff0000u); }
}
__device__ __forceinline__ u32x4 pack8(const float* f) { u32x4 w; w.x = pk2(f[0], f[1]); w.y = pk2(f[2], f[3]); w.z = pk2(f[4], f[5]); w.w = pk2(f[6], f[7]); return w; }
__device__ __forceinline__ float swap_add32(float a, float b) { const u32x2 r = __builtin_amdgcn_permlane32_swap(__float_as_uint(a), __float_as_uint(b), false, false); return __uint_as_float(r.x) + __uint_as_float(r.y); }
__device__ __forceinline__ float swap_add16(float a, float b) { const u32x2 r = __builtin_amdgcn_permlane16_swap(__float_as_uint(a), __float_as_uint(b), false, false); return __uint_as_float(r.x) + __uint_as_float(r.y); }
template <int CTRL> __device__ __forceinline__ float dpp_f(float x) { return __builtin_bit_cast(float, __builtin_amdgcn_update_dpp(0, __builtin_bit_cast(int, x), CTRL, 0xf, 0xf, true)); }
__device__ __forceinline__ float wsum(float v) {
    const float h = swap_add32(v, v); float s = swap_add16(h, h);
    s += dpp_f<0x128>(s); s += dpp_f<0xB1>(s); s += dpp_f<0x4E>(s); s += dpp_f<0x141>(s); return s;
}
__device__ __forceinline__ float wmax(float v) {
#pragma unroll
    for (int o = 32; o >= 1; o >>= 1) v = fmaxf(v, __shfl_xor(v, o));
    return v;
}
__device__ __forceinline__ int lane_id() { return (int)__builtin_amdgcn_mbcnt_hi(~0u, __builtin_amdgcn_mbcnt_lo(~0u, 0u)); }
__device__ __forceinline__ float sigmoidf_(float x) { return 1.f / (1.f + __expf(-x)); }
__device__ __forceinline__ int tok_pos(int row) { return row < M ? (row & (SEQ - 1)) + NMETA : row - M; }

enum { MAP_ID = 0, MAP_WIN = 1, MAP_UKV = 2 };
__device__ __forceinline__ int map_col(int mode, int n) {
    if (mode == MAP_ID) return n;
    if (mode == MAP_WIN) {
        if (n < 704) return n;
        if (n < 720) return S_GA + (n - 704);
        if (n < 768) return -1;
        if (n < 1280) return S_GQ + (n - 768);
        if (n < 2304) return S_GG + (n - 1280);
        if (n < 3328) return S_A + (n - 2304);
        if (n < 4352) return S_B + (n - 3328);
        if (n < 4864) return S_GK + (n - 4352);
        return S_GV + (n - 4864);
    }
    const int r = n >> 10, j = n & 1023;
    if (j < 512) return (4 * r + (j >> 7)) * 256 + (j & 127);
    return (4 * r + ((j - 512) >> 7)) * 256 + 128 + ((j - 512) & 127);
}
struct EpiProjNat {
    const float* R1; bf16_t *P0, *GQ, *GG, *GA, *GB;
    __device__ __forceinline__ void operator()(int row, int col, const float* v, float s) const {
        float o[8];
#pragma unroll
        for (int i = 0; i < 8; ++i) o[i] = v[i] * s;
        bf16_t* dst;
        if (col < 768) dst = P0 + (size_t)row * P0W + col;
        else if (col < 1280) dst = GQ + (size_t)row * GDK + (col - 768);
        else { if (row >= M) return;
            if (col < 2304) dst = GG + (size_t)row * D + (col - 1280);
            else if (col < 3328) dst = GA + (size_t)row * D + (col - 2304);
            else dst = GB + (size_t)row * D + (col - 3328); }
        *(u32x4*)dst = pack8(o);
    }
};
struct EpiProjTr {
    const float* R1; bf16_t *GKT, *GVT;
    __device__ __forceinline__ void operator()(int row, int col, const float* v, const f32x4 (&c)[2]) const {
        const float o[8] = {v[0] * c[0].x, v[1] * c[0].y, v[2] * c[0].z, v[3] * c[0].w, v[4] * c[1].x, v[5] * c[1].y, v[6] * c[1].z, v[7] * c[1].w};
        bf16_t* dst = row < 512 ? GKT + (size_t)row * ME + col : GVT + (size_t)(row - 512) * ME + col;
        *(u32x4*)dst = pack8(o);
    }
};
struct EpiUq {
    const float* RQ; bf16_t* QC;
    __device__ __forceinline__ void operator()(int row, int col, const float* v, float s) const {
        if (row >= M) return;
        float o[8];
#pragma unroll
        for (int i = 0; i < 8; ++i) o[i] = v[i] * s;
        *(u32x4*)(QC + (size_t)row * 768 + col) = pack8(o);
    }
};
struct EpiUkv {
    const float* RKV; bf16_t *KN, *V; int roff = 0, pad = 0;
    __device__ __forceinline__ void operator()(int row, int col, const float* v, float s) const {
        row += roff; float o[8];
#pragma unroll
        for (int i = 0; i < 8; ++i) o[i] = v[i] * s;
        bf16_t* dst = col < 512 ? KN + (size_t)row * 512 + col : V + (size_t)row * 512 + (col - 512);
        *(u32x4*)dst = pack8(o);
    }
};
struct EpiOut { static constexpr bool XFORM = false, ROWSTAT = false, PRE = false, AUX = true;
    const float* __restrict__ x; float* __restrict__ out; bf16_t* __restrict__ HB; float* __restrict__ SSQ;
    __device__ __forceinline__ bool keep(int) const { return false; }
    __device__ __forceinline__ void aux(int, int row, int col, u32x4 (&ax)[2]) const { ax[0] = *(const u32x4*)(x + (size_t)row * D + col); ax[1] = *(const u32x4*)(x + (size_t)row * D + col + 4); }
    __device__ __forceinline__ bool apply(int, int row, int col, float* v, const u32x4 (&ax)[2]) const {
        const f32x4 a = __builtin_bit_cast(f32x4, ax[0]), b = __builtin_bit_cast(f32x4, ax[1]);
        const float h[8] = {a.x + v[0], a.y + v[1], a.z + v[2], a.w + v[3], b.x + v[4], b.y + v[5], b.z + v[6], b.w + v[7]};
        *(u32x4*)(HB + (size_t)row * D + col) = pack8(h);
        float ss = (h[0] * h[0] + h[1] * h[1]) + (h[2] * h[2] + h[3] * h[3]) + (h[4] * h[4] + h[5] * h[5]) + (h[6] * h[6] + h[7] * h[7]);
        ss = swap_add16(ss, ss); ss = swap_add32(ss, ss);
        if (((col >> 3) & 3) == 0) SSQ[(size_t)row * 32 + (col >> 5)] = ss;
        return false; }
};
struct EpiScore { bf16_t* S;
    __device__ __forceinline__ void operator()(int row, int col, const float* v) const { *(u32x4*)(S + (size_t)row * 2048 + col) = pack8(v); }
};

namespace pg8 {
#define PG8_LAS __attribute__((address_space(3)))
typedef short bf16x8 __attribute__((ext_vector_type(8)));
constexpr int BM = 256, BK = 64, HALF = 128, HTB = HALF * BK * 2, STAGE_BYTES = 8 * HTB, NXCD = 8, WGM = 8;
__host__ __device__ __forceinline__ int lds_byte(int r, int c) { const int st = (r >> 4) * 2 + (c >> 5), rr = r & 15, cc = c & 31, ob = rr * 64 + cc * 2; return st * 1024 + (ob ^ (((ob >> 9) & 1) << 5)); }
__host__ __device__ __forceinline__ void stage_rc(int b, int& R, int& C) { const int st = b / 1024, sb = b % 1024, swz = sb ^ (((sb >> 9) & 1) << 5); R = (st >> 1) * 16 + swz / 64; C = (st & 1) * 32 + (swz % 64) / 2; }
__host__ __device__ __forceinline__ int perm32(int rho) { const int n = rho >> 4, i = rho & 15; return 8 * (i >> 2) + 4 * n + (i & 3); }
struct Unit { const char* A; const char* B; int pm, pn, gid; };
struct Fam { int lda, ldb, K; };
__device__ __forceinline__ void tile_of(int L, int nM, int nN, int& pm, int& pn) {
    const int nwg = nM * nN; int wgid = L; { const int q = nwg / NXCD, r = nwg % NXCD, xcd = wgid % NXCD, off = wgid / NXCD; wgid = (xcd < r ? xcd * (q + 1) : r * (q + 1) + (xcd - r) * q) + off; }
    const int nig = WGM * nN, gid = wgid / nig, fm = gid * WGM, gsz = (nM - fm) < WGM ? (nM - fm) : WGM;
    pm = fm + ((wgid % nig) % gsz); pn = (wgid % nig) / gsz;
}
typedef int i32x4 __attribute__((ext_vector_type(4)));
template <bool I8> __device__ __forceinline__ f32x4 mma16(bf16x8 b, bf16x8 a, f32x4 c) {
    if constexpr (I8) return __builtin_bit_cast(f32x4, __builtin_amdgcn_mfma_i32_16x16x64_i8(__builtin_bit_cast(i32x4, b), __builtin_bit_cast(i32x4, a), __builtin_bit_cast(i32x4, c), 0, 0, 0));
    else return __builtin_amdgcn_mfma_f32_16x16x32_bf16(b, a, c, 0, 0, 0); }
template <bool I8> __device__ __forceinline__ f32x4 acc_f(f32x4 a) { if constexpr (I8) { const i32x4 q = __builtin_bit_cast(i32x4, a); return (f32x4){(float)q.x, (float)q.y, (float)q.z, (float)q.w}; } else return a; }
template <class Epi, class Sched, bool I8 = false>
__device__ __forceinline__ void gemm_phase(PG8_LAS unsigned char* lds, const Fam f, const Sched& S, const Epi& E, int wv) {
    int tid_ = wv * 64 + lane_id(); asm volatile("" : "+v"(tid_));
    const int tid = tid_, wid = __builtin_amdgcn_readfirstlane(tid >> 6), lane = tid & 63, wr = wid >> 2, wc = wid & 3, fr = lane & 15, fq = lane >> 4;
    const int nt = f.K / BK;
    unsigned voffA[2], voffB[2];
#pragma unroll
    for (int i = 0; i < 2; ++i) { int R, C; stage_rc(tid * 16 + i * 8192, R, C); const int Rb = (R & ~31) + perm32(R & 31);
        voffA[i] = (unsigned)(R * f.lda + C) * 2u; voffB[i] = (unsigned)(Rb * f.ldb + C) * 2u; }
    const size_t kstep = (size_t)(BK * 2);
    const size_t hstepA = (size_t)HALF * f.lda * 2, hstepB = (size_t)HALF * f.ldb * 2;
    const unsigned ldsw = (unsigned)wid * 1024u;
    const int aoff = lds_byte(wr * 64 + fr, fq * 8), boff = lds_byte(wc * 32 + fr, fq * 8);
#define PG8_SA(b, h) (((b) * 2 + (h)) * HTB)
#define PG8_SB(b, h) ((4 + (b) * 2 + (h)) * HTB)
#define PG8_STAGE(bufoff, gbase, voff) do { _Pragma("unroll") for (int _i = 0; _i < 2; ++_i) \
        __builtin_amdgcn_global_load_lds((const unsigned*)((const char*)(gbase) + (voff)[_i]), (PG8_LAS unsigned*)(lds + (bufoff) + ldsw + _i * 8192), 16, 0, 0); } while (0)
#define PG8_LDA(dst, b, h) do { _Pragma("unroll") for (int m = 0; m < 4; ++m) _Pragma("unroll") for (int k = 0; k < 2; ++k) dst[m][k] = *(const PG8_LAS bf16x8*)(lds + PG8_SA(b, h) + aoff + m * 2048 + k * 1024); } while (0)
#define PG8_LDB(dst, b, h) do { _Pragma("unroll") for (int n = 0; n < 2; ++n) _Pragma("unroll") for (int k = 0; k < 2; ++k) dst[n][k] = *(const PG8_LAS bf16x8*)(lds + PG8_SB(b, h) + boff + n * 2048 + k * 1024); } while (0)
#define PG8_MMA(ai, bj, At, Bt) do { __builtin_amdgcn_s_setprio(1); _Pragma("unroll") for (int m = 0; m < 4; ++m) _Pragma("unroll") for (int n = 0; n < 2; ++n) _Pragma("unroll") for (int k = 0; k < 2; ++k) \
        acc[ai][bj][m][n] = mma16<I8>(Bt[n][k], At[m][k], acc[ai][bj][m][n]); __builtin_amdgcn_s_setprio(0); } while (0)
#define PG8_WAIT_V(n) asm volatile("s_waitcnt vmcnt(" #n ")" ::: "memory")
#define PG8_WAIT_L(n) asm volatile("s_waitcnt lgkmcnt(" #n ")" ::: "memory")
#define PG8_BAR __builtin_amdgcn_s_barrier()
#define PG8_SCHED __builtin_amdgcn_sched_barrier(0)
    Unit cur, nxt; int ui = 0;
    if (!S.next(0, cur)) return;
    f32x4 acc[2][2][4][2];
#pragma unroll
    for (int a = 0; a < 2; ++a)
#pragma unroll
        for (int b = 0; b < 2; ++b)
#pragma unroll
            for (int m = 0; m < 4; ++m)
#pragma unroll
                for (int n = 0; n < 2; ++n) acc[a][b][m][n] = (f32x4){0.f, 0.f, 0.f, 0.f};
    bf16x8 At[4][2], B0[2][2], B1[2][2];
    const char* cA = cur.A; const char* cB = cur.B;
    PG8_STAGE(PG8_SB(0, 0), cB, voffB); PG8_STAGE(PG8_SB(0, 1), cB + hstepB, voffB); PG8_STAGE(PG8_SA(0, 0), cA, voffA); PG8_STAGE(PG8_SA(0, 1), cA + hstepA, voffA);
    if (wr == 1) PG8_BAR;
    PG8_WAIT_V(2); PG8_BAR;
    PG8_STAGE(PG8_SB(1, 0), cB + kstep, voffB); PG8_STAGE(PG8_SA(1, 0), cA + kstep, voffA); PG8_STAGE(PG8_SB(1, 1), cB + hstepB + kstep, voffB);
    PG8_WAIT_V(6); PG8_BAR;
    for (;;) {
        const bool has_next = S.next(ui + 1, nxt);
        const char* nA = has_next ? nxt.A : cA; const char* nB = has_next ? nxt.B : cB;
        for (int t = 0; t < nt; t += 2) {
            const bool last = (t == nt - 2);
            const char* a1 = cA + (size_t)(t + 1) * kstep;
            const char* a2 = last ? nA : cA + (size_t)(t + 2) * kstep; const char* b2 = last ? nB : cB + (size_t)(t + 2) * kstep;
            const char* a3 = a2 + kstep; const char* b3 = b2 + kstep;
            PG8_LDB(B0, 0, 0); PG8_LDB(B1, 0, 1); PG8_SCHED; PG8_LDA(At, 0, 0); PG8_STAGE(PG8_SA(1, 1), a1 + hstepA, voffA);
            PG8_WAIT_V(8); PG8_WAIT_L(0); PG8_BAR; PG8_MMA(0, 0, At, B0); PG8_MMA(0, 1, At, B1); PG8_BAR; PG8_SCHED;
            PG8_LDA(At, 0, 1); PG8_STAGE(PG8_SB(0, 0), b2, voffB); PG8_STAGE(PG8_SB(0, 1), b2 + hstepB, voffB); PG8_STAGE(PG8_SA(0, 0), a2, voffA);
            PG8_WAIT_V(8); PG8_WAIT_L(0); PG8_BAR; PG8_MMA(1, 0, At, B0); PG8_MMA(1, 1, At, B1); PG8_BAR; PG8_SCHED;
            PG8_LDB(B0, 1, 0); PG8_LDB(B1, 1, 1); PG8_SCHED; PG8_LDA(At, 1, 0); PG8_STAGE(PG8_SA(0, 1), a2 + hstepA, voffA);
            PG8_WAIT_V(8); PG8_WAIT_L(0); PG8_BAR; PG8_MMA(0, 0, At, B0); PG8_MMA(0, 1, At, B1); PG8_BAR; PG8_SCHED;
            PG8_LDA(At, 1, 1); PG8_STAGE(PG8_SB(1, 0), b3, voffB); PG8_STAGE(PG8_SB(1, 1), b3 + hstepB, voffB); PG8_STAGE(PG8_SA(1, 0), a3, voffA);
            PG8_WAIT_V(8); PG8_WAIT_L(0); PG8_BAR; PG8_MMA(1, 0, At, B0); PG8_MMA(1, 1, At, B1); PG8_BAR; PG8_SCHED;
        }
        if (wr == 0) PG8_BAR;
        {
            const int row0 = cur.pm * BM + wr * 64 + fr, col0 = cur.pn * BM + wc * 32 + 8 * fq;
            float rs[2][4]; f32x4 cs[2][2];
            if constexpr (Epi::PRE) E.pre(cur.gid, row0, col0, rs, cs);
            bool stat = false; PG8_LAS float* XS = (PG8_LAS float*)(lds + 131072 + 512);
            if constexpr (Epi::ROWSTAT) { if (E.want_stat(cur.gid, cur.pn)) {
                stat = true;
#pragma unroll
                for (int ai = 0; ai < 2; ++ai)
#pragma unroll
                    for (int m = 0; m < 4; ++m)
#pragma unroll
                        for (int bj = 0; bj < 2; ++bj) { const f32x4 v0 = acc_f<I8>(acc[ai][bj][m][0]), v1 = acc_f<I8>(acc[ai][bj][m][1]);
                            float ss = (v0[0] * v0[0] + v0[1] * v0[1]) + (v0[2] * v0[2] + v0[3] * v0[3]) + (v1[0] * v1[0] + v1[1] * v1[1]) + (v1[2] * v1[2] + v1[3] * v1[3]);
                            ss = swap_add16(ss, ss); ss = swap_add32(ss, ss);
                            if (fq == 0) XS[(wc * 256 + ai * 128 + wr * 64 + m * 16 + fr) * 2 + bj] = ss; }
                asm volatile("s_waitcnt lgkmcnt(0)" ::: "memory"); __builtin_amdgcn_s_barrier(); asm volatile("" ::: "memory");
            } }
            if constexpr (Epi::AUX) {
                u32x4 axn[2]; E.aux(cur.gid, row0, col0, axn);
#pragma unroll
                for (int k = 0; k < 16; ++k) { const int ai = k >> 3, m = (k >> 1) & 3, bj = k & 1; u32x4 ax[2] = {axn[0], axn[1]};
                    if (k + 1 < 16) E.aux(cur.gid, row0 + ((k + 1) >> 3) * HALF + (((k + 1) >> 1) & 3) * 16, col0 + ((k + 1) & 1) * HALF, axn);
                    const f32x4 v0 = acc_f<I8>(acc[ai][bj][m][0]), v1 = acc_f<I8>(acc[ai][bj][m][1]);
                    float v[8] = {v0[0], v0[1], v0[2], v0[3], v1[0], v1[1], v1[2], v1[3]};
                    if (E.apply(cur.gid, row0 + ai * HALF + m * 16, col0 + bj * HALF, v, ax)) { acc[ai][bj][m][0] = (f32x4){v[0], v[1], v[2], v[3]}; acc[ai][bj][m][1] = (f32x4){v[4], v[5], v[6], v[7]}; } }
            } else
#pragma unroll
            for (int ai = 0; ai < 2; ++ai)
#pragma unroll
                for (int m = 0; m < 4; ++m)
#pragma unroll
                    for (int bj = 0; bj < 2; ++bj) {
                        const f32x4 v0 = acc_f<I8>(acc[ai][bj][m][0]), v1 = acc_f<I8>(acc[ai][bj][m][1]);
                        float v[8] = {v0[0], v0[1], v0[2], v0[3], v1[0], v1[1], v1[2], v1[3]};
                        if constexpr (Epi::XFORM) { if (E.xform(cur.gid, row0 + ai * HALF + m * 16, col0 + bj * HALF, v)) {
                            acc[ai][bj][m][0] = (f32x4){v[0], v[1], v[2], v[3]}; acc[ai][bj][m][1] = (f32x4){v[4], v[5], v[6], v[7]}; } }
                        else if constexpr (Epi::ROWSTAT) { float ss = 0.f; if (stat) { const int rl = (ai * 128 + wr * 64 + m * 16 + fr) * 2 + bj; ss = (XS[rl] + XS[512 + rl]) + (XS[1024 + rl] + XS[1536 + rl]); }
                            E(cur.gid, row0 + ai * HALF + m * 16, col0 + bj * HALF, v, ss, rs[ai][m], cs[bj]); }
                        else if constexpr (Epi::PRE) E(cur.gid, row0 + ai * HALF + m * 16, col0 + bj * HALF, v, rs[ai][m], cs[bj]);
                        else E(cur.gid, row0 + ai * HALF + m * 16, col0 + bj * HALF, v);
                    }
        }
        if (!has_next) break;
        bool keep = false; if constexpr (Epi::XFORM || Epi::AUX) keep = E.keep(cur.gid);
        if (!keep) {
#pragma unroll
        for (int a = 0; a < 2; ++a)
#pragma unroll
            for (int b = 0; b < 2; ++b)
#pragma unroll
                for (int m = 0; m < 4; ++m)
#pragma unroll
                    for (int n = 0; n < 2; ++n) acc[a][b][m][n] = (f32x4){0.f, 0.f, 0.f, 0.f};
        }
        cur = nxt; cA = nA; cB = nB; ++ui;
        if (wr == 1) PG8_BAR;
    }
    PG8_WAIT_V(0);
    PG8_BAR;
#undef PG8_SA
#undef PG8_SB
#undef PG8_STAGE
#undef PG8_LDA
#undef PG8_LDB
#undef PG8_MMA
#undef PG8_WAIT_V
#undef PG8_WAIT_L
#undef PG8_BAR
#undef PG8_SCHED
}
}


namespace att {
typedef short bf16x8 __attribute__((ext_vector_type(8)));
typedef short s16x4 __attribute__((ext_vector_type(4)));
typedef float f32x16 __attribute__((ext_vector_type(16)));
typedef PG8_LAS const char* lptr;
constexpr int KROWB = 384, SHM_K = 64 * KROWB, SHM_V = 64 * 256;
constexpr int L_K = 0, L_V = 2 * SHM_K, L_WS = L_V + 2 * SHM_V, L_END = L_WS + 8 * 256;
constexpr float THRL = 11.5f;
__device__ __forceinline__ int crow(int r, int hi) { return (r & 3) + 8 * (r >> 2) + 4 * hi; }
__device__ __forceinline__ unsigned cvtpk(float lo, float hi) { unsigned r; asm volatile("v_cvt_pk_bf16_f32 %0, %1, %2" : "=v"(r) : "v"(lo), "v"(hi)); return r; }
__device__ __forceinline__ int v_rd_base(int lane) { return ((lane & 3) << 3) | (((lane >> 2) & 3) << 6) | (((lane >> 4) & 1) << 5) | (((lane >> 5) & 1) << 8); }
constexpr int v_rd_off(int d0, int ks, int half) { return d0 * 512 + ks * 4096 + half * 2048; }
__device__ __forceinline__ void partialSM(f32x16& p0, f32x16& p1, float& m_reg, float& alpha) {
    float pmax = p0[0];
#pragma unroll
    for (int r = 1; r < 16; ++r) pmax = fmaxf(pmax, p0[r]);
#pragma unroll
    for (int r = 0; r < 16; ++r) pmax = fmaxf(pmax, p1[r]);
    { auto rr = __builtin_amdgcn_permlane32_swap(__float_as_uint(pmax), __float_as_uint(pmax), false, false); pmax = fmaxf(__uint_as_float(rr[0]), __uint_as_float(rr[1])); }
    float mn;
    if (__builtin_expect(__all(pmax - m_reg <= THRL), 1)) { mn = m_reg; alpha = 1.f; }
    else { mn = fmaxf(m_reg, pmax); alpha = __builtin_amdgcn_exp2f(m_reg - mn); m_reg = mn; }
#pragma unroll
    for (int r = 0; r < 16; ++r) { p0[r] = __builtin_amdgcn_exp2f(p0[r] - mn); p1[r] = __builtin_amdgcn_exp2f(p1[r] - mn); }
}
__device__ __forceinline__ void finishSM(const f32x16& p0, const f32x16& p1, float alpha, float& l_reg, bf16x8& pa0, bf16x8& pa1, bf16x8& pa2, bf16x8& pa3) {
    float ps = 0.f;
#pragma unroll
    for (int r = 0; r < 16; ++r) ps += p0[r] + p1[r];
    { auto rr = __builtin_amdgcn_permlane32_swap(__float_as_uint(ps), __float_as_uint(ps), false, false); ps = __uint_as_float(rr[0]) + __uint_as_float(rr[1]); }
    l_reg = l_reg * alpha + ps;
#define PK4(P, B_, OUT) do { unsigned a0 = cvtpk(P[B_+0], P[B_+1]), a1 = cvtpk(P[B_+2], P[B_+3]); unsigned b0 = cvtpk(P[B_+4], P[B_+5]), b1 = cvtpk(P[B_+6], P[B_+7]); \
        auto r0 = __builtin_amdgcn_permlane32_swap(a0, b0, false, false); auto r1 = __builtin_amdgcn_permlane32_swap(a1, b1, false, false); \
        u32x4 w = {r0[0], r1[0], r0[1], r1[1]}; OUT = __builtin_bit_cast(bf16x8, w); } while (0)
    PK4(p0, 0, pa0); PK4(p0, 8, pa1); PK4(p1, 0, pa2); PK4(p1, 8, pa3);
#undef PK4
}
template <int KB>
__device__ __forceinline__ void qkt(f32x16& p0, f32x16& p1, lptr K_lds, int r32, int hi, const bf16x8* qr) {
    p0 = f32x16{}; p1 = f32x16{};
    lptr kb[4];
#pragma unroll
    for (int dd = 0; dd < 4; ++dd) kb[dd] = K_lds + KB * SHM_K + r32 * KROWB + (((dd * 16 + hi * 8) * 2) ^ ((r32 & 7) << 4));
#pragma unroll
    for (int d0 = 0; d0 < 12; ++d0) { lptr a = kb[d0 & 3] + (d0 >> 2) * 128;
        const bf16x8 b0 = *(const PG8_LAS bf16x8*)a, b1 = *(const PG8_LAS bf16x8*)(a + 32 * KROWB);
        p0 = __builtin_amdgcn_mfma_f32_32x32x16_bf16(b0, qr[d0], p0, 0, 0, 0);
        p1 = __builtin_amdgcn_mfma_f32_32x32x16_bf16(b1, qr[d0], p1, 0, 0, 0); }
}
template <int VB>
__device__ __forceinline__ void pv_tile(f32x16* o, int vb0, bf16x8 pa0, bf16x8 pa1, bf16x8 pa2, bf16x8 pa3) {
#define TRRD(dst, off) asm volatile("ds_read_b64_tr_b16 %0, %1 offset:%2" : "=&v"(dst) : "v"(vb0), "i"(off) : "memory")
#define PV_D0(d0) do { s16x4 l0, l1, l2, l3, h0, h1, h2, h3; constexpr int b_ = VB * SHM_V + v_rd_off(d0, 0, 0); \
        TRRD(l0, b_); TRRD(h0, b_ + 2048); TRRD(l1, b_ + 4096); TRRD(h1, b_ + 6144); TRRD(l2, b_ + 8192); TRRD(h2, b_ + 10240); TRRD(l3, b_ + 12288); TRRD(h3, b_ + 14336); \
        asm volatile("s_waitcnt lgkmcnt(0)" ::: "memory"); __builtin_amdgcn_sched_barrier(0); \
        o[d0] = __builtin_amdgcn_mfma_f32_32x32x16_bf16(pa0, (bf16x8){l0[0], l0[1], l0[2], l0[3], h0[0], h0[1], h0[2], h0[3]}, o[d0], 0, 0, 0); \
        o[d0] = __builtin_amdgcn_mfma_f32_32x32x16_bf16(pa1, (bf16x8){l1[0], l1[1], l1[2], l1[3], h1[0], h1[1], h1[2], h1[3]}, o[d0], 0, 0, 0); \
        o[d0] = __builtin_amdgcn_mfma_f32_32x32x16_bf16(pa2, (bf16x8){l2[0], l2[1], l2[2], l2[3], h2[0], h2[1], h2[2], h2[3]}, o[d0], 0, 0, 0); \
        o[d0] = __builtin_amdgcn_mfma_f32_32x32x16_bf16(pa3, (bf16x8){l3[0], l3[1], l3[2], l3[3], h3[0], h3[1], h3[2], h3[3]}, o[d0], 0, 0, 0); } while (0)
    PV_D0(0); PV_D0(1); PV_D0(2); PV_D0(3);
#undef PV_D0
#undef TRRD
}
struct Tens { const bf16_t* QC; const bf16_t* KN; const bf16_t* KPE; const bf16_t* V; bf16_t* YA; const float* qn_nope; const float* qn_pe; const float* RT; };
__device__ __forceinline__ void attn_unit(PG8_LAS unsigned char* lds, const Tens& T, int b, int hh, int qb, int round, int wv) {
    int tid_ = wv * 64 + lane_id(); asm volatile("" : "+v"(tid_));
    const int tid = tid_, wid = __builtin_amdgcn_readfirstlane(tid >> 6), lane = tid & 63, r32 = lane & 31, hi = lane >> 5;
    const int NT = 4 * qb + 5, last_act = 4 * qb + (wid >> 1) + 1;
    unsigned koff[3]; bool kpe[3]; unsigned voff[2];
#pragma unroll
    for (int i = 0; i < 3; ++i) { const int p16 = (i * 8 + wid) * 64 + lane, row = p16 / 24, cp = p16 % 24, c = (cp & ~7) | ((cp & 7) ^ (row & 7));
        kpe[i] = c >= 16; koff[i] = kpe[i] ? (unsigned)(row * ROPE + (c - 16) * 8) * 2u : (unsigned)(row * 512 + hh * NOPE + c * 8) * 2u; }
#pragma unroll
    for (int i = 0; i < 2; ++i) { const int p16 = (i * 8 + wid) * 64 + lane, sub = p16 >> 5, kk = (sub >> 2) * 8 + ((p16 >> 2) & 7), cc = (sub & 3) * 32 + (p16 & 3) * 8;
        const int k = (kk & ~0xC) | ((kk & 4) << 1) | ((kk & 8) >> 1); voff[i] = (unsigned)(k * 512 + hh * 128 + cc) * 2u; }
    const unsigned ldsw = (unsigned)wid * 1024u;
#define ATT_DMA(jt, buf) do { const int kbase_ = (jt) == 0 ? M : b * SEQ + 64 * ((jt) - 1); \
        const char* kn_ = (const char*)(T.KN + (size_t)kbase_ * 512); const char* kp_ = (const char*)(T.KPE + (size_t)kbase_ * ROPE); const char* vv_ = (const char*)(T.V + (size_t)kbase_ * 512); \
        _Pragma("unroll") for (int i_ = 0; i_ < 3; ++i_) __builtin_amdgcn_global_load_lds((const unsigned*)((kpe[i_] ? kp_ : kn_) + koff[i_]), (PG8_LAS unsigned*)(lds + L_K + (buf) * SHM_K + ldsw + i_ * 8192), 16, 0, 0); \
        _Pragma("unroll") for (int i_ = 0; i_ < 2; ++i_) __builtin_amdgcn_global_load_lds((const unsigned*)(vv_ + voff[i_]), (PG8_LAS unsigned*)(lds + L_V + (buf) * SHM_V + ldsw + i_ * 8192), 16, 0, 0); } while (0)
    ATT_DMA(0, 0);
    const bf16_t* Qw = T.QC + (size_t)(b * SEQ + qb * 256 + wid * 32 + r32) * 768 + hh * QKD + hi * 8;
    bf16x8 qr[12];
#pragma unroll
    for (int d0 = 0; d0 < 12; ++d0) qr[d0] = *(const bf16x8*)(Qw + d0 * 16);
    {
        float ssn = 0.f, ssp = 0.f;
#pragma unroll
        for (int d0 = 0; d0 < 12; ++d0) { float f[8]; unpack8(__builtin_bit_cast(u32x4, qr[d0]), f); float t = 0.f;
#pragma unroll
            for (int j = 0; j < 8; ++j) t += f[j] * f[j];
            if (d0 < 8) ssn += t; else ssp += t; }
        ssn = swap_add32(ssn, ssn); ssp = swap_add32(ssp, ssp);
        const float rn = rsqrtf(ssn * (1.f / NOPE) + EPS) * SCL2, rp = rsqrtf(ssp * (1.f / ROPE) + EPS) * SCL2;
#pragma unroll
        for (int d0 = 0; d0 < 8; ++d0) { float f[8]; unpack8(__builtin_bit_cast(u32x4, qr[d0]), f);
            const f32x4 g0 = *(const f32x4*)(T.qn_nope + d0 * 16 + hi * 8), g1 = *(const f32x4*)(T.qn_nope + d0 * 16 + hi * 8 + 4);
            f[0] *= rn * g0.x; f[1] *= rn * g0.y; f[2] *= rn * g0.z; f[3] *= rn * g0.w; f[4] *= rn * g1.x; f[5] *= rn * g1.y; f[6] *= rn * g1.z; f[7] *= rn * g1.w;
            qr[d0] = __builtin_bit_cast(bf16x8, pack8(f)); }
        const int pos = qb * 256 + wid * 32 + r32 + NMETA;
#pragma unroll
        for (int dd = 0; dd < 2; ++dd) { float x1[8], x2[8]; unpack8(__builtin_bit_cast(u32x4, qr[8 + dd]), x1); unpack8(__builtin_bit_cast(u32x4, qr[10 + dd]), x2);
            const int c0 = dd * 16 + hi * 8;
#pragma unroll
            for (int j = 0; j < 8; ++j) { const float y1 = x1[j] * rp * T.qn_pe[c0 + j], y2 = x2[j] * rp * T.qn_pe[c0 + j + 32];
                const float cs = T.RT[(pos * RH + c0 + j) * 2], sn = T.RT[(pos * RH + c0 + j) * 2 + 1];
                x1[j] = y1 * cs - y2 * sn; x2[j] = y2 * cs + y1 * sn; }
            qr[8 + dd] = __builtin_bit_cast(bf16x8, pack8(x1)); qr[10 + dd] = __builtin_bit_cast(bf16x8, pack8(x2)); }
    }
    float m_reg = -1e30f, l_reg = 0.f; f32x16 o[4] = {};
    PG8_LAS float* wsf = (PG8_LAS float*)(lds + L_WS) + wid * 64;
    const lptr K_lds = (lptr)(lds + L_K);
    const int vb0 = (int)(uintptr_t)(lds + L_V) + v_rd_base(lane);
    asm volatile("s_waitcnt vmcnt(0)" ::: "memory"); __builtin_amdgcn_s_barrier(); asm volatile("" ::: "memory");
#define ATT_TILE(KB, t) do { if ((t) + 1 < NT) ATT_DMA((t) + 1, 1 - (KB)); \
        if ((t) <= last_act) { f32x16 p0, p1; qkt<KB>(p0, p1, K_lds, r32, hi, qr); \
            if ((t) == 0) { const float NEG = -__builtin_inff(); _Pragma("unroll") for (int r = 0; r < 16; ++r) { if (crow(r, hi) >= NMETA) p0[r] = NEG; p1[r] = NEG; } } \
            float alpha; partialSM(p0, p1, m_reg, alpha); \
            if (__any(alpha < 1.f)) { if (hi == 0) wsf[r32] = alpha; asm volatile("s_waitcnt lgkmcnt(0)" ::: "memory"); \
                _Pragma("unroll") for (int d_ = 0; d_ < 4; ++d_) _Pragma("unroll") for (int r = 0; r < 16; ++r) o[d_][r] *= wsf[crow(r, hi)]; } \
            bf16x8 pa0, pa1, pa2, pa3; finishSM(p0, p1, alpha, l_reg, pa0, pa1, pa2, pa3); __builtin_amdgcn_sched_barrier(0); \
            pv_tile<KB>(o, vb0, pa0, pa1, pa2, pa3); } \
        asm volatile("s_waitcnt vmcnt(0) lgkmcnt(0)" ::: "memory"); __builtin_amdgcn_s_barrier(); asm volatile("" ::: "memory"); } while (0)
    for (int t = 0; t < NT; t += 2) { ATT_TILE(0, t); if (t + 1 < NT) ATT_TILE(1, t + 1); }
#undef ATT_TILE
#undef ATT_DMA
    if (hi == 0) wsf[32 + r32] = l_reg; asm volatile("s_waitcnt lgkmcnt(0)" ::: "memory");
    bf16_t* Ow = T.YA + (size_t)(b * SEQ + qb * 256 + wid * 32) * D + (round * 4 + hh) * 128;
#pragma unroll
    for (int r = 0; r < 16; ++r) { const int orow = crow(r, hi); const float rl = __builtin_amdgcn_rcpf(wsf[32 + orow]);
#pragma unroll
        for (int d0 = 0; d0 < 4; ++d0) { const float v = o[d0][r] * rl, vn = dpp_f<0xB1>(v);
            if ((r32 & 1) == 0) *(unsigned*)(Ow + (size_t)orow * D + d0 * 32 + r32) = cvtpk(v, vn); } }
    asm volatile("s_waitcnt lgkmcnt(0)" ::: "memory"); __builtin_amdgcn_s_barrier(); asm volatile("" ::: "memory");
}
__device__ __forceinline__ void attn_phase(PG8_LAS unsigned char* lds, const Tens& T, int round, int G, int c, int wv) {
    for (int p = c; p < 256; p += G) {
        const int xcd = p & 7, j = p >> 3, x = j & 3, g = (j >> 2) * 8 + xcd, b = g >> 2, hh = g & 3;
        attn_unit(lds, T, b, hh, 7 - x, round, wv);
        attn_unit(lds, T, b, hh, x, round, wv);
    }
}
__device__ __forceinline__ void attn_phase_dyn(PG8_LAS unsigned char* lds, const Tens& T, int round, unsigned* ticket, volatile PG8_LAS unsigned* slot, int wv) {
    for (;;) {
        if (wv == 0 && lane_id() == 0) *slot = __hip_atomic_fetch_add(ticket, 1u, __ATOMIC_RELAXED, __HIP_MEMORY_SCOPE_AGENT);
        __syncthreads();
        const int u = (int)*slot;
        if (u >= 512) break;
        attn_unit(lds, T, (u & 63) >> 2, u & 3, 7 - (u >> 6), round, wv);
    }
}
}


namespace peer {
typedef _Float16 h2 __attribute__((ext_vector_type(2)));
__device__ __forceinline__ h2 as_h2(unsigned w) { return __builtin_bit_cast(h2, w); }
__device__ __forceinline__ void ins16(float (&t)[16], float x) {
#pragma unroll
    for (int i = 15; i >= 1; --i) t[i] = __builtin_amdgcn_fmed3f(t[i - 1], t[i], x);
    t[0] = fmaxf(t[0], x);
}
constexpr int TK_WAVE_LDS = 16384;
__device__ __forceinline__ void topk64(PG8_LAS float* wl, const bf16_t* __restrict__ S, const float* __restrict__ SSQ, int* __restrict__ IDX, float* __restrict__ GATE, int m0, int hd, bool tile, int lane) {
    {
        float ta[16], tb[16];
#pragma unroll
        for (int p = 0; p < 2; ++p) {
            float t[16];
#pragma unroll
            for (int i = 0; i < 16; ++i) t[i] = -__builtin_inff();
#pragma unroll 1
            for (int q = 0; q < 2; ++q) {
                u32x4 st[8];
#pragma unroll
                for (int j = 0; j < 8; ++j) { const int list = j * 8 + (lane >> 3);
                    st[j] = *(const u32x4*)(S + (size_t)(tile ? m0 + list : m0 + (list >> 3)) * 2048 + (tile ? hd : (list & 7)) * 256 + p * 128 + q * 64 + (lane & 7) * 8); }
#pragma unroll
                for (int j = 0; j < 8; ++j) { float f[8]; unpack8(st[j], f); PG8_LAS float* wp = wl + (j * 8 + (lane >> 3)) * 64 + (lane & 7) * 8;
                    *(PG8_LAS f32x4*)wp = (f32x4){f[0], f[1], f[2], f[3]}; *(PG8_LAS f32x4*)(wp + 4) = (f32x4){f[4], f[5], f[6], f[7]}; }
                asm volatile("s_waitcnt lgkmcnt(0)" ::: "memory");
#pragma unroll 8
                for (int i = 0; i < 64; ++i) { const int e = (i + lane) & 63; const float x = wl[lane * 64 + e];
                    ins16(t, __uint_as_float((__float_as_uint(x) & ~127u) | (unsigned)(q * 64 + e))); }
                asm volatile("s_waitcnt lgkmcnt(0)" ::: "memory");
            }
#pragma unroll
            for (int i = 0; i < 16; ++i) { if (p == 0) ta[i] = t[i]; else tb[i] = t[i]; }
        }
        PG8_LAS int* wi = (PG8_LAS int*)wl + lane * 33;
#pragma unroll
        for (int i = 0; i < 16; ++i) { wi[i] = (int)(__float_as_uint(ta[i]) & 127u); wi[16 + i] = (int)(__float_as_uint(tb[i]) & 127u);
            ta[i] = __uint_as_float(__float_as_uint(ta[i]) & ~127u); tb[i] = __uint_as_float(__float_as_uint(tb[i]) & ~127u); }
        float tc[16];
#pragma unroll
        for (int i = 0; i < 16; ++i) tc[i] = -__builtin_inff();
#pragma unroll
        for (int i = 0; i < 16; ++i)
#pragma unroll
            for (int j = 0; j < 16; ++j) if ((i + 1) * (j + 1) <= 16) ins16(tc, __uint_as_float((__float_as_uint(ta[i] + tb[j]) & ~255u) | (unsigned)(i * 16 + j)));
        asm volatile("s_waitcnt lgkmcnt(0)" ::: "memory");
        float g[16]; int id[16]; float sum = 0.f;
        const float mx = __uint_as_float(__float_as_uint(tc[0]) & ~255u);
        const int mtok = tile ? m0 + lane : m0 + (lane >> 3), mhd = tile ? hd : (lane & 7);
        float r2; { const float* sp = SSQ + (size_t)mtok * 32; float t = 0.f;
#pragma unroll
            for (int i = 0; i < 8; ++i) { const f32x4 q = *(const f32x4*)(sp + 4 * i); t += (q.x + q.y) + (q.z + q.w); }
            r2 = rsqrtf(t * (1.f / D) + EPS); }
#pragma unroll
        for (int k = 0; k < 16; ++k) { const unsigned key = __float_as_uint(tc[k]); const int pos = (int)(key & 255u);
            id[k] = wi[pos >> 4] * 128 + wi[16 + (pos & 15)]; g[k] = __expf((__uint_as_float(key & ~255u) - mx) * r2); sum += g[k]; }
        const float inv = 1.f / sum;
        const size_t o = ((size_t)mtok * 8 + mhd) * 16;
#pragma unroll
        for (int k = 0; k < 16; k += 4) { *(f32x4*)(GATE + o + k) = (f32x4){g[k] * inv, g[k + 1] * inv, g[k + 2] * inv, g[k + 3] * inv};
            *(u32x4*)(IDX + o + k) = (u32x4){(unsigned)id[k], (unsigned)id[k + 1], (unsigned)id[k + 2], (unsigned)id[k + 3]}; }
        asm volatile("s_waitcnt lgkmcnt(0)" ::: "memory");
    }
}
constexpr float PEER_SU = 94.4f, PEER_SV = 5.883f;
struct __attribute__((packed, aligned(4))) U3 { unsigned x, y, z; };
typedef unsigned u32x6 __attribute__((ext_vector_type(6)));
typedef float f32x32 __attribute__((ext_vector_type(32)));
typedef float f32x2 __attribute__((ext_vector_type(2)));
__device__ __forceinline__ float gelu_erf(float x) {
    const float z = fabsf(x) * 0.70710678118654752f, t = __builtin_amdgcn_rcpf(fmaf(0.3275911f, z, 1.f));
    const float pl = t * fmaf(t, fmaf(t, fmaf(t, fmaf(t, 1.061405429f, -1.453152027f), 1.421413741f), -0.284496736f), 0.254829592f);
    const float e = 1.f - pl * __expf(-z * z);
    return 0.5f * x * (1.f + (x < 0.f ? -e : e));
}
__device__ __forceinline__ int row3(int idx) { int t; asm("v_lshl_add_u32 %0, %1, 1, %1" : "=v"(t) : "v"(idx)); return t << 8; }
__device__ __forceinline__ void gather1s_phase(PG8_LAS unsigned char* lds, const bf16_t* __restrict__ HN, const int* __restrict__ IDX, const float* __restrict__ GATE, const unsigned char* __restrict__ U8, const unsigned char* __restrict__ V8, const float* __restrict__ SSQ, float* out, int G, int c, int wv) {
    int tid_ = wv * 64 + lane_id(); asm volatile("" : "+v"(tid_));
    const int lane = tid_ & 63, wid = wv;
    typedef unsigned u32x2_ __attribute__((ext_vector_type(2)));
    PG8_LAS u32x2_* LW = (PG8_LAS u32x2_*)(lds + wid * 2048);
#pragma unroll
    for (int i = 0; i < 4; ++i) LW[64 * i + lane] = (u32x2_){0u, 0u};
    const int m0 = c * 8 + wid, mstep = G * 8, l12 = 12 * lane, l8 = 8 * lane;
    if (m0 >= M) return;
#define LOAD_TOK(mm, lane) do { pi0 = IDX[(size_t)(mm) * 128 + lane]; pi1 = IDX[(size_t)(mm) * 128 + 64 + lane]; pg0 = GATE[(size_t)(mm) * 128 + lane]; pg1 = GATE[(size_t)(mm) * 128 + 64 + lane]; } while (0)
#define LOAD_HN(mm, lane) do { hp0 = *(const u32x4*)(HN + (size_t)(mm) * D + 16 * lane); hp1 = *(const u32x4*)(HN + (size_t)(mm) * D + 16 * lane + 8); pss = lane < 32 ? SSQ[(size_t)(mm) * 32 + lane] : 0.f; } while (0)
#define BUILD_LIST(base) do { const int i0_ = pi0, i1_ = pi1; const float g0_ = pg0, g1_ = pg1; \
          int cnt = (base); \
          _Pragma("unroll 1") for (int sl = 0; sl < 8; ++sl) { \
              const bool q0 = (i0_ >> 11) == sl, q1 = (i1_ >> 11) == sl; const unsigned long long k0 = __ballot(q0), k1 = __ballot(q1); \
              if (q0) LW[cnt + (int)__builtin_amdgcn_mbcnt_hi((unsigned)(k0 >> 32), __builtin_amdgcn_mbcnt_lo((unsigned)k0, 0u))] = (u32x2_){(unsigned)i0_, __float_as_uint(g0_)}; \
              cnt += __builtin_popcountll(k0); \
              if (q1) LW[cnt + (int)__builtin_amdgcn_mbcnt_hi((unsigned)(k1 >> 32), __builtin_amdgcn_mbcnt_lo((unsigned)k1, 0u))] = (u32x2_){(unsigned)i1_, __float_as_uint(g1_)}; \
              cnt += __builtin_popcountll(k1); } \
          asm volatile("s_waitcnt lgkmcnt(0)" ::: "memory"); } while (0)
#define LOAD_ROWS(dst, TAB, e) do { _Pragma("unroll") for (int j = 0; j < 8; ++j) dst[j] = *(const U3*)(TAB + (size_t)(unsigned)(row3((int)LW[(e) + j].x) + l12)); asm volatile("" ::: "memory"); } while (0)
    int pi0, pi1; float pg0, pg1, pss; u32x4 hp0, hp1;
    LOAD_TOK(m0, lane); BUILD_LIST(0); LOAD_HN(m0, lane);
    if (m0 + mstep < M) LOAD_TOK(m0 + mstep, lane);
    #define LOAD_ROWS4(dst, TAB, e) do { _Pragma("unroll") for (int j = 0; j < 8; ++j) dst[j] = *(const u32x2_*)(TAB + (size_t)(unsigned)(__mul24((int)LW[(e) + j].x, 512) + l8)); asm volatile("" ::: "memory"); } while (0)
    u32x2_ ub0[8], ub1[8], vb0[8];
    LOAD_ROWS4(ub0, U8, 0); LOAD_ROWS4(vb0, V8, 0); LOAD_ROWS4(ub1, U8, 8);
    int ring = 0;
#pragma unroll 1
    for (int m = m0; m < M; m += mstep) {
        f32x2 hn[8], acc[8]; unsigned hq1[2], hq2[2]; float hs1, hs2;
        int ln = lane; asm volatile("" : "+v"(ln));
        const float ssq = pss;
        { float f[16]; unpack8(hp0, f); unpack8(hp1, f + 8);
#pragma unroll
          for (int i = 0; i < 8; ++i) { hn[i] = (f32x2){f[2 * i], f[2 * i + 1]}; acc[i] = (f32x2){0.f, 0.f}; }
          float am = 0.f;
#pragma unroll
          for (int i = 0; i < 16; ++i) am = fmaxf(am, fabsf(f[i]));
          { const u32x2 r_ = __builtin_amdgcn_permlane32_swap(__float_as_uint(am), __float_as_uint(am), false, false); am = fmaxf(__uint_as_float(r_.x), __uint_as_float(r_.y)); }
          { const u32x2 r_ = __builtin_amdgcn_permlane16_swap(__float_as_uint(am), __float_as_uint(am), false, false); am = fmaxf(__uint_as_float(r_.x), __uint_as_float(r_.y)); }
          am = fmaxf(am, dpp_f<0x128>(am)); am = fmaxf(am, dpp_f<0xB1>(am)); am = fmaxf(am, dpp_f<0x4E>(am)); am = fmaxf(am, dpp_f<0x141>(am));
          hs1 = fmaxf(am, 1e-20f) * (1.f / 7.5f); hs2 = hs1 * (1.f / 16.f); const float i1_ = 1.f / hs1, i2_ = 1.f / hs2;
          hq1[0] = hq1[1] = hq2[0] = hq2[1] = 0u;
#pragma unroll
          for (int i = 0; i < 16; ++i) { const float q1 = fminf(fmaxf(__builtin_rintf(f[i] * i1_), -8.f), 7.f), rr = f[i] - q1 * hs1, q2 = fminf(fmaxf(__builtin_rintf(rr * i2_), -8.f), 7.f);
              hq1[i >> 3] |= ((unsigned)(int)q1 & 15u) << (4 * (i & 7)); hq2[i >> 3] |= ((unsigned)(int)q2 & 15u) << (4 * (i & 7)); } }
        float sq = swap_add16(swap_add32(ssq, ssq), swap_add32(ssq, ssq)); sq += dpp_f<0x128>(sq); sq += dpp_f<0xB1>(sq); sq += dpp_f<0x4E>(sq); sq += dpp_f<0x141>(sq);
        const float r2su = rsqrtf(sq * (1.f / D) + EPS) * (1.f / PEER_SU);
        if (m + mstep < M) { BUILD_LIST(ring ^ 128); LOAD_HN(m + mstep, ln); if (m + 2 * mstep < M) LOAD_TOK(m + 2 * mstep, ln); }
#define F4ACC(vb, b) { acc[4 * w + b] = __builtin_elementwise_fma((f32x2){a, a}, __builtin_amdgcn_cvt_scalef32_pk_f32_fp4(vb[j][w], 1.0f, b), acc[4 * w + b]); }
#define ACC_ROWS(vb, ap, j0, j1) do { _Pragma("unroll") for (int j = j0; j < j1; ++j) { const float a = __builtin_bit_cast(float, __builtin_amdgcn_readlane(__builtin_bit_cast(int, ap), j * 8)); \
                _Pragma("unroll") for (int w = 0; w < 2; ++w) { F4ACC(vb, 0) F4ACC(vb, 1) F4ACC(vb, 2) F4ACC(vb, 3) } } } while (0)
#define DOT8(ub, d) do { _Pragma("unroll") for (int j = 0; j < 8; ++j) {     \
                int t_ = __builtin_amdgcn_sdot8((int)ub[j].y, (int)hq1[1], __builtin_amdgcn_sdot8((int)ub[j].x, (int)hq1[0], 0, false), false) << 4; \
                t_ = __builtin_amdgcn_sdot8((int)ub[j].y, (int)hq2[1], __builtin_amdgcn_sdot8((int)ub[j].x, (int)hq2[0], t_, false), false); \
                d[j] = (float)t_ * hs2; } } while (0)
#define GSTEP(ub, vb, k, HAVE_PREV) do { const int e0 = ring + (k) * 8, e2 = (e0 + 16) & 255, e1 = (e0 + 8) & 255; \
            float d[8]; DOT8(ub, d); \
            asm volatile("" ::: "memory"); \
            LOAD_ROWS4(ub, U8, e2); \
            float s4[4], s2[2], s1; \
            if (HAVE_PREV) ACC_ROWS(vb, actp, 0, 1); \
            _Pragma("unroll") for (int j = 0; j < 4; ++j) s4[j] = swap_add32(d[j], d[j + 4]); \
            if (HAVE_PREV) ACC_ROWS(vb, actp, 1, 2); \
            _Pragma("unroll") for (int j = 0; j < 2; ++j) s2[j] = swap_add16(s4[j], s4[j + 2]); \
            if (HAVE_PREV) ACC_ROWS(vb, actp, 2, 3); \
            { const bool up = lane & 8; const float keep = up ? s2[1] : s2[0], send = up ? s2[0] : s2[1]; s1 = keep + dpp_f<0x128>(send); } \
            if (HAVE_PREV) ACC_ROWS(vb, actp, 3, 4); \
            s1 += dpp_f<0xB1>(s1); s1 += dpp_f<0x4E>(s1); s1 += dpp_f<0x141>(s1); \
            s1 *= r2su; \
            if (HAVE_PREV) ACC_ROWS(vb, actp, 4, 5); \
            const float actn = gelu_erf(s1) * __uint_as_float(LW[e0 + (lane >> 3)].y) * (1.f / PEER_SV); \
            if (HAVE_PREV) { ACC_ROWS(vb, actp, 5, 8); \
                asm volatile("" ::: "memory"); \
                LOAD_ROWS4(vb, V8, e0); } \
            actp = actn; \
        } while (0)
        float actp;
        GSTEP(ub0, vb0, 0, false);
#pragma unroll 1
        for (int k = 1; k < 15; k += 2) { GSTEP(ub1, vb0, k, true); GSTEP(ub0, vb0, k + 1, true); }
        GSTEP(ub1, vb0, 15, true);
        ACC_ROWS(vb0, actp, 0, 8);
        asm volatile("" ::: "memory");
        LOAD_ROWS4(vb0, V8, (ring + 128) & 255);
#undef GSTEP
#undef DOT8
#undef ACC_ROWS
#undef F4ACC
        int lo_ = lane; asm volatile("" : "+v"(lo_));
        float* o = out + (size_t)m * D + 16 * lo_;
#pragma unroll
        for (int i = 0; i < 4; ++i) *(f32x4*)(o + 4 * i) = (f32x4){hn[2 * i].x + acc[2 * i].x, hn[2 * i].y + acc[2 * i].y, hn[2 * i + 1].x + acc[2 * i + 1].x, hn[2 * i + 1].y + acc[2 * i + 1].y};
        ring ^= 128;
    }
#undef LOAD_ROWS
#undef LOAD_ROWS4
#undef BUILD_LIST
#undef LOAD_TOK
#undef LOAD_HN
    asm volatile("s_waitcnt lgkmcnt(0)" ::: "memory");
}
}
namespace gla {
#define LDS_BARRIER() do { asm volatile("s_waitcnt lgkmcnt(0)" ::: "memory"); __builtin_amdgcn_s_barrier(); asm volatile("" ::: "memory"); } while (0)
typedef short bf16x8 __attribute__((ext_vector_type(8)));
typedef float f32x16 __attribute__((ext_vector_type(16)));
__device__ __forceinline__ int chunk_row0(int b, int c) { return c == 0 ? M : b * SEQ + 64 * (c - 1); }
__device__ __forceinline__ int ppos(int d) { const int g = (d >> 2) & 3; return (d & ~12) | ((g == 1 ? 2 : (g == 2 ? 1 : g)) << 2); }
__device__ __forceinline__ unsigned cvtpk(float lo, float hi) { unsigned r; asm volatile("v_cvt_pk_bf16_f32 %0, %1, %2" : "=v"(r) : "v"(lo), "v"(hi)); return r; }
struct Tens { bf16_t* GQ; bf16_t* GKT; const bf16_t* GVT; bf16_t* GQo; bf16_t* GKTo; int var; const bf16_t* P0; const float* w_a2; const float* b_a; bf16_t* AG; float* DECL; bf16_t* OG; };
constexpr int PQROW = 136;
constexpr int BMROW = 132;
constexpr int P_GAL = 0, P_TOT = 2048, P_BM = 4096, P_QL = P_BM + 64 * BMROW * 4, P_KL = P_QL + 64 * PQROW * 2, P_END = P_KL + 64 * PQROW * 2;
struct PrepIn { u32x4 ga, kt0, kt1, q0, q1; };
__device__ __forceinline__ void prep_load(PrepIn& I, const Tens& T, int u, int tid) {
    const int b = u / 132, h = (u / 33) & 3, c = u % 33, row0 = chunk_row0(b, c), d = tid & 127, jq = tid >> 7, j = tid >> 3, c16 = tid & 7;
    I.ga = tid < 128 ? *(const u32x4*)(T.P0 + (size_t)(row0 + (tid >> 1)) * P0W + 704 + (tid & 1) * 8) : (u32x4){0u, 0u, 0u, 0u};
    const bf16_t* kt = T.GKT + (size_t)(h * GHK + d) * ME + row0 + jq * 16; I.kt0 = *(const u32x4*)kt; I.kt1 = *(const u32x4*)(kt + 8);
    const size_t g = (size_t)(row0 + j) * GDK + h * GHK + c16 * 16;
    I.q0 = *(const u32x4*)(T.GQ + g); I.q1 = *(const u32x4*)(T.GQ + g + 8);
}
__device__ __forceinline__ void prep_compute(PG8_LAS unsigned char* lds, const Tens& T, const PrepIn& I, const float (&w)[GR], float ba, int u, int tid, int wid, int lane) {
    const int b = u / 132, h = (u / 33) & 3, c = u % 33, row0 = chunk_row0(b, c), d = tid & 127, jq = tid >> 7, j = tid >> 3, c16 = tid & 7;
    PG8_LAS bf16_t* GAL = (PG8_LAS bf16_t*)(lds + P_GAL); PG8_LAS float* TOT = (PG8_LAS float*)(lds + P_TOT); PG8_LAS float* BM = (PG8_LAS float*)(lds + P_BM);
    PG8_LAS bf16_t* QL = (PG8_LAS bf16_t*)(lds + P_QL); PG8_LAS bf16_t* KL = (PG8_LAS bf16_t*)(lds + P_KL);
    if (tid < 128) *(PG8_LAS u32x4*)(GAL + (tid >> 1) * 16 + (tid & 1) * 8) = I.ga;
    LDS_BARRIER();
    float Bv[16]; float run = 0.f;
#pragma unroll
    for (int jj = 0; jj < 16; ++jj) { const int jt = jq * 16 + jj; float x = ba;
        const u32x4 g0 = *(const PG8_LAS u32x4*)(GAL + jt * 16), g1 = *(const PG8_LAS u32x4*)(GAL + jt * 16 + 8); float gf[16]; unpack8(g0, gf); unpack8(g1, gf + 8);
#pragma unroll
        for (int r = 0; r < GR; ++r) x += gf[r] * w[r];
        float la = (fminf(x, 0.f) - __logf(1.f + __expf(-fabsf(x)))) * (1.f / 16.f);
        if (c == 0 && jt >= NMETA) la = 0.f;
        run += la; Bv[jj] = run; }
    TOT[jq * 128 + d] = run;
    LDS_BARRIER();
    float base = 0.f, blast = 0.f;
#pragma unroll
    for (int g = 0; g < 4; ++g) { const float t = TOT[g * 128 + d]; blast += t; if (g < jq) base += t; }
#pragma unroll
    for (int jj = 0; jj < 16; ++jj) BM[(jq * 16 + jj) * BMROW + d] = base + Bv[jj];
    { float kf[16]; unpack8(I.kt0, kf); unpack8(I.kt1, kf + 8);
      const int pd = ppos(d);
#pragma unroll
      for (int jj = 0; jj < 16; ++jj) { const float e = __expf(-(base + Bv[jj])); KL[(jq * 16 + jj) * PQROW + pd] = f2bf(kf[jj] * e); kf[jj] *= e * __expf(blast); }
      bf16_t* kto = T.GKTo + (size_t)(h * GHK + d) * ME + row0 + jq * 16; if (T.var == 0) { *(u32x4*)kto = pack8(kf); *(u32x4*)(kto + 8) = pack8(kf + 8); } else if (kf[3] == 1.2345f) T.DECL[1] = 1.f; }
    if (jq == 0) T.DECL[(size_t)u * GHK + d] = __expf(blast);
    LDS_BARRIER();
    {
        float qf[16], bv[16]; unpack8(I.q0, qf); unpack8(I.q1, qf + 8);
#pragma unroll
        for (int i = 0; i < 4; ++i) { const f32x4 t = *(const PG8_LAS f32x4*)(BM + j * BMROW + c16 * 16 + 4 * i); bv[4 * i] = t.x; bv[4 * i + 1] = t.y; bv[4 * i + 2] = t.z; bv[4 * i + 3] = t.w; }
        float qo[16];
#pragma unroll
        for (int i = 0; i < 16; ++i) { const int p = (i & 3) | ((((i >> 2) == 1) ? 2 : ((i >> 2) == 2 ? 1 : (i >> 2))) << 2); qo[p] = qf[i] * GLA_QS * __expf(bv[i]); }
        const u32x4 qa = pack8(qo), qb = pack8(qo + 8);
        *(PG8_LAS u32x4*)(QL + j * PQROW + c16 * 16) = qa; *(PG8_LAS u32x4*)(QL + j * PQROW + c16 * 16 + 8) = qb;
        bf16_t* go = T.GQo + (size_t)(row0 + j) * GDK + h * GHK + c16 * 16; if (T.var == 0) { *(u32x4*)go = qa; *(u32x4*)(go + 8) = qb; } }
    LDS_BARRIER();
    { const int bi = wid >> 1, fr = lane & 15, fq = lane >> 4;
#pragma unroll
      for (int t = 0; t < 2; ++t) { const int bj = 2 * (wid & 1) + t; f32x4 acc = {0.f, 0.f, 0.f, 0.f};
#pragma unroll
        for (int s_ = 0; s_ < 4; ++s_) { const bf16x8 af = *(const PG8_LAS bf16x8*)(QL + (16 * bi + fr) * PQROW + 32 * s_ + 8 * fq), bf = *(const PG8_LAS bf16x8*)(KL + (16 * bj + fr) * PQROW + 32 * s_ + 8 * fq);
            acc = __builtin_amdgcn_mfma_f32_16x16x32_bf16(af, bf, acc, 0, 0, 0); }
#pragma unroll
        for (int r = 0; r < 4; ++r) { const int i = 16 * bi + fq * 4 + r, jc = 16 * bj + fr; if (T.var == 0) T.AG[((size_t)u * 64 + i) * 64 + jc] = f2bf(jc <= i ? acc[r] : 0.f); else if (acc[r] == 1.2345f) T.DECL[2] = 1.f; } } }
    LDS_BARRIER();
}
__device__ __forceinline__ int prep_unit_id(int k) { return k < NB * 4 * 32 ? (k >> 5) * 33 + 1 + (k & 31) : (k - NB * 4 * 32) * 33; }
__device__ __forceinline__ void prep_phase(PG8_LAS unsigned char* lds, const Tens& T, int G, int c, int wv) {
    int tid_ = wv * 64 + lane_id(); asm volatile("" : "+v"(tid_));
    const int tid = tid_, lane = tid & 63, wid = wv; constexpr int NK = NB * 4 * 32 + 4;
    if (c >= NK) return;
    PrepIn cur, nxt; prep_load(cur, T, prep_unit_id(c), tid);
    float w[GR], ba = 0.f; int hcur = -1;
#pragma unroll 1
    for (int k = c; k < NK; k += G) {
        const bool more = k + G < NK; const int u = prep_unit_id(k), h = (u / 33) & 3;
        if (more) prep_load(nxt, T, prep_unit_id(k + G), tid);
        if (h != hcur) { hcur = h; const int d = tid & 127;
#pragma unroll
            for (int r = 0; r < GR; ++r) w[r] = T.w_a2[r * GDK + h * GHK + d];
            ba = T.b_a[h * GHK + d]; }
        prep_compute(lds, T, cur, w, ba, u, tid, wid, lane);
        if (more) cur = nxt;
    }
}
constexpr int S_Q = 0, S_A = 64 * 272, S_K = S_A + 64 * 144, S_D = S_K + 128 * 144, S_BUF = S_D + 512;
__device__ __forceinline__ void scan_wg(PG8_LAS unsigned char* lds, const Tens& T, int b, int h, int wv) {
    int tid_ = wv * 64 + lane_id(); asm volatile("" : "+v"(tid_));
    const int tid = tid_, wid = __builtin_amdgcn_readfirstlane(tid >> 6), lane = tid & 63, r32 = lane & 31, hi = lane >> 5;
    f32x16 S[4];
#pragma unroll
    for (int i = 0; i < 4; ++i) S[i] = f32x16{};
    const int u0 = (b * 4 + h) * 33;
    u32x4 sq[2], sa, sk[2]; float sd = 0.f; bf16x8 vcur[4], vnxt[4];
    const bf16_t* vrow = T.GVT + (size_t)(h * GHV + 32 * wid + r32) * ME + 8 * hi;
#define GLA_LOAD(c_) do { const int row0_ = chunk_row0(b, (c_)); \
        _Pragma("unroll") for (int i = 0; i < 2; ++i) { const int ch = tid + i * 512; sq[i] = *(const u32x4*)(T.GQ + (size_t)(row0_ + (ch >> 4)) * GDK + h * GHK + (ch & 15) * 8); \
            sk[i] = *(const u32x4*)(T.GKT + (size_t)(h * GHK + (ch >> 3)) * ME + row0_ + (ch & 7) * 8); } \
        const int uc_ = (c_) == 0 ? h * 33 : u0 + (c_); sa = *(const u32x4*)(T.AG + ((size_t)uc_ * 64 + (tid >> 3)) * 64 + (tid & 7) * 8); if (tid < 128) sd = T.DECL[(size_t)uc_ * GHK + tid]; \
        _Pragma("unroll") for (int s_ = 0; s_ < 4; ++s_) vnxt[s_] = *(const bf16x8*)(vrow + row0_ + 16 * s_); } while (0)
#define GLA_WRITE(buf) do { PG8_LAS unsigned char* L_ = lds + (buf) * S_BUF; \
        _Pragma("unroll") for (int i = 0; i < 2; ++i) { const int ch = tid + i * 512; *(PG8_LAS u32x4*)(L_ + S_Q + (ch >> 4) * 272 + (ch & 15) * 16) = sq[i]; *(PG8_LAS u32x4*)(L_ + S_K + (ch >> 3) * 144 + (ch & 7) * 16) = sk[i]; } \
        *(PG8_LAS u32x4*)(L_ + S_A + (tid >> 3) * 144 + (tid & 7) * 16) = sa; if (tid < 128) *(PG8_LAS float*)(L_ + S_D + tid * 4) = sd; } while (0)
    GLA_LOAD(0); GLA_WRITE(0);
#pragma unroll
    for (int s_ = 0; s_ < 4; ++s_) vcur[s_] = vnxt[s_];
    LDS_BARRIER();
#pragma unroll 1
    for (int c = 0; c < 33; ++c) {
        if (c + 1 < 33) GLA_LOAD(c + 1);
        PG8_LAS unsigned char* L = lds + (c & 1) * S_BUF;
        f32x16 o[2];
#pragma unroll
        for (int ib = 0; ib < 2; ++ib) { o[ib] = f32x16{};
#pragma unroll
            for (int s_ = 0; s_ < 4; ++s_) { const bf16x8 af = *(const PG8_LAS bf16x8*)(L + S_A + (32 * ib + r32) * 144 + (16 * s_ + 8 * hi) * 2);
                o[ib] = __builtin_amdgcn_mfma_f32_32x32x16_bf16(af, vcur[s_], o[ib], 0, 0, 0); } }
#pragma unroll
        for (int s_ = 0; s_ < 8; ++s_) { const int db = s_ >> 1, t8 = 8 * (s_ & 1);
            u32x4 wv; wv.x = cvtpk(S[db][t8 + 0], S[db][t8 + 1]); wv.y = cvtpk(S[db][t8 + 2], S[db][t8 + 3]); wv.z = cvtpk(S[db][t8 + 4], S[db][t8 + 5]); wv.w = cvtpk(S[db][t8 + 6], S[db][t8 + 7]);
            const bf16x8 sf = __builtin_bit_cast(bf16x8, wv);
#pragma unroll
            for (int ib = 0; ib < 2; ++ib) { const bf16x8 qf = *(const PG8_LAS bf16x8*)(L + S_Q + (32 * ib + r32) * 272 + (16 * s_ + 8 * hi) * 2);
                o[ib] = __builtin_amdgcn_mfma_f32_32x32x16_bf16(qf, sf, o[ib], 0, 0, 0); } }
        if (c > 0) { bf16_t* Ow = T.OG + (size_t)chunk_row0(b, c) * D + h * GHV + 32 * wid;
#pragma unroll
            for (int ib = 0; ib < 2; ++ib)
#pragma unroll
                for (int r = 0; r < 16; ++r) { const int orow = 32 * ib + (r & 3) + 8 * (r >> 2) + 4 * hi; const float v = o[ib][r], vn = dpp_f<0xB1>(v);
                    if ((r32 & 1) == 0) *(unsigned*)(Ow + (size_t)orow * D + r32) = cvtpk(v, vn); } }
#pragma unroll
        for (int db = 0; db < 4; ++db) {
#pragma unroll
            for (int g = 0; g < 4; ++g) { const f32x4 dv = *(const PG8_LAS f32x4*)(L + S_D + (32 * db + 8 * g + 4 * hi) * 4);
                S[db][4 * g + 0] *= dv[0]; S[db][4 * g + 1] *= dv[1]; S[db][4 * g + 2] *= dv[2]; S[db][4 * g + 3] *= dv[3]; }
#pragma unroll
            for (int s_ = 0; s_ < 4; ++s_) { const bf16x8 kf = *(const PG8_LAS bf16x8*)(L + S_K + (32 * db + r32) * 144 + (16 * s_ + 8 * hi) * 2);
                S[db] = __builtin_amdgcn_mfma_f32_32x32x16_bf16(kf, vcur[s_], S[db], 0, 0, 0); } }
        if (c + 1 < 33) { GLA_WRITE((c + 1) & 1);
#pragma unroll
            for (int s_ = 0; s_ < 4; ++s_) vcur[s_] = vnxt[s_]; }
        LDS_BARRIER();
    }
#undef GLA_LOAD
#undef GLA_WRITE
}
}


#define XB_TMO      128
#define XB_XCNT(j)  (256  + 64 * (j))
#define XB_XSUB(j)  (1280 + 64 * (j))
#define XB_XGEN(j)  (2304 + 64 * (j))
#define XB_TOP      3328
#define XB_TOPGEN   3392
#define XCD_BAR_WORDS 3456
#define XB_SPIN_CAP (1u << 18)

__device__ __forceinline__ unsigned xb_ld(unsigned* p)              { return __hip_atomic_load(p, __ATOMIC_RELAXED, __HIP_MEMORY_SCOPE_AGENT); }
__device__ __forceinline__ unsigned xb_add(unsigned* p, unsigned v) { return __hip_atomic_fetch_add(p, v, __ATOMIC_RELAXED, __HIP_MEMORY_SCOPE_AGENT); }
__device__ __forceinline__ unsigned xb_xcc_id() { return (unsigned)__builtin_amdgcn_s_getreg((3 << 11) | 20) & 0xFu; }
#define XB_SPIN(cond, bar) do { unsigned _sp = 0; while (cond) { __builtin_amdgcn_s_sleep(1); \
    if ((++_sp & 255u) == 0u) { if (xb_ld(&(bar)[XB_TMO])) break; if (_sp > XB_SPIN_CAP) { atomicAdd(&(bar)[XB_TMO], 1u); break; } } } } while (0)

struct XcdBarrier {
    int wv;
    unsigned* bar; unsigned x;
    volatile PG8_LAS unsigned* st;
};

__device__ __forceinline__ XcdBarrier xcd_barrier_post(unsigned* bar, volatile PG8_LAS unsigned* st, int wv) {
    XcdBarrier b; b.wv = wv; b.bar = bar; b.x = xb_xcc_id(); b.st = st;
    if (wv == 0 && lane_id() == 0) (void)xb_add(&bar[XB_XCNT(b.x)], 1u);
    return b;
}
__device__ __forceinline__ void xcd_barrier_complete(unsigned* bar, unsigned x, unsigned& nloc, unsigned& nx) {
    const unsigned G = gridDim.x * gridDim.y * gridDim.z;
    unsigned sum, cnt, mine, sp = 0u;
    for (;;) {
        sum = 0u; cnt = 0u; mine = 0u;
#pragma unroll
        for (unsigned j = 0; j < 16; ++j) { const unsigned c = xb_ld(&bar[XB_XCNT(j)]); sum += c; cnt += (c > 0u) ? 1u : 0u; mine = (j == x) ? c : mine; }
        if (sum == G) break;
        __builtin_amdgcn_s_sleep(1);
        if ((++sp & 255u) == 0u) { if (xb_ld(&bar[XB_TMO])) break; if (sp > XB_SPIN_CAP) { atomicAdd(&bar[XB_TMO], 1u); break; } }
    }
    nloc = mine > 0u ? mine : 1u; nx = cnt > 0u ? cnt : 1u;
}

__device__ __forceinline__ void xcd_barrier(const XcdBarrier& b) {
    asm volatile("s_waitcnt vmcnt(0)" ::: "memory");
    __syncthreads();
    if (b.wv == 0 && lane_id() == 0) {
        unsigned* bar = b.bar;
        __builtin_amdgcn_s_waitcnt(0);
        unsigned nloc = b.st[0], nx = b.st[1];
        if (nloc == 0u) { xcd_barrier_complete(bar, b.x, nloc, nx); b.st[0] = nloc; b.st[1] = nx; }
        const unsigned old = xb_add(&bar[XB_XSUB(b.x)], 1u);
        const unsigned gen = old / nloc;
        if (old + 1u == (gen + 1u) * nloc) {
            __builtin_amdgcn_fence(__ATOMIC_RELEASE, "agent");
            asm volatile("s_waitcnt vmcnt(0)" ::: "memory");
            const unsigned og = xb_add(&bar[XB_TOP], 1u);
            const unsigned tg = og / nx;
            if (og + 1u == (tg + 1u) * nx) xb_add(&bar[XB_TOPGEN], 1u);
            else XB_SPIN(xb_ld(&bar[XB_TOPGEN]) == tg, bar);
            __builtin_amdgcn_fence(__ATOMIC_ACQUIRE, "agent");
            xb_add(&bar[XB_XGEN(b.x)], 1u);
            asm volatile("s_waitcnt vmcnt(0)" ::: "memory");
        } else {
            XB_SPIN(xb_ld(&bar[XB_XGEN(b.x)]) == gen, bar);
            __builtin_amdgcn_fence(__ATOMIC_ACQUIRE, "agent");
            asm volatile("s_waitcnt vmcnt(0)" ::: "memory");
        }
    }
    __syncthreads();
}

namespace sm {
__device__ __forceinline__ void prep_x(const float* __restrict__ x, const float* __restrict__ meta, bf16_t* __restrict__ XB, float* __restrict__ R1, int gw, int nw, int lane) {
    asm volatile("" : "+v"(lane));
    unsigned char* XQ = (unsigned char*)XB;
    for (int r0 = gw * 4; r0 < ME; r0 += nw * 4) {
        f32x4 v[4][4];
#pragma unroll
        for (int t = 0; t < 4; ++t) { const int r = r0 + t; const float* src = r < M ? x + (size_t)r * D : (r < M + NMETA ? meta + (size_t)(r - M) * D : nullptr);
#pragma unroll
            for (int j = 0; j < 4; ++j) v[t][j] = src ? *(const f32x4*)(src + 16 * lane + 4 * j) : (f32x4){0.f, 0.f, 0.f, 0.f}; }
#pragma unroll
        for (int t = 0; t < 4; ++t) { const int r = r0 + t; float ss = 0.f, am = 0.f;
#pragma unroll
            for (int j = 0; j < 4; ++j) { ss += v[t][j].x * v[t][j].x + v[t][j].y * v[t][j].y + v[t][j].z * v[t][j].z + v[t][j].w * v[t][j].w;
                am = fmaxf(fmaxf(am, fmaxf(fabsf(v[t][j].x), fabsf(v[t][j].y))), fmaxf(fabsf(v[t][j].z), fabsf(v[t][j].w))); }
            ss = wsum(ss);
            { const u32x2 q_ = __builtin_amdgcn_permlane32_swap(__float_as_uint(am), __float_as_uint(am), false, false); am = fmaxf(__uint_as_float(q_.x), __uint_as_float(q_.y)); }
            { const u32x2 q_ = __builtin_amdgcn_permlane16_swap(__float_as_uint(am), __float_as_uint(am), false, false); am = fmaxf(__uint_as_float(q_.x), __uint_as_float(q_.y)); }
            am = fmaxf(am, dpp_f<0x128>(am)); am = fmaxf(am, dpp_f<0xB1>(am)); am = fmaxf(am, dpp_f<0x4E>(am)); am = fmaxf(am, dpp_f<0x141>(am));
            const float rn = rsqrtf(ss * (1.f / D) + EPS), qs = am > 0.f ? 127.f / am : 0.f;
            if (lane == 0) R1[r] = am * rn * (1.f / 127.f) * SW_IN;
            u32x4 o;
#pragma unroll
            for (int j = 0; j < 4; ++j) { const int a0 = (int)__builtin_rintf(v[t][j].x * qs), a1 = (int)__builtin_rintf(v[t][j].y * qs), a2 = (int)__builtin_rintf(v[t][j].z * qs), a3 = (int)__builtin_rintf(v[t][j].w * qs);
                o[j] = (unsigned)(a0 & 255) | (unsigned)(a1 & 255) << 8 | (unsigned)(a2 & 255) << 16 | (unsigned)(a3 & 255) << 24; }
            *(u32x4*)(XQ + (size_t)r * D + 16 * lane) = o; }
    }
}
struct WDesc { const float* src; int Nsrc, K; bf16_t* dst; int Ndst; const float* gain; int gmod, mode; float qs; };
__device__ __forceinline__ void prep_w_load(const WDesc& W, int it, float (&x)[32], int lane) {
    const int nblk = W.Ndst / 32, kb = it / nblk, nb = it % nblk, k0 = 64 * kb, n0 = 32 * nb, c = map_col(W.mode, n0 + (lane & 31)), cs = c < 0 ? 0 : c;
    const float* sp = W.src + (size_t)(k0 + (lane >> 5)) * W.Nsrc + cs; const size_t st2 = (size_t)2 * W.Nsrc;
#pragma unroll
    for (int i = 0; i < 32; ++i) x[i] = sp[i * st2];
}
__device__ __forceinline__ void prep_w_fin(const WDesc& W, int it, const float (&x)[32], PG8_LAS float* scr, int lane) {
    const int nblk = W.Ndst / 32, kb = it / nblk, nb = it % nblk, k0 = 64 * kb, n0 = 32 * nb, c = map_col(W.mode, n0 + (lane & 31));
    const int cc = lane & 7;
    f32x4 g0 = (f32x4){1.f, 1.f, 1.f, 1.f}, g1 = g0;
    if (W.gain) { const float* gp = W.gain + (k0 + 8 * cc) % W.gmod; g0 = *(const f32x4*)gp; g1 = *(const f32x4*)(gp + 4); }
#pragma unroll
    for (int i = 0; i < 32; ++i) scr[(2 * i + (lane >> 5)) * 33 + (lane & 31)] = c < 0 ? 0.f : x[i];
    asm volatile("s_waitcnt lgkmcnt(0)" ::: "memory");
#pragma unroll
    for (int j = 0; j < 4; ++j) { const int n = (lane >> 3) + 8 * j; const PG8_LAS float* p = scr + (8 * cc) * 33 + n;
        if (W.qs > 0.f) { const float f_[8] = {p[0] * g0.x, p[33] * g0.y, p[66] * g0.z, p[99] * g0.w, p[132] * g1.x, p[165] * g1.y, p[198] * g1.z, p[231] * g1.w}; unsigned w_[2] = {0u, 0u};
#pragma unroll
            for (int e = 0; e < 8; ++e) w_[e >> 2] |= (unsigned)((int)fminf(fmaxf(__builtin_rintf(f_[e] * W.qs), -127.f), 127.f) & 255) << (8 * (e & 3));
            *(u32x2*)((unsigned char*)W.dst + (size_t)(n0 + n) * W.K + k0 + 8 * cc) = (u32x2){w_[0], w_[1]}; }
        else { u32x4 o; o.x = pk2(p[0] * g0.x, p[33] * g0.y); o.y = pk2(p[66] * g0.z, p[99] * g0.w); o.z = pk2(p[132] * g1.x, p[165] * g1.y); o.w = pk2(p[198] * g1.z, p[231] * g1.w);
            *(u32x4*)(W.dst + (size_t)(n0 + n) * W.K + k0 + 8 * cc) = o; } }
    asm volatile("s_waitcnt lgkmcnt(0)" ::: "memory");
}
struct WAll { const float *w_in, *g_in, *w_uq, *g_uq, *w_ukv, *g_ukv, *w_om, *w_og, *g_og, *w_out; bf16_t *WinT, *WuqT, *WukvT, *WomT, *WogT, *WoutT; };
__device__ __forceinline__ WDesc prep_w_pick(const WAll& A, int it, int& r) {
    constexpr int n0 = (D / 64) * (WIN_ROWS / 32), n1 = (QR / 64) * (1536 / 32), n2 = (KVR / 64) * (2048 / 32), n3 = (D / 64) * (D / 32);
    r = it;
    if (r < n0) return WDesc{A.w_in, DIN, D, A.WinT, WIN_ROWS, A.g_in, D, (int)MAP_WIN, 1.f / SW_IN}; r -= n0;
    if (r < n1) return WDesc{A.w_uq, 1536, QR, A.WuqT, 1536, A.g_uq, QR, (int)MAP_ID, 0.f}; r -= n1;
    if (r < n2) return WDesc{A.w_ukv, 2048, KVR, A.WukvT, 2048, A.g_ukv, KVR, (int)MAP_UKV, 0.f}; r -= n2;
    if (r < n3) return WDesc{A.w_om, D, D, A.WomT, D, (const float*)nullptr, 1, (int)MAP_ID, 0.f}; r -= n3;
    if (r < n3) return WDesc{A.w_og, D, D, A.WogT, D, A.g_og, GHV, (int)MAP_ID, 0.f}; r -= n3;
    return WDesc{A.w_out, D, D, A.WoutT, D, (const float*)nullptr, 1, (int)MAP_ID, 0.f};
}
__device__ __forceinline__ void prep_w_all(const WAll& A, PG8_LAS float* scr, int gw, int nw, int lane) {
    asm volatile("" : "+v"(lane));
    constexpr int NIT = (D / 64) * (WIN_ROWS / 32) + (QR / 64) * (1536 / 32) + (KVR / 64) * (2048 / 32) + 3 * (D / 64) * (D / 32);
    float xa[32], xb[32]; int ra, rb;
    if (gw < NIT) { const WDesc W = prep_w_pick(A, gw, ra); prep_w_load(W, ra, xa, lane); }
    for (int it = gw; it < NIT; it += 2 * nw) {
        const int i1 = it + nw, i2 = it + 2 * nw;
        if (i1 < NIT) { const WDesc W = prep_w_pick(A, i1, rb); prep_w_load(W, rb, xb, lane); }
        { const WDesc W = prep_w_pick(A, it, ra); prep_w_fin(W, ra, xa, scr, lane); }
        if (i2 < NIT) { const WDesc W = prep_w_pick(A, i2, ra); prep_w_load(W, ra, xa, lane); }
        if (i1 < NIT) { const WDesc W = prep_w_pick(A, i1, rb); prep_w_fin(W, rb, xb, scr, lane); }
    }
}
typedef float f32x16 __attribute__((ext_vector_type(16)));
__device__ __forceinline__ void prep_ws(const float* __restrict__ wq, const float* __restrict__ keys, const float* __restrict__ gain, bf16_t* __restrict__ WsT, int gw, int nw, int lane) {
    asm volatile("" : "+v"(lane));
    const int r = lane & 31, h = lane >> 5;
    for (int blk = gw; blk < 64 * 32; blk += nw) {
        const int n0 = (blk >> 5) * 32, k0 = (blk & 31) * 32, hp = n0 >> 7;
        const float* ap = wq + (size_t)(k0 + r) * 2048 + hp * 128 + 64 * h;
        const float* bp = keys + (size_t)(hp & 1) * 128 * 128 + (size_t)((n0 & 127) + r) * 128 + 64 * h;
        f32x4 av[16], bv[16];
#pragma unroll
        for (int i = 0; i < 16; ++i) { av[i] = *(const f32x4*)(ap + 4 * i); bv[i] = *(const f32x4*)(bp + 4 * i); }
        f32x16 c;
#pragma unroll
        for (int i = 0; i < 16; ++i) c[i] = 0.f;
#pragma unroll
        for (int i = 0; i < 16; ++i)
#pragma unroll
            for (int e = 0; e < 4; ++e) c = __builtin_amdgcn_mfma_f32_32x32x2f32(av[i][e], bv[i][e], c, 0, 0, 0);
#pragma unroll
        for (int g = 0; g < 4; ++g) {
            const int k = k0 + 8 * g + 4 * h; const f32x4 gq = *(const f32x4*)(gain + k);
            const unsigned long long o = (unsigned long long)pk2(c[4 * g] * gq.x, c[4 * g + 1] * gq.y) | ((unsigned long long)pk2(c[4 * g + 2] * gq.z, c[4 * g + 3] * gq.w) << 32);
            *(unsigned long long*)(WsT + (size_t)(n0 + r) * D + k) = o; }
    }
}
__device__ __forceinline__ void prep_rope(float* __restrict__ RT, int gt, int nt) {
    for (int i = gt; i < 2064 * RH; i += nt) { const int pos = i / RH, f = i % RH; const float inv = powf(10000.f, -(float)f / (float)RH); const float ang = (float)pos * inv; RT[2 * i] = cosf(ang); RT[2 * i + 1] = sinf(ang); }
}
__device__ __forceinline__ void p0stats(const bf16_t* __restrict__ P0, const float* __restrict__ kn_pe, const float* __restrict__ RT, float* __restrict__ RQ, float* __restrict__ RKV, bf16_t* __restrict__ KPE, int gw, int nw, int lane) {
    asm volatile("" : "+v"(lane));
    const bool kl = lane >= 16 && lane < 24, hi = lane & 4; const int ke = 8 * (lane & 7);
    const f32x4 gk0 = *(const f32x4*)(kn_pe + ke), gk1 = *(const f32x4*)(kn_pe + ke + 4);
    for (int r0 = gw * 4; r0 < ME; r0 += nw * 4) {
        u32x4 A[4], B[4]; f32x4 rt[4][4];
#pragma unroll
        for (int t = 0; t < 4; ++t) { const int r = r0 + t; const bf16_t* p = P0 + (size_t)r * P0W; A[t] = *(const u32x4*)(p + 8 * lane); B[t] = *(const u32x4*)(p + 512 + 8 * (lane & 31));
            const int pos = tok_pos(r) < 2064 ? tok_pos(r) : 0; const float* q = RT + ((size_t)pos * RH + 8 * (lane & 3)) * 2;
#pragma unroll
            for (int i = 0; i < 4; ++i) rt[t][i] = *(const f32x4*)(q + 4 * i); }
#pragma unroll
        for (int t = 0; t < 4; ++t) { const int r = r0 + t;
            float fa[8], fb[8]; unpack8(A[t], fa); unpack8(B[t], fb);
            float sa = 0.f, sb = 0.f;
#pragma unroll
            for (int i = 0; i < 8; ++i) { sa += fa[i] * fa[i]; sb += fb[i] * fb[i]; }
            const float sq = wsum(lane < 48 ? sa : 0.f), skv = wsum((lane >= 48 ? sa : 0.f) + (lane < 16 ? sb : 0.f)), sk = wsum(kl ? sb : 0.f);
            if (lane == 0) { RQ[r] = rsqrtf(sq * (1.f / QR) + EPS); RKV[r] = rsqrtf(skv * (1.f / KVR) + EPS); }
            if (kl) {
                const float rn = rsqrtf(sk * (1.f / ROPE) + EPS); float y[8], o[8];
                const float gk[8] = {gk0.x, gk0.y, gk0.z, gk0.w, gk1.x, gk1.y, gk1.z, gk1.w};
                const float cs[16] = {rt[t][0].x, rt[t][0].y, rt[t][0].z, rt[t][0].w, rt[t][1].x, rt[t][1].y, rt[t][1].z, rt[t][1].w, rt[t][2].x, rt[t][2].y, rt[t][2].z, rt[t][2].w, rt[t][3].x, rt[t][3].y, rt[t][3].z, rt[t][3].w};
#pragma unroll
                for (int i = 0; i < 8; ++i) y[i] = fb[i] * rn * gk[i];
#pragma unroll
                for (int i = 0; i < 8; ++i) { const float up = dpp_f<0x114>(y[i]), dn = dpp_f<0x104>(y[i]);
                    o[i] = hi ? y[i] * cs[2 * i] + up * cs[2 * i + 1] : y[i] * cs[2 * i] - dn * cs[2 * i + 1]; }
                *(u32x4*)(KPE + (size_t)r * ROPE + ke) = pack8(o); }
        }
    }
}
__device__ __forceinline__ void meta_kv(const bf16_t* __restrict__ P0, const bf16_t* __restrict__ Wkv, const float* __restrict__ RKV, const float* __restrict__ kn_nope, bf16_t* __restrict__ KN, bf16_t* __restrict__ V, int gw, int nw, int lane) {
    asm volatile("" : "+v"(lane));
    for (int it = gw; it < NMETA * 8; it += nw) {
        const int row = M + (it >> 3), g = it & 7; const bf16_t* a = P0 + (size_t)row * P0W + S_CKV; float acc[2] = {0.f, 0.f};
#pragma unroll
        for (int t = 0; t < 2; ++t) { const bf16_t* w = Wkv + (size_t)(g * 128 + lane + 64 * t) * KVR;
            for (int k = 0; k < KVR; k += 8) { float fa[8], fw[8]; unpack8(*(const u32x4*)(a + k), fa); unpack8(*(const u32x4*)(w + k), fw);
#pragma unroll
                for (int i = 0; i < 8; ++i) acc[t] += fa[i] * fw[i]; } }
        const float sc = RKV[row]; acc[0] *= sc; acc[1] *= sc;
        if (g < 4) { const float rn = rsqrtf(wsum(acc[0] * acc[0] + acc[1] * acc[1]) * (1.f / NOPE) + EPS);
            KN[(size_t)row * 512 + g * 128 + lane] = f2bf(acc[0] * rn * kn_nope[lane]); KN[(size_t)row * 512 + g * 128 + lane + 64] = f2bf(acc[1] * rn * kn_nope[lane + 64]); }
        else { V[(size_t)row * 512 + (g - 4) * 128 + lane] = f2bf(acc[0]); V[(size_t)row * 512 + (g - 4) * 128 + lane + 64] = f2bf(acc[1]); }
    }
}
__device__ __forceinline__ void gla_post(const bf16_t* OG, const bf16_t* __restrict__ GG, bf16_t* OO, int gw, int nw, int lane) {
    asm volatile("" : "+v"(lane));
    for (int r0 = gw * 2; r0 < M; r0 += nw * 2) {
        u32x4 ow[2][2], gwv[2][2];
#pragma unroll
        for (int t = 0; t < 2; ++t) { const size_t off = (size_t)(r0 + t) * D + 16 * lane;
            ow[t][0] = *(const u32x4*)(OG + off); ow[t][1] = *(const u32x4*)(OG + off + 8); gwv[t][0] = *(const u32x4*)(GG + off); gwv[t][1] = *(const u32x4*)(GG + off + 8); }
#pragma unroll
        for (int t = 0; t < 2; ++t) { float o[16], g[16]; unpack8(ow[t][0], o); unpack8(ow[t][1], o + 8); unpack8(gwv[t][0], g); unpack8(gwv[t][1], g + 8);
            float ss = 0.f;
#pragma unroll
            for (int i = 0; i < 16; ++i) ss += o[i] * o[i];
            ss += dpp_f<0xB1>(ss); ss += dpp_f<0x4E>(ss); ss += dpp_f<0x141>(ss); ss += dpp_f<0x128>(ss);
            const float rn = rsqrtf(ss * (1.f / GHV) + EPS);
#pragma unroll
            for (int i = 0; i < 16; ++i) o[i] = o[i] * rn * g[i] * sigmoidf_(g[i]);
            const size_t off = (size_t)(r0 + t) * D + 16 * lane; *(u32x4*)(OO + off) = pack8(o); *(u32x4*)(OO + off + 8) = pack8(o + 8); }
    }
}
struct __attribute__((packed, aligned(4))) U3 { unsigned x, y, z; };
__device__ __forceinline__ unsigned enc_e2m3(float v) {
    const float t = fminf(fabsf(v) * 8.f, 60.f);
    const float m = t < 16.f ? 1.f : t < 32.f ? 0.5f : 0.25f; const unsigned b = t < 16.f ? 0u : t < 32.f ? 8u : 16u;
    return ((unsigned)(int)__builtin_rintf(t * m) + b) | (v < 0.f ? 32u : 0u);
}
__device__ __forceinline__ void conv_f6(const float* __restrict__ a, unsigned char* __restrict__ ao, float scale, const float* __restrict__ gain, int n16, int gt, int nt) {
    for (int i0 = gt; i0 < n16; i0 += 2 * nt) {
        const int i1 = i0 + nt < n16 ? i0 + nt : i0;
        f32x4 x[2][4], g[2][4];
#pragma unroll
        for (int t = 0; t < 2; ++t)
#pragma unroll
            for (int j = 0; j < 4; ++j) { const int i = t ? i1 : i0; x[t][j] = *(const f32x4*)(a + (size_t)i * 16 + 4 * j); g[t][j] = *(const f32x4*)(gain + (i & 63) * 16 + 4 * j); }
#pragma unroll
        for (int t = 0; t < 2; ++t) { const int i = t ? i1 : i0;
            unsigned c[16];
#pragma unroll
            for (int j = 0; j < 4; ++j) { const f32x4 v = x[t][j], q = g[t][j];
                c[4 * j] = enc_e2m3(v.x * q.x * scale); c[4 * j + 1] = enc_e2m3(v.y * q.y * scale); c[4 * j + 2] = enc_e2m3(v.z * q.z * scale); c[4 * j + 3] = enc_e2m3(v.w * q.w * scale); }
            unsigned long long lo = 0ull;
#pragma unroll
            for (int j = 0; j < 10; ++j) lo |= (unsigned long long)c[j] << (6 * j);
            lo |= (unsigned long long)(c[10] & 15u) << 60;
            unsigned hi = c[10] >> 4;
#pragma unroll
            for (int j = 11; j < 16; ++j) hi |= c[j] << (6 * (j - 11) + 2);
            *(U3*)(ao + (size_t)i * 12) = U3{(unsigned)lo, (unsigned)(lo >> 32), hi}; }
    }
}
__device__ __forceinline__ unsigned enc_e2m1(float v) {
    const float t = fabsf(v);
    return (unsigned)((t > 0.25f) + (t > 0.75f) + (t > 1.25f) + (t > 1.75f) + (t > 2.5f) + (t > 3.5f) + (t > 5.f)) | (v < 0.f ? 8u : 0u);
}
__device__ __forceinline__ void conv_f4(const float* __restrict__ a, unsigned char* __restrict__ ao, float scale, int n16, int gt, int nt) {
    for (int i0 = gt; i0 < n16; i0 += 2 * nt) {
        const int i1 = i0 + nt < n16 ? i0 + nt : i0;
        f32x4 x[2][4];
#pragma unroll
        for (int t = 0; t < 2; ++t)
#pragma unroll
            for (int j = 0; j < 4; ++j) x[t][j] = *(const f32x4*)(a + (size_t)(t ? i1 : i0) * 16 + 4 * j);
#pragma unroll
        for (int t = 0; t < 2; ++t) { unsigned w0 = 0u, w1 = 0u;
#pragma unroll
            for (int j = 0; j < 4; ++j) { const f32x4 v = x[t][j];
                const unsigned c = enc_e2m1(v.x * scale) | enc_e2m1(v.y * scale) << 4 | enc_e2m1(v.z * scale) << 8 | enc_e2m1(v.w * scale) << 12;
                if (j < 2) w0 |= c << (16 * j); else w1 |= c << (16 * (j - 2)); }
            *(u32x2*)(ao + (size_t)(t ? i1 : i0) * 8) = (u32x2){w0, w1}; }
    }
}
__device__ __forceinline__ unsigned enc_s4(float v) { return (unsigned)(int)fminf(fmaxf(__builtin_rintf(v), -8.f), 7.f) & 15u; }
__device__ __forceinline__ void conv_s4g(const float* __restrict__ a, unsigned char* __restrict__ ao, float scale, const float* __restrict__ gain, int n16, int gt, int nt) {
    for (int i0 = gt; i0 < n16; i0 += 2 * nt) {
        const int i1 = i0 + nt < n16 ? i0 + nt : i0;
        f32x4 x[2][4], g[2][4];
#pragma unroll
        for (int t = 0; t < 2; ++t)
#pragma unroll
            for (int j = 0; j < 4; ++j) { const int i = t ? i1 : i0; x[t][j] = *(const f32x4*)(a + (size_t)i * 16 + 4 * j); g[t][j] = *(const f32x4*)(gain + (i & 63) * 16 + 4 * j); }
#pragma unroll
        for (int t = 0; t < 2; ++t) { unsigned w0 = 0u, w1 = 0u;
#pragma unroll
            for (int j = 0; j < 4; ++j) { const f32x4 v = x[t][j], q = g[t][j];
                const unsigned c = enc_s4(v.x * q.x * scale) | enc_s4(v.y * q.y * scale) << 4 | enc_s4(v.z * q.z * scale) << 8 | enc_s4(v.w * q.w * scale) << 12;
                if (j < 2) w0 |= c << (16 * j); else w1 |= c << (16 * (j - 2)); }
            *(u32x2*)(ao + (size_t)(t ? i1 : i0) * 8) = (u32x2){w0, w1}; }
    }
}
}

#ifndef REP_G
#define REP_G 1
#endif
#ifndef REP_A
#define REP_A 1
#endif
#ifndef REP_GA
#define REP_GA 1
#endif
#ifndef REP_P
#define REP_P 1
#endif
#ifndef REP_R
#define REP_R 1
#endif
#ifndef REP_SY
#define REP_SY 1
#endif
#ifndef REP_T
#define REP_T 1
#endif
#ifndef REP_U
#define REP_U 1
#endif
#ifndef PREP_VAR
#define PREP_VAR 0
#endif
#ifndef REP_S
#define REP_S 1
#endif
constexpr int MEGA_THREADS = 512, MEGA_LDS = 147456;
struct MegaArgs {
    const float* in[23]; float* out; char* ws; int ph_lo, ph_hi, coop, pad;
};
enum { PH_PREP = 0, PH_PROJ = 1, PH_STATS = 2, PH_UP = 3, PH_ATT = 4, PH_GLAPOST = 7, PH_MIX = 8, PH_OUT = 9, PH_SCORE = 10, PH_GATHER = 11, PH_N = 12 };

struct SchedProj { const char* XB; const char* WinT; int G, c;
    __device__ __forceinline__ bool next(int i, pg8::Unit& u) const {
        const int L = i * G + c; constexpr int NNAT = 129 * 17, NTR = 6 * 129;
        if (L >= NNAT + NTR) return false;
        if (L < NNAT) { pg8::tile_of(L, 129, 17, u.pm, u.pn); u.gid = 0; u.A = XB + (size_t)u.pm * 256 * D; u.B = WinT + (size_t)u.pn * 256 * D; }
        else { pg8::tile_of(L - NNAT, 6, 129, u.pm, u.pn); u.gid = 1; u.A = WinT + (size_t)(WIN_NAT + u.pm * 256) * D; u.B = XB + (size_t)u.pn * 256 * D; }
        return true; }
};
struct EpiProj { static constexpr bool XFORM = false, ROWSTAT = false, PRE = true, AUX = false; EpiProjNat n; EpiProjTr t;
    __device__ __forceinline__ void pre(int gid, int row0, int col0, float (&rs)[2][4], f32x4 (&cs)[2][2]) const {
        if (gid == 0) {
#pragma unroll
            for (int ai = 0; ai < 2; ++ai)
#pragma unroll
                for (int m = 0; m < 4; ++m) rs[ai][m] = n.R1[row0 + ai * 128 + m * 16]; }
        else {
#pragma unroll
            for (int bj = 0; bj < 2; ++bj) { cs[bj][0] = *(const f32x4*)(t.R1 + col0 + bj * 128); cs[bj][1] = *(const f32x4*)(t.R1 + col0 + bj * 128 + 4); } } }
    __device__ __forceinline__ void operator()(int gid, int row, int col, const float* v, float rsv, const f32x4 (&csv)[2]) const { if (gid == 0) n(row, col, v, rsv); else t(row, col, v, csv); } };
struct SchedSimple { const char* A; const char* B; size_t sA, sB; int nM, nN, G, c, gid;
    __device__ __forceinline__ bool next(int i, pg8::Unit& u) const {
        const int L = i * G + c; if (L >= nM * nN) return false;
        pg8::tile_of(L, nM, nN, u.pm, u.pn); u.gid = gid; u.A = A + (size_t)u.pm * sA; u.B = B + (size_t)u.pn * sB; return true; }
};
struct EpiUp { static constexpr bool XFORM = false, ROWSTAT = true, PRE = true, AUX = false; EpiUq q; EpiUkv kv; const float* kn_nope;
    __device__ __forceinline__ bool want_stat(int gid, int pn) const { return gid == 1 && pn < 2; }
    __device__ __forceinline__ void pre(int gid, int row0, int col0, float (&rs)[2][4], f32x4 (&cs)[2][2]) const {
        const float* R = gid == 0 ? q.RQ : kv.RKV;
#pragma unroll
        for (int ai = 0; ai < 2; ++ai)
#pragma unroll
            for (int m = 0; m < 4; ++m) rs[ai][m] = R[row0 + ai * 128 + m * 16];
        cs[0][0] = *(const f32x4*)(kn_nope + (col0 & 127)); cs[0][1] = *(const f32x4*)(kn_nope + (col0 & 127) + 4); cs[1][0] = cs[0][0]; cs[1][1] = cs[0][1]; }
    __device__ __forceinline__ void operator()(int gid, int row, int col, const float* v, float ss, float s, const f32x4 (&g)[2]) const {
        if (gid == 0) { q(row, col, v, s); return; }
        if (col < 512) {
            const float rn = s * rsqrtf(s * s * ss * (1.f / NOPE) + EPS);
            const float o[8] = {v[0] * rn * g[0].x, v[1] * rn * g[0].y, v[2] * rn * g[0].z, v[3] * rn * g[0].w, v[4] * rn * g[1].x, v[5] * rn * g[1].y, v[6] * rn * g[1].z, v[7] * rn * g[1].w};
            *(u32x4*)(kv.KN + (size_t)row * 512 + col) = pack8(o); }
        else kv(row, col, v, s); }
};
template <class E1> struct EpiWrap { static constexpr bool XFORM = false, ROWSTAT = false, PRE = false, AUX = false; E1 e;
    __device__ __forceinline__ void operator()(int, int row, int col, const float* v) const { e(row, col, v); } };
struct SchedMix { const char* YA; const char* YB; const char* W1; const char* W2; int G, c;
    __device__ __forceinline__ bool next(int i, pg8::Unit& u) const {
        const int L = (i >> 1) * G + c; if (L >= 128 * 4) return false;
        pg8::tile_of(L, 128, 4, u.pm, u.pn); u.gid = i & 1;
        u.A = (u.gid ? YB : YA) + (size_t)u.pm * 256 * D * 2; u.B = (u.gid ? W2 : W1) + (size_t)u.pn * 256 * D * 2; return true; }
};
struct EpiMix { static constexpr bool XFORM = false, ROWSTAT = false, PRE = false, AUX = true; const bf16_t* __restrict__ GA; const bf16_t* __restrict__ GB; bf16_t* __restrict__ MIX;
    __device__ __forceinline__ bool keep(int gid) const { return gid == 0; }
    __device__ __forceinline__ void aux(int gid, int row, int col, u32x4 (&ax)[2]) const { ax[1] = *(const u32x4*)(GB + (size_t)row * D + col); if (gid == 0) ax[0] = *(const u32x4*)(GA + (size_t)row * D + col); }
    __device__ __forceinline__ bool apply(int gid, int row, int col, float* v, const u32x4 (&ax)[2]) const {
        float gb[8]; unpack8(ax[1], gb);
        if (gid == 0) { float ga[8]; unpack8(ax[0], ga);
#pragma unroll
            for (int i = 0; i < 8; ++i) v[i] *= (1.f + __expf(-gb[i])) / (1.f + __expf(-ga[i]));
            return true; }
        float o[8];
#pragma unroll
        for (int i = 0; i < 8; ++i) o[i] = v[i] * sigmoidf_(gb[i]);
        *(u32x4*)(MIX + (size_t)row * D + col) = pack8(o); return false; }
};

__global__ void __launch_bounds__(MEGA_THREADS, 2) mega(MegaArgs a) {
    extern __shared__ __attribute__((aligned(16))) unsigned char lds_raw[];
    PG8_LAS unsigned char* lds = (PG8_LAS unsigned char*)lds_raw;
    cg::grid_group grid = cg::this_grid();
    char* ws = a.ws;
    const int G = gridDim.x, bx = blockIdx.x, nw = G * 8, nt = G * MEGA_THREADS;
    const int wid_s = __builtin_amdgcn_readfirstlane((int)threadIdx.x >> 6);
#define TIDS int lane = lane_id(); asm volatile("" : "+v"(lane)); const int wid = wid_s, tid = wid * 64 + lane, gw = bx * 8 + wid, gt = bx * MEGA_THREADS + tid; (void)lane; (void)gw; (void)gt; (void)wid
    bf16_t *WinT = (bf16_t*)(ws + O_WIN), *XB = (bf16_t*)(ws + O_XB), *P0 = (bf16_t*)(ws + O_P0), *GQ = (bf16_t*)(ws + O_GQ), *GKT = (bf16_t*)(ws + O_GKT), *GVT = (bf16_t*)(ws + O_GVT), *GG = (bf16_t*)(ws + O_GG);
    float *R1 = (float*)(ws + O_R1), *RQ = (float*)(ws + O_RQ), *RKV = (float*)(ws + O_RKV), *SC = (float*)(ws + O_S), *RT = (float*)(ws + O_ROPE);
    bf16_t *WuqT = (bf16_t*)(ws + O_WUQ), *WukvT = (bf16_t*)(ws + O_WUKV), *WomT = (bf16_t*)(ws + O_WOM), *WogT = (bf16_t*)(ws + O_WOG), *WoutT = (bf16_t*)(ws + O_WOUT), *WsT = (bf16_t*)(ws + O_WS);
    bf16_t *QC = (bf16_t*)(ws + O_QC), *KN = (bf16_t*)(ws + O_KN), *V = (bf16_t*)(ws + O_V), *YA = (bf16_t*)(ws + O_YA), *YB = (bf16_t*)(ws + O_YB), *MIX = (bf16_t*)(ws + O_MIX), *HN2 = (bf16_t*)(ws + O_HN2);
    bf16_t *GA = (bf16_t*)a.out, *GB = (bf16_t*)a.out + (size_t)M * D; bf16_t* KPE = (bf16_t*)(ws + O_KPE);
#define IN(k) (a.ph_lo <= (k) && (k) < a.ph_hi)
    volatile PG8_LAS unsigned* MISC = (volatile PG8_LAS unsigned*)(lds + 131072 + 320);
    { TIDS; if (tid < 128) ((PG8_LAS unsigned*)(lds + 131072))[tid] = 0u; }
    __syncthreads();
    const XcdBarrier xbar = xcd_barrier_post((unsigned*)(ws + O_BAR), MISC + 8, wid_s);
    if (a.coop == 2) grid.sync();
#define SEAM(k) do { if (a.coop && (k) + 1 < a.ph_hi) xcd_barrier(xbar); } while (0)
    if (IN(PH_PREP)) { for (int rep = 0; rep < REP_P; ++rep) { TIDS;
        sm::prep_x(a.in[0], a.in[1], XB, R1, gw, nw, lane);
        PG8_LAS float* scr = (PG8_LAS float*)(lds + wid * 16384);
        sm::prep_w_all(sm::WAll{a.in[3], a.in[2], a.in[5], a.in[4], a.in[7], a.in[6], a.in[15], a.in[16], a.in[14], a.in[17], WinT, WuqT, WukvT, WomT, WogT, WoutT}, scr, gw, nw, lane);
        sm::prep_ws(a.in[19], a.in[20], a.in[18], WsT, gw, nw, lane);
        sm::prep_rope(RT, gt, nt); __syncthreads(); }
        SEAM(PH_PREP);
    }
    if (IN(PH_PROJ)) {
        SchedProj S{(const char*)XB, (const char*)WinT, G, bx};
        EpiProj E{EpiProjNat{R1, P0, GQ, GG, GA, GB}, EpiProjTr{R1, GKT, GVT}};
        for (int rep = 0; rep < REP_G; ++rep) pg8::gemm_phase<EpiProj, SchedProj, true>(lds, pg8::Fam{D / 2, D / 2, D / 2}, S, E, wid_s);
        SEAM(PH_PROJ);
    }
    if (IN(PH_STATS)) { TIDS;
        for (int rep = 0; rep < REP_R; ++rep) sm::p0stats(P0, a.in[11], RT, RQ, RKV, KPE, gw, nw, lane);
        for (int i = gt; i < 48 * 512 / 8; i += nt) { *(u32x4*)(KN + (size_t)(M + NMETA) * 512 + (size_t)i * 8) = (u32x4){0u, 0u, 0u, 0u}; *(u32x4*)(V + (size_t)(M + NMETA) * 512 + (size_t)i * 8) = (u32x4){0u, 0u, 0u, 0u}; }
        for (int rep = 0; rep < REP_U; ++rep) { const bool dm = rep + 1 < REP_U; const gla::Tens GT{GQ, GKT, GVT, dm ? QC : GQ, dm ? QC + (size_t)ME * 512 : GKT, dm ? PREP_VAR : 0, P0, a.in[12], a.in[13], (bf16_t*)(ws + O_AG), (float*)(ws + O_DECL), YB};
          gla::prep_phase(lds, GT, G, bx, wid_s); }
        SEAM(PH_STATS);
    }
#define ROUND_BODY(r) do { \
        if (IN(PH_UP + 2 * r)) { TIDS; \
            const int Gh = G >> 1; const bool isq = bx < Gh; \
            SchedSimple S{(const char*)(isq ? P0 : P0 + S_CKV), (const char*)(isq ? WuqT + (size_t)r * 768 * QR : WukvT + (size_t)r * 1024 * KVR), (size_t)256 * P0W * 2, (size_t)256 * (isq ? QR : KVR) * 2, 128, isq ? 3 : 4, isq ? Gh : G - Gh, isq ? bx : bx - Gh, isq ? 0 : 1}; \
            for (int rep = 0; rep < REP_G; ++rep) pg8::gemm_phase(lds, pg8::Fam{P0W, isq ? QR : KVR, isq ? QR : KVR}, S, EpiUp{EpiUq{RQ, QC}, EpiUkv{RKV, KN, V}, a.in[10]}, wid_s); \
            sm::meta_kv(P0, WukvT + (size_t)r * 1024 * KVR, RKV, a.in[10], KN, V, gw, nw, lane); \
            SEAM(PH_UP + 2 * r); \
        } \
        if (IN(PH_ATT + 2 * r)) { \
            if (r == 0) att::attn_phase(lds, att::Tens{QC, KN, KPE, V, YA, a.in[8], a.in[9], RT}, r, G, bx, wid_s); \
            else { \
                if (bx < NB * 4) { const gla::Tens GT{GQ, GKT, GVT, GQ, GKT, 0, P0, a.in[12], a.in[13], (bf16_t*)(ws + O_AG), (float*)(ws + O_DECL), YB}; \
                    for (int u = bx; u < NB * 4; u += G) gla::scan_wg(lds, GT, u >> 2, u & 3, wid_s); } \
                att::attn_phase_dyn(lds, att::Tens{QC, KN, KPE, V, YA, a.in[8], a.in[9], RT}, r, (unsigned*)(ws + O_BAR) + 3584, MISC, wid_s); } \
            SEAM(PH_ATT + 2 * r); } \
    } while (0)
    ROUND_BODY(0);
    ROUND_BODY(1);
#undef ROUND_BODY
    if (IN(PH_GLAPOST)) { TIDS; for (int rep = 0; rep < REP_R; ++rep) { sm::gla_post(YB, GG, rep + 1 < REP_R ? GVT : YB, gw, nw, lane);
        sm::conv_s4g(a.in[21], (unsigned char*)(ws + O_UB), peer::PEER_SU, a.in[18], 16384 * D / 16, gt, nt);
        sm::conv_f4(a.in[22], (unsigned char*)(ws + O_VB), peer::PEER_SV, 16384 * D / 16, gt, nt); }
        SEAM(PH_GLAPOST); }
    if (IN(PH_MIX)) {
        SchedMix S{(const char*)YA, (const char*)YB, (const char*)WomT, (const char*)WogT, G, bx};
        for (int rep = 0; rep < REP_G; ++rep) pg8::gemm_phase(lds, pg8::Fam{D, D, D}, S, EpiMix{GA, GB, MIX}, wid_s);
        SEAM(PH_MIX);
    }
    if (IN(PH_OUT)) {
        SchedSimple S{(const char*)MIX, (const char*)WoutT, (size_t)256 * D * 2, (size_t)256 * D * 2, 128, 4, G, bx, 0};
        for (int rep = 0; rep < REP_G; ++rep) pg8::gemm_phase(lds, pg8::Fam{D, D, D}, S, EpiOut{a.in[0], a.out, HN2, (float*)(ws + O_SSQ)}, wid_s);
        SEAM(PH_OUT);
    }
    if (IN(PH_SCORE)) {
        SchedSimple S{(const char*)HN2, (const char*)WsT, (size_t)256 * D * 2, (size_t)256 * D * 2, 128, 8, G, bx, 0};
        for (int rep = 0; rep < REP_G; ++rep) pg8::gemm_phase(lds, pg8::Fam{D, D, D}, S, EpiWrap<EpiScore>{EpiScore{(bf16_t*)SC}}, wid_s);
        { TIDS; PG8_LAS float* wl = (PG8_LAS float*)(lds + wid * peer::TK_WAVE_LDS); pg8::Unit u; int nu = 0; while (S.next(nu, u)) ++nu;
          for (int t = wid; t < nu * 4; t += 8) { S.next(t >> 2, u); peer::topk64(wl, (const bf16_t*)SC, (const float*)(ws + O_SSQ), (int*)(ws + O_IDX), (float*)(ws + O_GATE), u.pm * 256 + (t & 3) * 64, u.pn, true, lane); } }
        SEAM(PH_SCORE);
    }
    if (IN(PH_GATHER)) for (int rep = 0; rep < REP_GA; ++rep) peer::gather1s_phase(lds, HN2, (const int*)(ws + O_IDX), (const float*)(ws + O_GATE), (const unsigned char*)(ws + O_UB), (const unsigned char*)(ws + O_VB), (const float*)(ws + O_SSQ), rep + 1 < REP_GA ? SC : a.out, G, bx, wid_s);
}

extern "C" void kernel_launch(void* const* d_in, const int* in_sizes, int n_in, void* d_out, int out_size, void* d_ws, size_t ws_size, hipStream_t st) {
    (void)in_sizes; (void)out_size;
    static int grid = 0;
    if (grid == 0) {
        if (n_in != 23 || ws_size < O_WSEND) { fprintf(stderr, "kernel_launch: unexpected inputs (%d) or workspace %zu < %zu\n", n_in, ws_size, (size_t)O_WSEND); grid = -1; return; }
        int dev = 0, cus = 0, per_cu = 0;
        if (hipGetDevice(&dev) != hipSuccess || hipDeviceGetAttribute(&cus, hipDeviceAttributeMultiprocessorCount, dev) != hipSuccess) cus = 256;
        if (hipFuncSetAttribute((const void*)mega, hipFuncAttributeMaxDynamicSharedMemorySize, MEGA_LDS) != hipSuccess) { fprintf(stderr, "kernel_launch: hipFuncSetAttribute failed\n"); grid = -1; return; }
        if (hipOccupancyMaxActiveBlocksPerMultiprocessor(&per_cu, (const void*)mega, MEGA_THREADS, MEGA_LDS) != hipSuccess || per_cu < 1) { fprintf(stderr, "kernel_launch: occupancy query failed (%d)\n", per_cu); per_cu = 1; }
        (void)hipGetLastError();
        grid = cus * 1;
        if (per_cu < 1) grid = -1;
    }
    if (grid < 0) return;
    MegaArgs ma{};
    for (int i = 0; i < 23; ++i) ma.in[i] = (const float*)d_in[i];
    ma.out = (float*)d_out; ma.ws = (char*)d_ws; ma.ph_lo = 0; ma.ph_hi = PH_N; ma.coop = 1; ma.pad = 0;
    if (hipMemsetAsync((char*)d_ws + O_BAR, 0, BAR_BYTES, st) != hipSuccess) { fprintf(stderr, "kernel_launch: memset failed\n"); return; }
    void* args[] = {&ma};
    hipError_t e = hipLaunchCooperativeKernel((const void*)mega, dim3(grid), dim3(MEGA_THREADS), args, MEGA_LDS, st);
    if (e != hipSuccess) fprintf(stderr, "kernel_launch: cooperative launch failed: %s (grid %d)\n", hipGetErrorString(e), grid);
}
```

```cpp
#include <hip/hip_runtime.h>
#include <hip/hip_cooperative_groups.h>
namespace cg = cooperative_groups;
#include <cstdint>
#include <cstdio>

typedef unsigned short bf16_t;
typedef unsigned u32x4 __attribute__((ext_vector_type(4)));
typedef unsigned u32x2 __attribute__((ext_vector_type(2)));
typedef float f32x4 __attribute__((ext_vector_type(4)));

constexpr int D = 1024, NB = 16, SEQ = 2048, M = NB * SEQ, ME = M + 256, NMETA = 16;
constexpr float EPS = 1e-6f;
constexpr int QR = 384, KVR = 256, NOPE = 128, ROPE = 64, RH = 32, QKD = 192;
constexpr int GDK = 512, GDV = 1024, GHK = 128, GHV = 256, GR = 16;
constexpr int DIN = 5840;
constexpr int S_CQ = 0, S_CKV = 384, S_KPE = 640, S_GQ = 704, S_GK = 1216, S_GV = 1728, S_GA = 2752, S_GG = 2768, S_A = 3792, S_B = 4816;
constexpr int WIN_ROWS = 5888, WIN_NAT = 4352, P0W = 768;
constexpr float SCL2 = 0.07216878364870323f * 1.4426950408889634f;
constexpr float GLA_QS = 0.08838834764831845f;
constexpr float SW_IN = 4.5f / 32.f / 127.f;

constexpr size_t MiB = 1u << 20;
constexpr size_t al(size_t x) { return (x + 255) / 256 * 256; }
constexpr size_t O_WIN = 0;
constexpr size_t O_WUQ = O_WIN + al((size_t)WIN_ROWS * D * 2);
constexpr size_t O_WUKV = O_WUQ + al((size_t)1536 * QR * 2);
constexpr size_t O_WOM = O_WUKV + al((size_t)2048 * KVR * 2);
constexpr size_t O_WOG = O_WOM + al((size_t)D * D * 2);
constexpr size_t O_WOUT = O_WOG + al((size_t)D * D * 2);
constexpr size_t O_WS = O_WOUT + al((size_t)D * D * 2);
constexpr size_t O_ROPE = O_WS + al((size_t)2048 * D * 2);
constexpr size_t O_R1 = O_ROPE + al((size_t)2064 * RH * 2 * 4);
constexpr size_t O_RQ = O_R1 + al((size_t)ME * 4);
constexpr size_t O_RKV = O_RQ + al((size_t)ME * 4);
constexpr size_t O_KPE = O_RKV + al((size_t)ME * 4);
constexpr size_t O_XB = O_KPE + al((size_t)ME * ROPE * 2);
constexpr size_t O_POOL = O_XB + al((size_t)ME * D * 2);
constexpr size_t O_GKT = O_POOL;
constexpr size_t O_GQ = O_GKT + al((size_t)ME * GDK * 2);
constexpr size_t O_P0 = O_GQ + al((size_t)ME * GDK * 2);
constexpr size_t O_GK = O_P0 + al((size_t)ME * P0W * 2);
constexpr size_t O_GVT = O_GK + al((size_t)ME * GDK * 2);
constexpr size_t O_GG = O_GVT + al((size_t)ME * GDV * 2);
constexpr size_t O_QC = O_GG + al((size_t)M * D * 2);
constexpr size_t O_KN = O_QC + al((size_t)M * 768 * 2);
constexpr size_t O_V = O_KN + al((size_t)ME * 512 * 2);
constexpr size_t O_END = O_V + al((size_t)ME * 512 * 2);
constexpr int GLA_NU = NB * 4 * 33;
constexpr size_t O_AG = O_END;
constexpr size_t O_DECL = O_AG + al((size_t)GLA_NU * 64 * 64 * 2);
constexpr size_t O_BAR = O_DECL + al((size_t)GLA_NU * 128 * 4);
constexpr size_t BAR_BYTES = 16384;
constexpr size_t O_SSQ = O_BAR + BAR_BYTES;
constexpr size_t O_WSEND = O_SSQ + al((size_t)M * 32 * 4);
static_assert(O_WSEND <= 512 * MiB, "ws");
constexpr size_t O_YA = O_XB;
constexpr size_t O_YB = O_P0;
static_assert(O_YB + (size_t)M * D * 2 <= O_GVT, "YB overlay");
constexpr size_t O_MIX = O_GVT;
constexpr size_t O_HN2 = O_XB;
constexpr size_t O_S = O_POOL;
constexpr size_t O_IDX = O_QC;
static_assert(O_S + (size_t)M * 2048 * 4 <= O_QC, "S overlay");
constexpr size_t O_GATE = O_IDX + al((size_t)M * 128 * 4);
constexpr size_t O_UB = O_P0 + (size_t)M * D * 2;
constexpr size_t O_VB = O_UB + (size_t)16384 * 512;
static_assert(O_VB + (size_t)16384 * 512 <= O_GVT && O_S + (size_t)M * 2048 * 2 <= O_UB && O_GATE + (size_t)M * 128 * 4 <= O_END, "tables slot");

__device__ __forceinline__ float bf2f(bf16_t u) { return __uint_as_float((unsigned)u << 16); }
__device__ __forceinline__ bf16_t f2bf(float f) { unsigned u = __float_as_uint(f); return (bf16_t)((u + 0x7fffu + ((u >> 16) & 1u)) >> 16); }
__device__ __forceinline__ unsigned pk2(float lo, float hi) { return (unsigned)f2bf(lo) | ((unsigned)f2bf(hi) << 16); }
__device__ __forceinline__ void unpack8(u32x4 w, float* f) {
#pragma unroll
    for (int i = 0; i < 4; ++i) { f[2 * i] = __uint_as_float(w[i] << 16); f[2 * i + 1] = __uint_as_float(w[i] & 0xffff0000u); }
}
__device__ __forceinline__ u32x4 pack8(const float* f) { u32x4 w; w.x = pk2(f[0], f[1]); w.y = pk2(f[2], f[3]); w.z = pk2(f[4], f[5]); w.w = pk2(f[6], f[7]); return w; }
__device__ __forceinline__ float swap_add32(float a, float b) { const u32x2 r = __builtin_amdgcn_permlane32_swap(__float_as_uint(a), __float_as_uint(b), false, false); return __uint_as_float(r.x) + __uint_as_float(r.y); }
__device__ __forceinline__ float swap_add16(float a, float b) { const u32x2 r = __builtin_amdgcn_permlane16_swap(__float_as_uint(a), __float_as_uint(b), false, false); return __uint_as_float(r.x) + __uint_as_float(r.y); }
template <int CTRL> __device__ __forceinline__ float dpp_f(float x) { return __builtin_bit_cast(float, __builtin_amdgcn_update_dpp(0, __builtin_bit_cast(int, x), CTRL, 0xf, 0xf, true)); }
__device__ __forceinline__ float wsum(float v) {
    const float h = swap_add32(v, v); float s = swap_add16(h, h);
    s += dpp_f<0x128>(s); s += dpp_f<0xB1>(s); s += dpp_f<0x4E>(s); s += dpp_f<0x141>(s); return s;
}
__device__ __forceinline__ float wmax(float v) {
#pragma unroll
    for (int o = 32; o >= 1; o >>= 1) v = fmaxf(v, __shfl_xor(v, o));
    return v;
}
__device__ __forceinline__ int lane_id() { return (int)__builtin_amdgcn_mbcnt_hi(~0u, __builtin_amdgcn_mbcnt_lo(~0u, 0u)); }
__device__ __forceinline__ float sigmoidf_(float x) { return 1.f / (1.f + __expf(-x)); }
__device__ __forceinline__ int tok_pos(int row) { return row < M ? (row & (SEQ - 1)) + NMETA : row - M; }

enum { MAP_ID = 0, MAP_WIN = 1, MAP_UKV = 2 };
__device__ __forceinline__ int map_col(int mode, int n) {
    if (mode == MAP_ID) return n;
    if (mode == MAP_WIN) {
        if (n < 704) return n;
        if (n < 720) return S_GA + (n - 704);
        if (n < 768) return -1;
        if (n < 1280) return S_GQ + (n - 768);
        if (n < 2304) return S_GG + (n - 1280);
        if (n < 3328) return S_A + (n - 2304);
        if (n < 4352) return S_B + (n - 3328);
        if (n < 4864) return S_GK + (n - 4352);
        return S_GV + (n - 4864);
    }
    const int r = n >> 10, j = n & 1023;
    if (j < 512) return (4 * r + (j >> 7)) * 256 + (j & 127);
    return (4 * r + ((j - 512) >> 7)) * 256 + 128 + ((j - 512) & 127);
}
struct EpiProjNat {
    const float* R1; bf16_t *P0, *GQ, *GG, *GA, *GB;
    __device__ __forceinline__ void operator()(int row, int col, const float* v, float s) const {
        float o[8];
#pragma unroll
        for (int i = 0; i < 8; ++i) o[i] = v[i] * s;
        bf16_t* dst;
        if (col < 768) dst = P0 + (size_t)row * P0W + col;
        else if (col < 1280) dst = GQ + (size_t)row * GDK + (col - 768);
        else { if (row >= M) return;
            if (col < 2304) dst = GG + (size_t)row * D + (col - 1280);
            else if (col < 3328) dst = GA + (size_t)row * D + (col - 2304);
            else dst = GB + (size_t)row * D + (col - 3328); }
        *(u32x4*)dst = pack8(o);
    }
};
struct EpiProjTr {
    const float* R1; bf16_t *GKT, *GVT;
    __device__ __forceinline__ void operator()(int row, int col, const float* v, const f32x4 (&c)[2]) const {
        const float o[8] = {v[0] * c[0].x, v[1] * c[0].y, v[2] * c[0].z, v[3] * c[0].w, v[4] * c[1].x, v[5] * c[1].y, v[6] * c[1].z, v[7] * c[1].w};
        bf16_t* dst = row < 512 ? GKT + (size_t)row * ME + col : GVT + (size_t)(row - 512) * ME + col;
        *(u32x4*)dst = pack8(o);
    }
};
struct EpiUq {
    const float* RQ; bf16_t* QC;
    __device__ __forceinline__ void operator()(int row, int col, const float* v, float s) const {
        if (row >= M) return;
        float o[8];
#pragma unroll
        for (int i = 0; i < 8; ++i) o[i] = v[i] * s;
        *(u32x4*)(QC + (size_t)row * 768 + col) = pack8(o);
    }
};
struct EpiUkv {
    const float* RKV; bf16_t *KN, *V; int roff = 0, pad = 0;
    __device__ __forceinline__ void operator()(int row, int col, const float* v, float s) const {
        row += roff; float o[8];
#pragma unroll
        for (int i = 0; i < 8; ++i) o[i] = v[i] * s;
        bf16_t* dst = col < 512 ? KN + (size_t)row * 512 + col : V + (size_t)row * 512 + (col - 512);
        *(u32x4*)dst = pack8(o);
    }
};
struct EpiOut { static constexpr bool XFORM = false, ROWSTAT = false, PRE = false, AUX = true;
    const float* __restrict__ x; float* __restrict__ out; bf16_t* __restrict__ HB; float* __restrict__ SSQ;
    __device__ __forceinline__ bool keep(int) const { return false; }
    __device__ __forceinline__ void aux(int, int row, int col, u32x4 (&ax)[2]) const { ax[0] = *(const u32x4*)(x + (size_t)row * D + col); ax[1] = *(const u32x4*)(x + (size_t)row * D + col + 4); }
    __device__ __forceinline__ bool apply(int, int row, int col, float* v, const u32x4 (&ax)[2]) const {
        const f32x4 a = __builtin_bit_cast(f32x4, ax[0]), b = __builtin_bit_cast(f32x4, ax[1]);
        const float h[8] = {a.x + v[0], a.y + v[1], a.z + v[2], a.w + v[3], b.x + v[4], b.y + v[5], b.z + v[6], b.w + v[7]};
        *(u32x4*)(HB + (size_t)row * D + col) = pack8(h);
        float ss = (h[0] * h[0] + h[1] * h[1]) + (h[2] * h[2] + h[3] * h[3]) + (h[4] * h[4] + h[5] * h[5]) + (h[6] * h[6] + h[7] * h[7]);
        ss = swap_add16(ss, ss); ss = swap_add32(ss, ss);
        if (((col >> 3) & 3) == 0) SSQ[(size_t)row * 32 + (col >> 5)] = ss;
        return false; }
};
struct EpiScore { bf16_t* S;
    __device__ __forceinline__ void operator()(int row, int col, const float* v) const { *(u32x4*)(S + (size_t)row * 2048 + col) = pack8(v); }
};

namespace pg8 {
#define PG8_LAS __attribute__((address_space(3)))
typedef short bf16x8 __attribute__((ext_vector_type(8)));
constexpr int BM = 256, BK = 64, HALF = 128, HTB = HALF * BK * 2, STAGE_BYTES = 8 * HTB, NXCD = 8, WGM = 8;
__host__ __device__ __forceinline__ int lds_byte(int r, int c) { const int st = (r >> 4) * 2 + (c >> 5), rr = r & 15, cc = c & 31, ob = rr * 64 + cc * 2; return st * 1024 + (ob ^ (((ob >> 9) & 1) << 5)); }
__host__ __device__ __forceinline__ void stage_rc(int b, int& R, int& C) { const int st = b / 1024, sb = b % 1024, swz = sb ^ (((sb >> 9) & 1) << 5); R = (st >> 1) * 16 + swz / 64; C = (st & 1) * 32 + (swz % 64) / 2; }
__host__ __device__ __forceinline__ int perm32(int rho) { const int n = rho >> 4, i = rho & 15; return 8 * (i >> 2) + 4 * n + (i & 3); }
struct Unit { const char* A; const char* B; int pm, pn, gid; };
struct Fam { int lda, ldb, K; };
__device__ __forceinline__ void tile_of(int L, int nM, int nN, int& pm, int& pn) {
    const int nwg = nM * nN; int wgid = L; { const int q = nwg / NXCD, r = nwg % NXCD, xcd = wgid % NXCD, off = wgid / NXCD; wgid = (xcd < r ? xcd * (q + 1) : r * (q + 1) + (xcd - r) * q) + off; }
    const int nig = WGM * nN, gid = wgid / nig, fm = gid * WGM, gsz = (nM - fm) < WGM ? (nM - fm) : WGM;
    pm = fm + ((wgid % nig) % gsz); pn = (wgid % nig) / gsz;
}
typedef int i32x4 __attribute__((ext_vector_type(4)));
template <bool I8> __device__ __forceinline__ f32x4 mma16(bf16x8 b, bf16x8 a, f32x4 c) {
    if constexpr (I8) return __builtin_bit_cast(f32x4, __builtin_amdgcn_mfma_i32_16x16x64_i8(__builtin_bit_cast(i32x4, b), __builtin_bit_cast(i32x4, a), __builtin_bit_cast(i32x4, c), 0, 0, 0));
    else return __builtin_amdgcn_mfma_f32_16x16x32_bf16(b, a, c, 0, 0, 0); }
template <bool I8> __device__ __forceinline__ f32x4 acc_f(f32x4 a) { if constexpr (I8) { const i32x4 q = __builtin_bit_cast(i32x4, a); return (f32x4){(float)q.x, (float)q.y, (float)q.z, (float)q.w}; } else return a; }
template <class Epi, class Sched, bool I8 = false>
__device__ __forceinline__ void gemm_phase(PG8_LAS unsigned char* lds, const Fam f, const Sched& S, const Epi& E, int wv) {
    int tid_ = wv * 64 + lane_id(); asm volatile("" : "+v"(tid_));
    const int tid = tid_, wid = __builtin_amdgcn_readfirstlane(tid >> 6), lane = tid & 63, wr = wid >> 2, wc = wid & 3, fr = lane & 15, fq = lane >> 4;
    const int nt = f.K / BK;
    unsigned voffA[2], voffB[2];
#pragma unroll
    for (int i = 0; i < 2; ++i) { int R, C; stage_rc(tid * 16 + i * 8192, R, C); const int Rb = (R & ~31) + perm32(R & 31);
        voffA[i] = (unsigned)(R * f.lda + C) * 2u; voffB[i] = (unsigned)(Rb * f.ldb + C) * 2u; }
    const size_t kstep = (size_t)(BK * 2);
    const size_t hstepA = (size_t)HALF * f.lda * 2, hstepB = (size_t)HALF * f.ldb * 2;
    const unsigned ldsw = (unsigned)wid * 1024u;
    const int aoff = lds_byte(wr * 64 + fr, fq * 8), boff = lds_byte(wc * 32 + fr, fq * 8);
#define PG8_SA(b, h) (((b) * 2 + (h)) * HTB)
#define PG8_SB(b, h) ((4 + (b) * 2 + (h)) * HTB)
#define PG8_STAGE(bufoff, gbase, voff) do { _Pragma("unroll") for (int _i = 0; _i < 2; ++_i) \
        __builtin_amdgcn_global_load_lds((const unsigned*)((const char*)(gbase) + (voff)[_i]), (PG8_LAS unsigned*)(lds + (bufoff) + ldsw + _i * 8192), 16, 0, 0); } while (0)
#define PG8_LDA(dst, b, h) do { _Pragma("unroll") for (int m = 0; m < 4; ++m) _Pragma("unroll") for (int k = 0; k < 2; ++k) dst[m][k] = *(const PG8_LAS bf16x8*)(lds + PG8_SA(b, h) + aoff + m * 2048 + k * 1024); } while (0)
#define PG8_LDB(dst, b, h) do { _Pragma("unroll") for (int n = 0; n < 2; ++n) _Pragma("unroll") for (int k = 0; k < 2; ++k) dst[n][k] = *(const PG8_LAS bf16x8*)(lds + PG8_SB(b, h) + boff + n * 2048 + k * 1024); } while (0)
#define PG8_MMA(ai, bj, At, Bt) do { __builtin_amdgcn_s_setprio(1); _Pragma("unroll") for (int m = 0; m < 4; ++m) _Pragma("unroll") for (int n = 0; n < 2; ++n) _Pragma("unroll") for (int k = 0; k < 2; ++k) \
        acc[ai][bj][m][n] = mma16<I8>(Bt[n][k], At[m][k], acc[ai][bj][m][n]); __builtin_amdgcn_s_setprio(0); } while (0)
#define PG8_WAIT_V(n) asm volatile("s_waitcnt vmcnt(" #n ")" ::: "memory")
#define PG8_WAIT_L(n) asm volatile("s_waitcnt lgkmcnt(" #n ")" ::: "memory")
#define PG8_BAR __builtin_amdgcn_s_barrier()
#define PG8_SCHED __builtin_amdgcn_sched_barrier(0)
    Unit cur, nxt; int ui = 0;
    if (!S.next(0, cur)) return;
    f32x4 acc[2][2][4][2];
#pragma unroll
    for (int a = 0; a < 2; ++a)
#pragma unroll
        for (int b = 0; b < 2; ++b)
#pragma unroll
            for (int m = 0; m < 4; ++m)
#pragma unroll
                for (int n = 0; n < 2; ++n) acc[a][b][m][n] = (f32x4){0.f, 0.f, 0.f, 0.f};
    bf16x8 At[4][2], B0[2][2], B1[2][2];
    const char* cA = cur.A; const char* cB = cur.B;
    PG8_STAGE(PG8_SB(0, 0), cB, voffB); PG8_STAGE(PG8_SB(0, 1), cB + hstepB, voffB); PG8_STAGE(PG8_SA(0, 0), cA, voffA); PG8_STAGE(PG8_SA(0, 1), cA + hstepA, voffA);
    if (wr == 1) PG8_BAR;
    PG8_WAIT_V(2); PG8_BAR;
    PG8_STAGE(PG8_SB(1, 0), cB + kstep, voffB); PG8_STAGE(PG8_SA(1, 0), cA + kstep, voffA); PG8_STAGE(PG8_SB(1, 1), cB + hstepB + kstep, voffB);
    PG8_WAIT_V(6); PG8_BAR;
    for (;;) {
        const bool has_next = S.next(ui + 1, nxt);
        const char* nA = has_next ? nxt.A : cA; const char* nB = has_next ? nxt.B : cB;
        for (int t = 0; t < nt; t += 2) {
            const bool last = (t == nt - 2);
            const char* a1 = cA + (size_t)(t + 1) * kstep;
            const char* a2 = last ? nA : cA + (size_t)(t + 2) * kstep; const char* b2 = last ? nB : cB + (size_t)(t + 2) * kstep;
            const char* a3 = a2 + kstep; const char* b3 = b2 + kstep;
            PG8_LDB(B0, 0, 0); PG8_LDB(B1, 0, 1); PG8_SCHED; PG8_LDA(At, 0, 0); PG8_STAGE(PG8_SA(1, 1), a1 + hstepA, voffA);
            PG8_WAIT_V(8); PG8_WAIT_L(0); PG8_BAR; PG8_MMA(0, 0, At, B0); PG8_MMA(0, 1, At, B1); PG8_BAR; PG8_SCHED;
            PG8_LDA(At, 0, 1); PG8_STAGE(PG8_SB(0, 0), b2, voffB); PG8_STAGE(PG8_SB(0, 1), b2 + hstepB, voffB); PG8_STAGE(PG8_SA(0, 0), a2, voffA);
            PG8_WAIT_V(8); PG8_WAIT_L(0); PG8_BAR; PG8_MMA(1, 0, At, B0); PG8_MMA(1, 1, At, B1); PG8_BAR; PG8_SCHED;
            PG8_LDB(B0, 1, 0); PG8_LDB(B1, 1, 1); PG8_SCHED; PG8_LDA(At, 1, 0); PG8_STAGE(PG8_SA(0, 1), a2 + hstepA, voffA);
            PG8_WAIT_V(8); PG8_WAIT_L(0); PG8_BAR; PG8_MMA(0, 0, At, B0); PG8_MMA(0, 1, At, B1); PG8_BAR; PG8_SCHED;
            PG8_LDA(At, 1, 1); PG8_STAGE(PG8_SB(1, 0), b3, voffB); PG8_STAGE(PG8_SB(1, 1), b3 + hstepB, voffB); PG8_STAGE(PG8_SA(1, 0), a3, voffA);
            PG8_WAIT_V(8); PG8_WAIT_L(0); PG8_BAR; PG8_MMA(1, 0, At, B0); PG8_MMA(1, 1, At, B1); PG8_BAR; PG8_SCHED;
        }
        if (wr == 0) PG8_BAR;
        {
            const int row0 = cur.pm * BM + wr * 64 + fr, col0 = cur.pn * BM + wc * 32 + 8 * fq;
            float rs[2][4]; f32x4 cs[2][2];
            if constexpr (Epi::PRE) E.pre(cur.gid, row0, col0, rs, cs);
            bool stat = false; PG8_LAS float* XS = (PG8_LAS float*)(lds + 131072 + 512);
            if constexpr (Epi::ROWSTAT) { if (E.want_stat(cur.gid, cur.pn)) {
                stat = true;
#pragma unroll
                for (int ai = 0; ai < 2; ++ai)
#pragma unroll
                    for (int m = 0; m < 4; ++m)
#pragma unroll
                        for (int bj = 0; bj < 2; ++bj) { const f32x4 v0 = acc_f<I8>(acc[ai][bj][m][0]), v1 = acc_f<I8>(acc[ai][bj][m][1]);
                            float ss = (v0[0] * v0[0] + v0[1] * v0[1]) + (v0[2] * v0[2] + v0[3] * v0[3]) + (v1[0] * v1[0] + v1[1] * v1[1]) + (v1[2] * v1[2] + v1[3] * v1[3]);
                            ss = swap_add16(ss, ss); ss = swap_add32(ss, ss);
                            if (fq == 0) XS[(wc * 256 + ai * 128 + wr * 64 + m * 16 + fr) * 2 + bj] = ss; }
                asm volatile("s_waitcnt lgkmcnt(0)" ::: "memory"); __builtin_amdgcn_s_barrier(); asm volatile("" ::: "memory");
            } }
            if constexpr (Epi::AUX) {
                u32x4 axn[2]; E.aux(cur.gid, row0, col0, axn);
#pragma unroll
                for (int k = 0; k < 16; ++k) { const int ai = k >> 3, m = (k >> 1) & 3, bj = k & 1; u32x4 ax[2] = {axn[0], axn[1]};
                    if (k + 1 < 16) E.aux(cur.gid, row0 + ((k + 1) >> 3) * HALF + (((k + 1) >> 1) & 3) * 16, col0 + ((k + 1) & 1) * HALF, axn);
                    const f32x4 v0 = acc_f<I8>(acc[ai][bj][m][0]), v1 = acc_f<I8>(acc[ai][bj][m][1]);
                    float v[8] = {v0[0], v0[1], v0[2], v0[3], v1[0], v1[1], v1[2], v1[3]};
                    if (E.apply(cur.gid, row0 + ai * HALF + m * 16, col0 + bj * HALF, v, ax)) { acc[ai][bj][m][0] = (f32x4){v[0], v[1], v[2], v[3]}; acc[ai][bj][m][1] = (f32x4){v[4], v[5], v[6], v[7]}; } }
            } else
#pragma unroll
            for (int ai = 0; ai < 2; ++ai)
#pragma unroll
                for (int m = 0; m < 4; ++m)
#pragma unroll
                    for (int bj = 0; bj < 2; ++bj) {
                        const f32x4 v0 = acc_f<I8>(acc[ai][bj][m][0]), v1 = acc_f<I8>(acc[ai][bj][m][1]);
                        float v[8] = {v0[0], v0[1], v0[2], v0[3], v1[0], v1[1], v1[2], v1[3]};
                        if constexpr (Epi::XFORM) { if (E.xform(cur.gid, row0 + ai * HALF + m * 16, col0 + bj * HALF, v)) {
                            acc[ai][bj][m][0] = (f32x4){v[0], v[1], v[2], v[3]}; acc[ai][bj][m][1] = (f32x4){v[4], v[5], v[6], v[7]}; } }
                        else if constexpr (Epi::ROWSTAT) { float ss = 0.f; if (stat) { const int rl = (ai * 128 + wr * 64 + m * 16 + fr) * 2 + bj; ss = (XS[rl] + XS[512 + rl]) + (XS[1024 + rl] + XS[1536 + rl]); }
                            E(cur.gid, row0 + ai * HALF + m * 16, col0 + bj * HALF, v, ss, rs[ai][m], cs[bj]); }
                        else if constexpr (Epi::PRE) E(cur.gid, row0 + ai * HALF + m * 16, col0 + bj * HALF, v, rs[ai][m], cs[bj]);
                        else E(cur.gid, row0 + ai * HALF + m * 16, col0 + bj * HALF, v);
                    }
        }
        if (!has_next) break;
        bool keep = false; if constexpr (Epi::XFORM || Epi::AUX) keep = E.keep(cur.gid);
        if (!keep) {
#pragma unroll
        for (int a = 0; a < 2; ++a)
#pragma unroll
            for (int b = 0; b < 2; ++b)
#pragma unroll
                for (int m = 0; m < 4; ++m)
#pragma unroll
                    for (int n = 0; n < 2; ++n) acc[a][b][m][n] = (f32x4){0.f, 0.f, 0.f, 0.f};
        }
        cur = nxt; cA = nA; cB = nB; ++ui;
        if (wr == 1) PG8_BAR;
    }
    PG8_WAIT_V(0);
    PG8_BAR;
#undef PG8_SA
#undef PG8_SB
#undef PG8_STAGE
#undef PG8_LDA
#undef PG8_LDB
#undef PG8_MMA
#undef PG8_WAIT_V
#undef PG8_WAIT_L
#undef PG8_BAR
#undef PG8_SCHED
}
}


namespace att {
typedef short bf16x8 __attribute__((ext_vector_type(8)));
typedef short s16x4 __attribute__((ext_vector_type(4)));
typedef float f32x16 __attribute__((ext_vector_type(16)));
typedef PG8_LAS const char* lptr;
constexpr int KROWB = 384, SHM_K = 64 * KROWB, SHM_V = 64 * 256;
constexpr int L_K = 0, L_V = 2 * SHM_K, L_WS = L_V + 2 * SHM_V, L_END = L_WS + 8 * 256;
constexpr float THRL = 11.5f;
__device__ __forceinline__ int crow(int r, int hi) { return (r & 3) + 8 * (r >> 2) + 4 * hi; }
__device__ __forceinline__ unsigned cvtpk(float lo, float hi) { unsigned r; asm volatile("v_cvt_pk_bf16_f32 %0, %1, %2" : "=v"(r) : "v"(lo), "v"(hi)); return r; }
__device__ __forceinline__ int v_rd_base(int lane) { return ((lane & 3) << 3) | (((lane >> 2) & 3) << 6) | (((lane >> 4) & 1) << 5) | (((lane >> 5) & 1) << 8); }
constexpr int v_rd_off(int d0, int ks, int half) { return d0 * 512 + ks * 4096 + half * 2048; }
__device__ __forceinline__ void partialSM(f32x16& p0, f32x16& p1, float& m_reg, float& alpha) {
    float pmax = p0[0];
#pragma unroll
    for (int r = 1; r < 16; ++r) pmax = fmaxf(pmax, p0[r]);
#pragma unroll
    for (int r = 0; r < 16; ++r) pmax = fmaxf(pmax, p1[r]);
    { auto rr = __builtin_amdgcn_permlane32_swap(__float_as_uint(pmax), __float_as_uint(pmax), false, false); pmax = fmaxf(__uint_as_float(rr[0]), __uint_as_float(rr[1])); }
    float mn;
    if (__builtin_expect(__all(pmax - m_reg <= THRL), 1)) { mn = m_reg; alpha = 1.f; }
    else { mn = fmaxf(m_reg, pmax); alpha = __builtin_amdgcn_exp2f(m_reg - mn); m_reg = mn; }
#pragma unroll
    for (int r = 0; r < 16; ++r) { p0[r] = __builtin_amdgcn_exp2f(p0[r] - mn); p1[r] = __builtin_amdgcn_exp2f(p1[r] - mn); }
}
__device__ __forceinline__ void finishSM(const f32x16& p0, const f32x16& p1, float alpha, float& l_reg, bf16x8& pa0, bf16x8& pa1, bf16x8& pa2, bf16x8& pa3) {
    float ps = 0.f;
#pragma unroll
    for (int r = 0; r < 16; ++r) ps += p0[r] + p1[r];
    { auto rr = __builtin_amdgcn_permlane32_swap(__float_as_uint(ps), __float_as_uint(ps), false, false); ps = __uint_as_float(rr[0]) + __uint_as_float(rr[1]); }
    l_reg = l_reg * alpha + ps;
#define PK4(P, B_, OUT) do { unsigned a0 = cvtpk(P[B_+0], P[B_+1]), a1 = cvtpk(P[B_+2], P[B_+3]); unsigned b0 = cvtpk(P[B_+4], P[B_+5]), b1 = cvtpk(P[B_+6], P[B_+7]); \
        auto r0 = __builtin_amdgcn_permlane32_swap(a0, b0, false, false); auto r1 = __builtin_amdgcn_permlane32_swap(a1, b1, false, false); \
        u32x4 w = {r0[0], r1[0], r0[1], r1[1]}; OUT = __builtin_bit_cast(bf16x8, w); } while (0)
    PK4(p0, 0, pa0); PK4(p0, 8, pa1); PK4(p1, 0, pa2); PK4(p1, 8, pa3);
#undef PK4
}
template <int KB>
__device__ __forceinline__ void qkt(f32x16& p0, f32x16& p1, lptr K_lds, int r32, int hi, const bf16x8* qr) {
    p0 = f32x16{}; p1 = f32x16{};
    lptr kb[4];
#pragma unroll
    for (int dd = 0; dd < 4; ++dd) kb[dd] = K_lds + KB * SHM_K + r32 * KROWB + (((dd * 16 + hi * 8) * 2) ^ ((r32 & 7) << 4));
#pragma unroll
    for (int d0 = 0; d0 < 12; ++d0) { lptr a = kb[d0 & 3] + (d0 >> 2) * 128;
        const bf16x8 b0 = *(const PG8_LAS bf16x8*)a, b1 = *(const PG8_LAS bf16x8*)(a + 32 * KROWB);
        p0 = __builtin_amdgcn_mfma_f32_32x32x16_bf16(b0, qr[d0], p0, 0, 0, 0);
        p1 = __builtin_amdgcn_mfma_f32_32x32x16_bf16(b1, qr[d0], p1, 0, 0, 0); }
}
template <int VB>
__device__ __forceinline__ void pv_tile(f32x16* o, int vb0, bf16x8 pa0, bf16x8 pa1, bf16x8 pa2, bf16x8 pa3) {
#define TRRD(dst, off) asm volatile("ds_read_b64_tr_b16 %0, %1 offset:%2" : "=&v"(dst) : "v"(vb0), "i"(off) : "memory")
#define PV_D0(d0) do { s16x4 l0, l1, l2, l3, h0, h1, h2, h3; constexpr int b_ = VB * SHM_V + v_rd_off(d0, 0, 0); \
        TRRD(l0, b_); TRRD(h0, b_ + 2048); TRRD(l1, b_ + 4096); TRRD(h1, b_ + 6144); TRRD(l2, b_ + 8192); TRRD(h2, b_ + 10240); TRRD(l3, b_ + 12288); TRRD(h3, b_ + 14336); \
        asm volatile("s_waitcnt lgkmcnt(0)" ::: "memory"); __builtin_amdgcn_sched_barrier(0); \
        o[d0] = __builtin_amdgcn_mfma_f32_32x32x16_bf16(pa0, (bf16x8){l0[0], l0[1], l0[2], l0[3], h0[0], h0[1], h0[2], h0[3]}, o[d0], 0, 0, 0); \
        o[d0] = __builtin_amdgcn_mfma_f32_32x32x16_bf16(pa1, (bf16x8){l1[0], l1[1], l1[2], l1[3], h1[0], h1[1], h1[2], h1[3]}, o[d0], 0, 0, 0); \
        o[d0] = __builtin_amdgcn_mfma_f32_32x32x16_bf16(pa2, (bf16x8){l2[0], l2[1], l2[2], l2[3], h2[0], h2[1], h2[2], h2[3]}, o[d0], 0, 0, 0); \
        o[d0] = __builtin_amdgcn_mfma_f32_32x32x16_bf16(pa3, (bf16x8){l3[0], l3[1], l3[2], l3[3], h3[0], h3[1], h3[2], h3[3]}, o[d0], 0, 0, 0); } while (0)
    PV_D0(0); PV_D0(1); PV_D0(2); PV_D0(3);
#undef PV_D0
#undef TRRD
}
struct Tens { const bf16_t* QC; const bf16_t* KN; const bf16_t* KPE; const bf16_t* V; bf16_t* YA; const float* qn_nope; const float* qn_pe; const float* RT; };
__device__ __forceinline__ void attn_unit(PG8_LAS unsigned char* lds, const Tens& T, int b, int hh, int qb, int round, int wv) {
    int tid_ = wv * 64 + lane_id(); asm volatile("" : "+v"(tid_));
    const int tid = tid_, wid = __builtin_amdgcn_readfirstlane(tid >> 6), lane = tid & 63, r32 = lane & 31, hi = lane >> 5;
    const int NT = 4 * qb + 5, last_act = 4 * qb + (wid >> 1) + 1;
    unsigned koff[3]; bool kpe[3]; unsigned voff[2];
#pragma unroll
    for (int i = 0; i < 3; ++i) { const int p16 = (i * 8 + wid) * 64 + lane, row = p16 / 24, cp = p16 % 24, c = (cp & ~7) | ((cp & 7) ^ (row & 7));
        kpe[i] = c >= 16; koff[i] = kpe[i] ? (unsigned)(row * ROPE + (c - 16) * 8) * 2u : (unsigned)(row * 512 + hh * NOPE + c * 8) * 2u; }
#pragma unroll
    for (int i = 0; i < 2; ++i) { const int p16 = (i * 8 + wid) * 64 + lane, sub = p16 >> 5, kk = (sub >> 2) * 8 + ((p16 >> 2) & 7), cc = (sub & 3) * 32 + (p16 & 3) * 8;
        const int k = (kk & ~0xC) | ((kk & 4) << 1) | ((kk & 8) >> 1); voff[i] = (unsigned)(k * 512 + hh * 128 + cc) * 2u; }
    const unsigned ldsw = (unsigned)wid * 1024u;
#define ATT_DMA(jt, buf) do { const int kbase_ = (jt) == 0 ? M : b * SEQ + 64 * ((jt) - 1); \
        const char* kn_ = (const char*)(T.KN + (size_t)kbase_ * 512); const char* kp_ = (const char*)(T.KPE + (size_t)kbase_ * ROPE); const char* vv_ = (const char*)(T.V + (size_t)kbase_ * 512); \
        _Pragma("unroll") for (int i_ = 0; i_ < 3; ++i_) __builtin_amdgcn_global_load_lds((const unsigned*)((kpe[i_] ? kp_ : kn_) + koff[i_]), (PG8_LAS unsigned*)(lds + L_K + (buf) * SHM_K + ldsw + i_ * 8192), 16, 0, 0); \
        _Pragma("unroll") for (int i_ = 0; i_ < 2; ++i_) __builtin_amdgcn_global_load_lds((const unsigned*)(vv_ + voff[i_]), (PG8_LAS unsigned*)(lds + L_V + (buf) * SHM_V + ldsw + i_ * 8192), 16, 0, 0); } while (0)
    ATT_DMA(0, 0);
    const bf16_t* Qw = T.QC + (size_t)(b * SEQ + qb * 256 + wid * 32 + r32) * 768 + hh * QKD + hi * 8;
    bf16x8 qr[12];
#pragma unroll
    for (int d0 = 0; d0 < 12; ++d0) qr[d0] = *(const bf16x8*)(Qw + d0 * 16);
    {
        float ssn = 0.f, ssp = 0.f;
#pragma unroll
        for (int d0 = 0; d0 < 12; ++d0) { float f[8]; unpack8(__builtin_bit_cast(u32x4, qr[d0]), f); float t = 0.f;
#pragma unroll
            for (int j = 0; j < 8; ++j) t += f[j] * f[j];
            if (d0 < 8) ssn += t; else ssp += t; }
        ssn = swap_add32(ssn, ssn); ssp = swap_add32(ssp, ssp);
        const float rn = rsqrtf(ssn * (1.f / NOPE) + EPS) * SCL2, rp = rsqrtf(ssp * (1.f / ROPE) + EPS) * SCL2;
#pragma unroll
        for (int d0 = 0; d0 < 8; ++d0) { float f[8]; unpack8(__builtin_bit_cast(u32x4, qr[d0]), f);
            const f32x4 g0 = *(const f32x4*)(T.qn_nope + d0 * 16 + hi * 8), g1 = *(const f32x4*)(T.qn_nope + d0 * 16 + hi * 8 + 4);
            f[0] *= rn * g0.x; f[1] *= rn * g0.y; f[2] *= rn * g0.z; f[3] *= rn * g0.w; f[4] *= rn * g1.x; f[5] *= rn * g1.y; f[6] *= rn * g1.z; f[7] *= rn * g1.w;
            qr[d0] = __builtin_bit_cast(bf16x8, pack8(f)); }
        const int pos = qb * 256 + wid * 32 + r32 + NMETA;
#pragma unroll
        for (int dd = 0; dd < 2; ++dd) { float x1[8], x2[8]; unpack8(__builtin_bit_cast(u32x4, qr[8 + dd]), x1); unpack8(__builtin_bit_cast(u32x4, qr[10 + dd]), x2);
            const int c0 = dd * 16 + hi * 8;
#pragma unroll
            for (int j = 0; j < 8; ++j) { const float y1 = x1[j] * rp * T.qn_pe[c0 + j], y2 = x2[j] * rp * T.qn_pe[c0 + j + 32];
                const float cs = T.RT[(pos * RH + c0 + j) * 2], sn = T.RT[(pos * RH + c0 + j) * 2 + 1];
                x1[j] = y1 * cs - y2 * sn; x2[j] = y2 * cs + y1 * sn; }
            qr[8 + dd] = __builtin_bit_cast(bf16x8, pack8(x1)); qr[10 + dd] = __builtin_bit_cast(bf16x8, pack8(x2)); }
    }
    float m_reg = -1e30f, l_reg = 0.f; f32x16 o[4] = {};
    PG8_LAS float* wsf = (PG8_LAS float*)(lds + L_WS) + wid * 64;
    const lptr K_lds = (lptr)(lds + L_K);
    const int vb0 = (int)(uintptr_t)(lds + L_V) + v_rd_base(lane);
    asm volatile("s_waitcnt vmcnt(0)" ::: "memory"); __builtin_amdgcn_s_barrier(); asm volatile("" ::: "memory");
#define ATT_TILE(KB, t) do { if ((t) + 1 < NT) ATT_DMA((t) + 1, 1 - (KB)); \
        if ((t) <= last_act) { f32x16 p0, p1; qkt<KB>(p0, p1, K_lds, r32, hi, qr); \
            if ((t) == 0) { const float NEG = -__builtin_inff(); _Pragma("unroll") for (int r = 0; r < 16; ++r) { if (crow(r, hi) >= NMETA) p0[r] = NEG; p1[r] = NEG; } } \
            float alpha; partialSM(p0, p1, m_reg, alpha); \
            if (__any(alpha < 1.f)) { if (hi == 0) wsf[r32] = alpha; asm volatile("s_waitcnt lgkmcnt(0)" ::: "memory"); \
                _Pragma("unroll") for (int d_ = 0; d_ < 4; ++d_) _Pragma("unroll") for (int r = 0; r < 16; ++r) o[d_][r] *= wsf[crow(r, hi)]; } \
            bf16x8 pa0, pa1, pa2, pa3; finishSM(p0, p1, alpha, l_reg, pa0, pa1, pa2, pa3); __builtin_amdgcn_sched_barrier(0); \
            pv_tile<KB>(o, vb0, pa0, pa1, pa2, pa3); } \
        asm volatile("s_waitcnt vmcnt(0) lgkmcnt(0)" ::: "memory"); __builtin_amdgcn_s_barrier(); asm volatile("" ::: "memory"); } while (0)
    for (int t = 0; t < NT; t += 2) { ATT_TILE(0, t); if (t + 1 < NT) ATT_TILE(1, t + 1); }
#undef ATT_TILE
#undef ATT_DMA
    if (hi == 0) wsf[32 + r32] = l_reg; asm volatile("s_waitcnt lgkmcnt(0)" ::: "memory");
    bf16_t* Ow = T.YA + (size_t)(b * SEQ + qb * 256 + wid * 32) * D + (round * 4 + hh) * 128;
#pragma unroll
    for (int r = 0; r < 16; ++r) { const int orow = crow(r, hi); const float rl = __builtin_amdgcn_rcpf(wsf[32 + orow]);
#pragma unroll
        for (int d0 = 0; d0 < 4; ++d0) { const float v = o[d0][r] * rl, vn = dpp_f<0xB1>(v);
            if ((r32 & 1) == 0) *(unsigned*)(Ow + (size_t)orow * D + d0 * 32 + r32) = cvtpk(v, vn); } }
    asm volatile("s_waitcnt lgkmcnt(0)" ::: "memory"); __builtin_amdgcn_s_barrier(); asm volatile("" ::: "memory");
}
__device__ __forceinline__ void attn_phase(PG8_LAS unsigned char* lds, const Tens& T, int round, int G, int c, int wv) {
    for (int p = c; p < 256; p += G) {
        const int xcd = p & 7, j = p >> 3, x = j & 3, g = (j >> 2) * 8 + xcd, b = g >> 2, hh = g & 3;
        attn_unit(lds, T, b, hh, 7 - x, round, wv);
        attn_unit(lds, T, b, hh, x, round, wv);
    }
}
__device__ __forceinline__ void attn_phase_dyn(PG8_LAS unsigned char* lds, const Tens& T, int round, unsigned* ticket, volatile PG8_LAS unsigned* slot, int wv) {
    for (;;) {
        if (wv == 0 && lane_id() == 0) *slot = __hip_atomic_fetch_add(ticket, 1u, __ATOMIC_RELAXED, __HIP_MEMORY_SCOPE_AGENT);
        __syncthreads();
        const int u = (int)*slot;
        if (u >= 512) break;
        attn_unit(lds, T, (u & 63) >> 2, u & 3, 7 - (u >> 6), round, wv);
    }
}
}


namespace peer {
typedef _Float16 h2 __attribute__((ext_vector_type(2)));
__device__ __forceinline__ h2 as_h2(unsigned w) { return __builtin_bit_cast(h2, w); }
__device__ __forceinline__ void ins16(float (&t)[16], float x) {
#pragma unroll
    for (int i = 15; i >= 1; --i) t[i] = __builtin_amdgcn_fmed3f(t[i - 1], t[i], x);
    t[0] = fmaxf(t[0], x);
}
constexpr int TK_WAVE_LDS = 16384;
__device__ __forceinline__ void topk64(PG8_LAS float* wl, const bf16_t* __restrict__ S, const float* __restrict__ SSQ, int* __restrict__ IDX, float* __restrict__ GATE, int m0, int hd, bool tile, int lane) {
    {
        float ta[16], tb[16];
#pragma unroll
        for (int p = 0; p < 2; ++p) {
            float t[16];
#pragma unroll
            for (int i = 0; i < 16; ++i) t[i] = -__builtin_inff();
#pragma unroll 1
            for (int q = 0; q < 2; ++q) {
                u32x4 st[8];
#pragma unroll
                for (int j = 0; j < 8; ++j) { const int list = j * 8 + (lane >> 3);
                    st[j] = *(const u32x4*)(S + (size_t)(tile ? m0 + list : m0 + (list >> 3)) * 2048 + (tile ? hd : (list & 7)) * 256 + p * 128 + q * 64 + (lane & 7) * 8); }
#pragma unroll
                for (int j = 0; j < 8; ++j) { float f[8]; unpack8(st[j], f); PG8_LAS float* wp = wl + (j * 8 + (lane >> 3)) * 64 + (lane & 7) * 8;
                    *(PG8_LAS f32x4*)wp = (f32x4){f[0], f[1], f[2], f[3]}; *(PG8_LAS f32x4*)(wp + 4) = (f32x4){f[4], f[5], f[6], f[7]}; }
                asm volatile("s_waitcnt lgkmcnt(0)" ::: "memory");
#pragma unroll 8
                for (int i = 0; i < 64; ++i) { const int e = (i + lane) & 63; const float x = wl[lane * 64 + e];
                    ins16(t, __uint_as_float((__float_as_uint(x) & ~127u) | (unsigned)(q * 64 + e))); }
                asm volatile("s_waitcnt lgkmcnt(0)" ::: "memory");
            }
#pragma unroll
            for (int i = 0; i < 16; ++i) { if (p == 0) ta[i] = t[i]; else tb[i] = t[i]; }
        }
        PG8_LAS int* wi = (PG8_LAS int*)wl + lane * 33;
#pragma unroll
        for (int i = 0; i < 16; ++i) { wi[i] = (int)(__float_as_uint(ta[i]) & 127u); wi[16 + i] = (int)(__float_as_uint(tb[i]) & 127u);
            ta[i] = __uint_as_float(__float_as_uint(ta[i]) & ~127u); tb[i] = __uint_as_float(__float_as_uint(tb[i]) & ~127u); }
        float tc[16];
#pragma unroll
        for (int i = 0; i < 16; ++i) tc[i] = -__builtin_inff();
#pragma unroll
        for (int i = 0; i < 16; ++i)
#pragma unroll
            for (int j = 0; j < 16; ++j) if ((i + 1) * (j + 1) <= 16) ins16(tc, __uint_as_float((__float_as_uint(ta[i] + tb[j]) & ~255u) | (unsigned)(i * 16 + j)));
        asm volatile("s_waitcnt lgkmcnt(0)" ::: "memory");
        float g[16]; int id[16]; float sum = 0.f;
        const float mx = __uint_as_float(__float_as_uint(tc[0]) & ~255u);
        const int mtok = tile ? m0 + lane : m0 + (lane >> 3), mhd = tile ? hd : (lane & 7);
        float r2; { const float* sp = SSQ + (size_t)mtok * 32; float t = 0.f;
#pragma unroll
            for (int i = 0; i < 8; ++i) { const f32x4 q = *(const f32x4*)(sp + 4 * i); t += (q.x + q.y) + (q.z + q.w); }
            r2 = rsqrtf(t * (1.f / D) + EPS); }
#pragma unroll
        for (int k = 0; k < 16; ++k) { const unsigned key = __float_as_uint(tc[k]); const int pos = (int)(key & 255u);
            id[k] = wi[pos >> 4] * 128 + wi[16 + (pos & 15)]; g[k] = __expf((__uint_as_float(key & ~255u) - mx) * r2); sum += g[k]; }
        const float inv = 1.f / sum;
        const size_t o = ((size_t)mtok * 8 + mhd) * 16;
#pragma unroll
        for (int k = 0; k < 16; k += 4) { *(f32x4*)(GATE + o + k) = (f32x4){g[k] * inv, g[k + 1] * inv, g[k + 2] * inv, g[k + 3] * inv};
            *(u32x4*)(IDX + o + k) = (u32x4){(unsigned)id[k], (unsigned)id[k + 1], (unsigned)id[k + 2], (unsigned)id[k + 3]}; }
        asm volatile("s_waitcnt lgkmcnt(0)" ::: "memory");
    }
}
constexpr float PEER_SU = 94.4f, PEER_SV = 5.883f;
struct __attribute__((packed, aligned(4))) U3 { unsigned x, y, z; };
typedef unsigned u32x6 __attribute__((ext_vector_type(6)));
typedef float f32x32 __attribute__((ext_vector_type(32)));
typedef float f32x2 __attribute__((ext_vector_type(2)));
__device__ __forceinline__ float gelu_erf(float x) {
    const float z = fabsf(x) * 0.70710678118654752f, t = __builtin_amdgcn_rcpf(fmaf(0.3275911f, z, 1.f));
    const float pl = t * fmaf(t, fmaf(t, fmaf(t, fmaf(t, 1.061405429f, -1.453152027f), 1.421413741f), -0.284496736f), 0.254829592f);
    const float e = 1.f - pl * __expf(-z * z);
    return 0.5f * x * (1.f + (x < 0.f ? -e : e));
}
__device__ __forceinline__ int row3(int idx) { int t; asm("v_lshl_add_u32 %0, %1, 1, %1" : "=v"(t) : "v"(idx)); return t << 8; }
__device__ __forceinline__ void gather1s_phase(PG8_LAS unsigned char* lds, const bf16_t* __restrict__ HN, const int* __restrict__ IDX, const float* __restrict__ GATE, const unsigned char* __restrict__ U8, const unsigned char* __restrict__ V8, const float* __restrict__ SSQ, float* out, int G, int c, int wv) {
    int tid_ = wv * 64 + lane_id(); asm volatile("" : "+v"(tid_));
    const int lane = tid_ & 63, wid = wv;
    typedef unsigned u32x2_ __attribute__((ext_vector_type(2)));
    PG8_LAS u32x2_* LW = (PG8_LAS u32x2_*)(lds + wid * 2048);
#pragma unroll
    for (int i = 0; i < 4; ++i) LW[64 * i + lane] = (u32x2_){0u, 0u};
    const int m0 = c * 8 + wid, mstep = G * 8, l12 = 12 * lane, l8 = 8 * lane;
    if (m0 >= M) return;
#define LOAD_TOK(mm, lane) do { pi0 = IDX[(size_t)(mm) * 128 + lane]; pi1 = IDX[(size_t)(mm) * 128 + 64 + lane]; pg0 = GATE[(size_t)(mm) * 128 + lane]; pg1 = GATE[(size_t)(mm) * 128 + 64 + lane]; } while (0)
#define LOAD_HN(mm, lane) do { hp0 = *(const u32x4*)(HN + (size_t)(mm) * D + 16 * lane); hp1 = *(const u32x4*)(HN + (size_t)(mm) * D + 16 * lane + 8); pss = lane < 32 ? SSQ[(size_t)(mm) * 32 + lane] : 0.f; } while (0)
#define BUILD_LIST(base) do { const int i0_ = pi0, i1_ = pi1; const float g0_ = pg0, g1_ = pg1; \
          int cnt = (base); \
          _Pragma("unroll 1") for (int sl = 0; sl < 8; ++sl) { \
              const bool q0 = (i0_ >> 11) == sl, q1 = (i1_ >> 11) == sl; const unsigned long long k0 = __ballot(q0), k1 = __ballot(q1); \
              if (q0) LW[cnt + (int)__builtin_amdgcn_mbcnt_hi((unsigned)(k0 >> 32), __builtin_amdgcn_mbcnt_lo((unsigned)k0, 0u))] = (u32x2_){(unsigned)i0_, __float_as_uint(g0_)}; \
              cnt += __builtin_popcountll(k0); \
              if (q1) LW[cnt + (int)__builtin_amdgcn_mbcnt_hi((unsigned)(k1 >> 32), __builtin_amdgcn_mbcnt_lo((unsigned)k1, 0u))] = (u32x2_){(unsigned)i1_, __float_as_uint(g1_)}; \
              cnt += __builtin_popcountll(k1); } \
          asm volatile("s_waitcnt lgkmcnt(0)" ::: "memory"); } while (0)
#define LOAD_ROWS(dst, TAB, e) do { _Pragma("unroll") for (int j = 0; j < 8; ++j) dst[j] = *(const U3*)(TAB + (size_t)(unsigned)(row3((int)LW[(e) + j].x) + l12)); asm volatile("" ::: "memory"); } while (0)
    int pi0, pi1; float pg0, pg1, pss; u32x4 hp0, hp1;
    LOAD_TOK(m0, lane); BUILD_LIST(0); LOAD_HN(m0, lane);
    if (m0 + mstep < M) LOAD_TOK(m0 + mstep, lane);
    #define LOAD_ROWS4(dst, TAB, e) do { _Pragma("unroll") for (int j = 0; j < 8; ++j) dst[j] = *(const u32x2_*)(TAB + (size_t)(unsigned)(__mul24((int)LW[(e) + j].x, 512) + l8)); asm volatile("" ::: "memory"); } while (0)
    u32x2_ ub0[8], ub1[8], vb0[8];
    LOAD_ROWS4(ub0, U8, 0); LOAD_ROWS4(vb0, V8, 0); LOAD_ROWS4(ub1, U8, 8);
    int ring = 0;
#pragma unroll 1
    for (int m = m0; m < M; m += mstep) {
        f32x2 hn[8], acc[8]; unsigned hq1[2], hq2[2]; float hs1, hs2;
        int ln = lane; asm volatile("" : "+v"(ln));
        const float ssq = pss;
        { float f[16]; unpack8(hp0, f); unpack8(hp1, f + 8);
#pragma unroll
          for (int i = 0; i < 8; ++i) { hn[i] = (f32x2){f[2 * i], f[2 * i + 1]}; acc[i] = (f32x2){0.f, 0.f}; }
          float am = 0.f;
#pragma unroll
          for (int i = 0; i < 16; ++i) am = fmaxf(am, fabsf(f[i]));
          { const u32x2 r_ = __builtin_amdgcn_permlane32_swap(__float_as_uint(am), __float_as_uint(am), false, false); am = fmaxf(__uint_as_float(r_.x), __uint_as_float(r_.y)); }
          { const u32x2 r_ = __builtin_amdgcn_permlane16_swap(__float_as_uint(am), __float_as_uint(am), false, false); am = fmaxf(__uint_as_float(r_.x), __uint_as_float(r_.y)); }
          am = fmaxf(am, dpp_f<0x128>(am)); am = fmaxf(am, dpp_f<0xB1>(am)); am = fmaxf(am, dpp_f<0x4E>(am)); am = fmaxf(am, dpp_f<0x141>(am));
          hs1 = fmaxf(am, 1e-20f) * (1.f / 7.5f); hs2 = hs1 * (1.f / 16.f); const float i1_ = 1.f / hs1, i2_ = 1.f / hs2;
          hq1[0] = hq1[1] = hq2[0] = hq2[1] = 0u;
#pragma unroll
          for (int i = 0; i < 16; ++i) { const float q1 = fminf(fmaxf(__builtin_rintf(f[i] * i1_), -8.f), 7.f), rr = f[i] - q1 * hs1, q2 = fminf(fmaxf(__builtin_rintf(rr * i2_), -8.f), 7.f);
              hq1[i >> 3] |= ((unsigned)(int)q1 & 15u) << (4 * (i & 7)); hq2[i >> 3] |= ((unsigned)(int)q2 & 15u) << (4 * (i & 7)); } }
        float sq = swap_add16(swap_add32(ssq, ssq), swap_add32(ssq, ssq)); sq += dpp_f<0x128>(sq); sq += dpp_f<0xB1>(sq); sq += dpp_f<0x4E>(sq); sq += dpp_f<0x141>(sq);
        const float r2su = rsqrtf(sq * (1.f / D) + EPS) * (1.f / PEER_SU);
        if (m + mstep < M) { BUILD_LIST(ring ^ 128); LOAD_HN(m + mstep, ln); if (m + 2 * mstep < M) LOAD_TOK(m + 2 * mstep, ln); }
#define F4ACC(vb, b) { acc[4 * w + b] = __builtin_elementwise_fma((f32x2){a, a}, __builtin_amdgcn_cvt_scalef32_pk_f32_fp4(vb[j][w], 1.0f, b), acc[4 * w + b]); }
#define ACC_ROWS(vb, ap, j0, j1) do { _Pragma("unroll") for (int j = j0; j < j1; ++j) { const float a = __builtin_bit_cast(float, __builtin_amdgcn_readlane(__builtin_bit_cast(int, ap), j * 8)); \
                _Pragma("unroll") for (int w = 0; w < 2; ++w) { F4ACC(vb, 0) F4ACC(vb, 1) F4ACC(vb, 2) F4ACC(vb, 3) } } } while (0)
#define DOT8(ub, d) do { _Pragma("unroll") for (int j = 0; j < 8; ++j) {     \
                int t_ = __builtin_amdgcn_sdot8((int)ub[j].y, (int)hq1[1], __builtin_amdgcn_sdot8((int)ub[j].x, (int)hq1[0], 0, false), false) << 4; \
                t_ = __builtin_amdgcn_sdot8((int)ub[j].y, (int)hq2[1], __builtin_amdgcn_sdot8((int)ub[j].x, (int)hq2[0], t_, false), false); \
                d[j] = (float)t_ * hs2; } } while (0)
#define GSTEP(ub, vb, k, HAVE_PREV) do { const int e0 = ring + (k) * 8, e2 = (e0 + 16) & 255, e1 = (e0 + 8) & 255; \
            float d[8]; DOT8(ub, d); \
            asm volatile("" ::: "memory"); \
            LOAD_ROWS4(ub, U8, e2); \
            float s4[4], s2[2], s1; \
            if (HAVE_PREV) ACC_ROWS(vb, actp, 0, 1); \
            _Pragma("unroll") for (int j = 0; j < 4; ++j) s4[j] = swap_add32(d[j], d[j + 4]); \
            if (HAVE_PREV) ACC_ROWS(vb, actp, 1, 2); \
            _Pragma("unroll") for (int j = 0; j < 2; ++j) s2[j] = swap_add16(s4[j], s4[j + 2]); \
            if (HAVE_PREV) ACC_ROWS(vb, actp, 2, 3); \
            { const bool up = lane & 8; const float keep = up ? s2[1] : s2[0], send = up ? s2[0] : s2[1]; s1 = keep + dpp_f<0x128>(send); } \
            if (HAVE_PREV) ACC_ROWS(vb, actp, 3, 4); \
            s1 += dpp_f<0xB1>(s1); s1 += dpp_f<0x4E>(s1); s1 += dpp_f<0x141>(s1); \
            s1 *= r2su; \
            if (HAVE_PREV) ACC_ROWS(vb, actp, 4, 5); \
            const float actn = gelu_erf(s1) * __uint_as_float(LW[e0 + (lane >> 3)].y) * (1.f / PEER_SV); \
            if (HAVE_PREV) { ACC_ROWS(vb, actp, 5, 8); \
                asm volatile("" ::: "memory"); \
                LOAD_ROWS4(vb, V8, e0); } \
            actp = actn; \
        } while (0)
        float actp;
        GSTEP(ub0, vb0, 0, false);
#pragma unroll 1
        for (int k = 1; k < 15; k += 2) { GSTEP(ub1, vb0, k, true); GSTEP(ub0, vb0, k + 1, true); }
        GSTEP(ub1, vb0, 15, true);
        ACC_ROWS(vb0, actp, 0, 8);
        asm volatile("" ::: "memory");
        LOAD_ROWS4(vb0, V8, (ring + 128) & 255);
#undef GSTEP
#undef DOT8
#undef ACC_ROWS
#undef F4ACC
        int lo_ = lane; asm volatile("" : "+v"(lo_));
        float* o = out + (size_t)m * D + 16 * lo_;
#pragma unroll
        for (int i = 0; i < 4; ++i) *(f32x4*)(o + 4 * i) = (f32x4){hn[2 * i].x + acc[2 * i].x, hn[2 * i].y + acc[2 * i].y, hn[2 * i + 1].x + acc[2 * i + 1].x, hn[2 * i + 1].y + acc[2 * i + 1].y};
        ring ^= 128;
    }
#undef LOAD_ROWS
#undef LOAD_ROWS4
#undef BUILD_LIST
#undef LOAD_TOK
#undef LOAD_HN
    asm volatile("s_waitcnt lgkmcnt(0)" ::: "memory");
}
}
namespace gla {
#define LDS_BARRIER() do { asm volatile("s_waitcnt lgkmcnt(0)" ::: "memory"); __builtin_amdgcn_s_barrier(); asm volatile("" ::: "memory"); } while (0)
typedef short bf16x8 __attribute__((ext_vector_type(8)));
typedef float f32x16 __attribute__((ext_vector_type(16)));
__device__ __forceinline__ int chunk_row0(int b, int c) { return c == 0 ? M : b * SEQ + 64 * (c - 1); }
__device__ __forceinline__ int ppos(int d) { const int g = (d >> 2) & 3; return (d & ~12) | ((g == 1 ? 2 : (g == 2 ? 1 : g)) << 2); }
__device__ __forceinline__ unsigned cvtpk(float lo, float hi) { unsigned r; asm volatile("v_cvt_pk_bf16_f32 %0, %1, %2" : "=v"(r) : "v"(lo), "v"(hi)); return r; }
struct Tens { bf16_t* GQ; bf16_t* GKT; const bf16_t* GVT; bf16_t* GQo; bf16_t* GKTo; int var; const bf16_t* P0; const float* w_a2; const float* b_a; bf16_t* AG; float* DECL; bf16_t* OG; };
constexpr int PQROW = 136;
constexpr int BMROW = 132;
constexpr int P_GAL = 0, P_TOT = 2048, P_BM = 4096, P_QL = P_BM + 64 * BMROW * 4, P_KL = P_QL + 64 * PQROW * 2, P_END = P_KL + 64 * PQROW * 2;
struct PrepIn { u32x4 ga, kt0, kt1, q0, q1; };
__device__ __forceinline__ void prep_load(PrepIn& I, const Tens& T, int u, int tid) {
    const int b = u / 132, h = (u / 33) & 3, c = u % 33, row0 = chunk_row0(b, c), d = tid & 127, jq = tid >> 7, j = tid >> 3, c16 = tid & 7;
    I.ga = tid < 128 ? *(const u32x4*)(T.P0 + (size_t)(row0 + (tid >> 1)) * P0W + 704 + (tid & 1) * 8) : (u32x4){0u, 0u, 0u, 0u};
    const bf16_t* kt = T.GKT + (size_t)(h * GHK + d) * ME + row0 + jq * 16; I.kt0 = *(const u32x4*)kt; I.kt1 = *(const u32x4*)(kt + 8);
    const size_t g = (size_t)(row0 + j) * GDK + h * GHK + c16 * 16;
    I.q0 = *(const u32x4*)(T.GQ + g); I.q1 = *(const u32x4*)(T.GQ + g + 8);
}
__device__ __forceinline__ void prep_compute(PG8_LAS unsigned char* lds, const Tens& T, const PrepIn& I, const float (&w)[GR], float ba, int u, int tid, int wid, int lane) {
    const int b = u / 132, h = (u / 33) & 3, c = u % 33, row0 = chunk_row0(b, c), d = tid & 127, jq = tid >> 7, j = tid >> 3, c16 = tid & 7;
    PG8_LAS bf16_t* GAL = (PG8_LAS bf16_t*)(lds + P_GAL); PG8_LAS float* TOT = (PG8_LAS float*)(lds + P_TOT); PG8_LAS float* BM = (PG8_LAS float*)(lds + P_BM);
    PG8_LAS bf16_t* QL = (PG8_LAS bf16_t*)(lds + P_QL); PG8_LAS bf16_t* KL = (PG8_LAS bf16_t*)(lds + P_KL);
    if (tid < 128) *(PG8_LAS u32x4*)(GAL + (tid >> 1) * 16 + (tid & 1) * 8) = I.ga;
    LDS_BARRIER();
    float Bv[16]; float run = 0.f;
#pragma unroll
    for (int jj = 0; jj < 16; ++jj) { const int jt = jq * 16 + jj; float x = ba;
        const u32x4 g0 = *(const PG8_LAS u32x4*)(GAL + jt * 16), g1 = *(const PG8_LAS u32x4*)(GAL + jt * 16 + 8); float gf[16]; unpack8(g0, gf); unpack8(g1, gf + 8);
#pragma unroll
        for (int r = 0; r < GR; ++r) x += gf[r] * w[r];
        float la = (fminf(x, 0.f) - __logf(1.f + __expf(-fabsf(x)))) * (1.f / 16.f);
        if (c == 0 && jt >= NMETA) la = 0.f;
        run += la; Bv[jj] = run; }
    TOT[jq * 128 + d] = run;
    LDS_BARRIER();
    float base = 0.f, blast = 0.f;
#pragma unroll
    for (int g = 0; g < 4; ++g) { const float t = TOT[g * 128 + d]; blast += t; if (g < jq) base += t; }
#pragma unroll
    for (int jj = 0; jj < 16; ++jj) BM[(jq * 16 + jj) * BMROW + d] = base + Bv[jj];
    { float kf[16]; unpack8(I.kt0, kf); unpack8(I.kt1, kf + 8);
      const int pd = ppos(d);
#pragma unroll
      for (int jj = 0; jj < 16; ++jj) { const float e = __expf(-(base + Bv[jj])); KL[(jq * 16 + jj) * PQROW + pd] = f2bf(kf[jj] * e); kf[jj] *= e * __expf(blast); }
      bf16_t* kto = T.GKTo + (size_t)(h * GHK + d) * ME + row0 + jq * 16; if (T.var == 0) { *(u32x4*)kto = pack8(kf); *(u32x4*)(kto + 8) = pack8(kf + 8); } else if (kf[3] == 1.2345f) T.DECL[1] = 1.f; }
    if (jq == 0) T.DECL[(size_t)u * GHK + d] = __expf(blast);
    LDS_BARRIER();
    {
        float qf[16], bv[16]; unpack8(I.q0, qf); unpack8(I.q1, qf + 8);
#pragma unroll
        for (int i = 0; i < 4; ++i) { const f32x4 t = *(const PG8_LAS f32x4*)(BM + j * BMROW + c16 * 16 + 4 * i); bv[4 * i] = t.x; bv[4 * i + 1] = t.y; bv[4 * i + 2] = t.z; bv[4 * i + 3] = t.w; }
        float qo[16];
#pragma unroll
        for (int i = 0; i < 16; ++i) { const int p = (i & 3) | ((((i >> 2) == 1) ? 2 : ((i >> 2) == 2 ? 1 : (i >> 2))) << 2); qo[p] = qf[i] * GLA_QS * __expf(bv[i]); }
        const u32x4 qa = pack8(qo), qb = pack8(qo + 8);
        *(PG8_LAS u32x4*)(QL + j * PQROW + c16 * 16) = qa; *(PG8_LAS u32x4*)(QL + j * PQROW + c16 * 16 + 8) = qb;
        bf16_t* go = T.GQo + (size_t)(row0 + j) * GDK + h * GHK + c16 * 16; if (T.var == 0) { *(u32x4*)go = qa; *(u32x4*)(go + 8) = qb; } }
    LDS_BARRIER();
    { const int bi = wid >> 1, fr = lane & 15, fq = lane >> 4;
#pragma unroll
      for (int t = 0; t < 2; ++t) { const int bj = 2 * (wid & 1) + t; f32x4 acc = {0.f, 0.f, 0.f, 0.f};
#pragma unroll
        for (int s_ = 0; s_ < 4; ++s_) { const bf16x8 af = *(const PG8_LAS bf16x8*)(QL + (16 * bi + fr) * PQROW + 32 * s_ + 8 * fq), bf = *(const PG8_LAS bf16x8*)(KL + (16 * bj + fr) * PQROW + 32 * s_ + 8 * fq);
            acc = __builtin_amdgcn_mfma_f32_16x16x32_bf16(af, bf, acc, 0, 0, 0); }
#pragma unroll
        for (int r = 0; r < 4; ++r) { const int i = 16 * bi + fq * 4 + r, jc = 16 * bj + fr; if (T.var == 0) T.AG[((size_t)u * 64 + i) * 64 + jc] = f2bf(jc <= i ? acc[r] : 0.f); else if (acc[r] == 1.2345f) T.DECL[2] = 1.f; } } }
    LDS_BARRIER();
}
__device__ __forceinline__ int prep_unit_id(int k) { return k < NB * 4 * 32 ? (k >> 5) * 33 + 1 + (k & 31) : (k - NB * 4 * 32) * 33; }
__device__ __forceinline__ void prep_phase(PG8_LAS unsigned char* lds, const Tens& T, int G, int c, int wv) {
    int tid_ = wv * 64 + lane_id(); asm volatile("" : "+v"(tid_));
    const int tid = tid_, lane = tid & 63, wid = wv; constexpr int NK = NB * 4 * 32 + 4;
    if (c >= NK) return;
    PrepIn cur, nxt; prep_load(cur, T, prep_unit_id(c), tid);
    float w[GR], ba = 0.f; int hcur = -1;
#pragma unroll 1
    for (int k = c; k < NK; k += G) {
        const bool more = k + G < NK; const int u = prep_unit_id(k), h = (u / 33) & 3;
        if (more) prep_load(nxt, T, prep_unit_id(k + G), tid);
        if (h != hcur) { hcur = h; const int d = tid & 127;
#pragma unroll
            for (int r = 0; r < GR; ++r) w[r] = T.w_a2[r * GDK + h * GHK + d];
            ba = T.b_a[h * GHK + d]; }
        prep_compute(lds, T, cur, w, ba, u, tid, wid, lane);
        if (more) cur = nxt;
    }
}
constexpr int S_Q = 0, S_A = 64 * 272, S_K = S_A + 64 * 144, S_D = S_K + 128 * 144, S_BUF = S_D + 512;
__device__ __forceinline__ void scan_wg(PG8_LAS unsigned char* lds, const Tens& T, int b, int h, int wv) {
    int tid_ = wv * 64 + lane_id(); asm volatile("" : "+v"(tid_));
    const int tid = tid_, wid = __builtin_amdgcn_readfirstlane(tid >> 6), lane = tid & 63, r32 = lane & 31, hi = lane >> 5;
    f32x16 S[4];
#pragma unroll
    for (int i = 0; i < 4; ++i) S[i] = f32x16{};
    const int u0 = (b * 4 + h) * 33;
    u32x4 sq[2], sa, sk[2]; float sd = 0.f; bf16x8 vcur[4], vnxt[4];
    const bf16_t* vrow = T.GVT + (size_t)(h * GHV + 32 * wid + r32) * ME + 8 * hi;
#define GLA_LOAD(c_) do { const int row0_ = chunk_row0(b, (c_)); \
        _Pragma("unroll") for (int i = 0; i < 2; ++i) { const int ch = tid + i * 512; sq[i] = *(const u32x4*)(T.GQ + (size_t)(row0_ + (ch >> 4)) * GDK + h * GHK + (ch & 15) * 8); \
            sk[i] = *(const u32x4*)(T.GKT + (size_t)(h * GHK + (ch >> 3)) * ME + row0_ + (ch & 7) * 8); } \
        const int uc_ = (c_) == 0 ? h * 33 : u0 + (c_); sa = *(const u32x4*)(T.AG + ((size_t)uc_ * 64 + (tid >> 3)) * 64 + (tid & 7) * 8); if (tid < 128) sd = T.DECL[(size_t)uc_ * GHK + tid]; \
        _Pragma("unroll") for (int s_ = 0; s_ < 4; ++s_) vnxt[s_] = *(const bf16x8*)(vrow + row0_ + 16 * s_); } while (0)
#define GLA_WRITE(buf) do { PG8_LAS unsigned char* L_ = lds + (buf) * S_BUF; \
        _Pragma("unroll") for (int i = 0; i < 2; ++i) { const int ch = tid + i * 512; *(PG8_LAS u32x4*)(L_ + S_Q + (ch >> 4) * 272 + (ch & 15) * 16) = sq[i]; *(PG8_LAS u32x4*)(L_ + S_K + (ch >> 3) * 144 + (ch & 7) * 16) = sk[i]; } \
        *(PG8_LAS u32x4*)(L_ + S_A + (tid >> 3) * 144 + (tid & 7) * 16) = sa; if (tid < 128) *(PG8_LAS float*)(L_ + S_D + tid * 4) = sd; } while (0)
    GLA_LOAD(0); GLA_WRITE(0);
#pragma unroll
    for (int s_ = 0; s_ < 4; ++s_) vcur[s_] = vnxt[s_];
    LDS_BARRIER();
#pragma unroll 1
    for (int c = 0; c < 33; ++c) {
        if (c + 1 < 33) GLA_LOAD(c + 1);
        PG8_LAS unsigned char* L = lds + (c & 1) * S_BUF;
        f32x16 o[2];
#pragma unroll
        for (int ib = 0; ib < 2; ++ib) { o[ib] = f32x16{};
#pragma unroll
            for (int s_ = 0; s_ < 4; ++s_) { const bf16x8 af = *(const PG8_LAS bf16x8*)(L + S_A + (32 * ib + r32) * 144 + (16 * s_ + 8 * hi) * 2);
                o[ib] = __builtin_amdgcn_mfma_f32_32x32x16_bf16(af, vcur[s_], o[ib], 0, 0, 0); } }
#pragma unroll
        for (int s_ = 0; s_ < 8; ++s_) { const int db = s_ >> 1, t8 = 8 * (s_ & 1);
            u32x4 wv; wv.x = cvtpk(S[db][t8 + 0], S[db][t8 + 1]); wv.y = cvtpk(S[db][t8 + 2], S[db][t8 + 3]); wv.z = cvtpk(S[db][t8 + 4], S[db][t8 + 5]); wv.w = cvtpk(S[db][t8 + 6], S[db][t8 + 7]);
            const bf16x8 sf = __builtin_bit_cast(bf16x8, wv);
#pragma unroll
            for (int ib = 0; ib < 2; ++ib) { const bf16x8 qf = *(const PG8_LAS bf16x8*)(L + S_Q + (32 * ib + r32) * 272 + (16 * s_ + 8 * hi) * 2);
                o[ib] = __builtin_amdgcn_mfma_f32_32x32x16_bf16(qf, sf, o[ib], 0, 0, 0); } }
        if (c > 0) { bf16_t* Ow = T.OG + (size_t)chunk_row0(b, c) * D + h * GHV + 32 * wid;
#pragma unroll
            for (int ib = 0; ib < 2; ++ib)
#pragma unroll
                for (int r = 0; r < 16; ++r) { const int orow = 32 * ib + (r & 3) + 8 * (r >> 2) + 4 * hi; const float v = o[ib][r], vn = dpp_f<0xB1>(v);
                    if ((r32 & 1) == 0) *(unsigned*)(Ow + (size_t)orow * D + r32) = cvtpk(v, vn); } }
#pragma unroll
        for (int db = 0; db < 4; ++db) {
#pragma unroll
            for (int g = 0; g < 4; ++g) { const f32x4 dv = *(const PG8_LAS f32x4*)(L + S_D + (32 * db + 8 * g + 4 * hi) * 4);
                S[db][4 * g + 0] *= dv[0]; S[db][4 * g + 1] *= dv[1]; S[db][4 * g + 2] *= dv[2]; S[db][4 * g + 3] *= dv[3]; }
#pragma unroll
            for (int s_ = 0; s_ < 4; ++s_) { const bf16x8 kf = *(const PG8_LAS bf16x8*)(L + S_K + (32 * db + r32) * 144 + (16 * s_ + 8 * hi) * 2);
                S[db] = __builtin_amdgcn_mfma_f32_32x32x16_bf16(kf, vcur[s_], S[db], 0, 0, 0); } }
        if (c + 1 < 33) { GLA_WRITE((c + 1) & 1);
#pragma unroll
            for (int s_ = 0; s_ < 4; ++s_) vcur[s_] = vnxt[s_]; }
        LDS_BARRIER();
    }
#undef GLA_LOAD
#undef GLA_WRITE
}
}


#define XB_TMO      128
#define XB_XCNT(j)  (256  + 64 * (j))
#define XB_XSUB(j)  (1280 + 64 * (j))
#define XB_XGEN(j)  (2304 + 64 * (j))
#define XB_TOP      3328
#define XB_TOPGEN   3392
#define XCD_BAR_WORDS 3456
#define XB_SPIN_CAP (1u << 18)

__device__ __forceinline__ unsigned xb_ld(unsigned* p)              { return __hip_atomic_load(p, __ATOMIC_RELAXED, __HIP_MEMORY_SCOPE_AGENT); }
__device__ __forceinline__ unsigned xb_add(unsigned* p, unsigned v) { return __hip_atomic_fetch_add(p, v, __ATOMIC_RELAXED, __HIP_MEMORY_SCOPE_AGENT); }
__device__ __forceinline__ unsigned xb_xcc_id() { return (unsigned)__builtin_amdgcn_s_getreg((3 << 11) | 20) & 0xFu; }
#define XB_SPIN(cond, bar) do { unsigned _sp = 0; while (cond) { __builtin_amdgcn_s_sleep(1); \
    if ((++_sp & 255u) == 0u) { if (xb_ld(&(bar)[XB_TMO])) break; if (_sp > XB_SPIN_CAP) { atomicAdd(&(bar)[XB_TMO], 1u); break; } } } } while (0)

struct XcdBarrier {
    int wv;
    unsigned* bar; unsigned x;
    volatile PG8_LAS unsigned* st;
};

__device__ __forceinline__ XcdBarrier xcd_barrier_post(unsigned* bar, volatile PG8_LAS unsigned* st, int wv) {
    XcdBarrier b; b.wv = wv; b.bar = bar; b.x = xb_xcc_id(); b.st = st;
    if (wv == 0 && lane_id() == 0) (void)xb_add(&bar[XB_XCNT(b.x)], 1u);
    return b;
}
__device__ __forceinline__ void xcd_barrier_complete(unsigned* bar, unsigned x, unsigned& nloc, unsigned& nx) {
    const unsigned G = gridDim.x * gridDim.y * gridDim.z;
    unsigned sum, cnt, mine, sp = 0u;
    for (;;) {
        sum = 0u; cnt = 0u; mine = 0u;
#pragma unroll
        for (unsigned j = 0; j < 16; ++j) { const unsigned c = xb_ld(&bar[XB_XCNT(j)]); sum += c; cnt += (c > 0u) ? 1u : 0u; mine = (j == x) ? c : mine; }
        if (sum == G) break;
        __builtin_amdgcn_s_sleep(1);
        if ((++sp & 255u) == 0u) { if (xb_ld(&bar[XB_TMO])) break; if (sp > XB_SPIN_CAP) { atomicAdd(&bar[XB_TMO], 1u); break; } }
    }
    nloc = mine > 0u ? mine : 1u; nx = cnt > 0u ? cnt : 1u;
}

__device__ __forceinline__ void xcd_barrier(const XcdBarrier& b) {
    asm volatile("s_waitcnt vmcnt(0)" ::: "memory");
    __syncthreads();
    if (b.wv == 0 && lane_id() == 0) {
        unsigned* bar = b.bar;
        __builtin_amdgcn_s_waitcnt(0);
        unsigned nloc = b.st[0], nx = b.st[1];
        if (nloc == 0u) { xcd_barrier_complete(bar, b.x, nloc, nx); b.st[0] = nloc; b.st[1] = nx; }
        const unsigned old = xb_add(&bar[XB_XSUB(b.x)], 1u);
        const unsigned gen = old / nloc;
        if (old + 1u == (gen + 1u) * nloc) {
            __builtin_amdgcn_fence(__ATOMIC_RELEASE, "agent");
            asm volatile("s_waitcnt vmcnt(0)" ::: "memory");
            const unsigned og = xb_add(&bar[XB_TOP], 1u);
            const unsigned tg = og / nx;
            if (og + 1u == (tg + 1u) * nx) xb_add(&bar[XB_TOPGEN], 1u);
            else XB_SPIN(xb_ld(&bar[XB_TOPGEN]) == tg, bar);
            __builtin_amdgcn_fence(__ATOMIC_ACQUIRE, "agent");
            xb_add(&bar[XB_XGEN(b.x)], 1u);
            asm volatile("s_waitcnt vmcnt(0)" ::: "memory");
        } else {
            XB_SPIN(xb_ld(&bar[XB_XGEN(b.x)]) == gen, bar);
            __builtin_amdgcn_fence(__ATOMIC_ACQUIRE, "agent");
            asm volatile("s_waitcnt vmcnt(0)" ::: "memory");
        }
    }
    __syncthreads();
}

namespace sm {
__device__ __forceinline__ void prep_x(const float* __restrict__ x, const float* __restrict__ meta, bf16_t* __restrict__ XB, float* __restrict__ R1, int gw, int nw, int lane) {
    asm volatile("" : "+v"(lane));
    unsigned char* XQ = (unsigned char*)XB;
    for (int r0 = gw * 4; r0 < ME; r0 += nw * 4) {
        f32x4 v[4][4];
#pragma unroll
        for (int t = 0; t < 4; ++t) { const int r = r0 + t; const float* src = r < M ? x + (size_t)r * D : (r < M + NMETA ? meta + (size_t)(r - M) * D : nullptr);
#pragma unroll
            for (int j = 0; j < 4; ++j) v[t][j] = src ? *(const f32x4*)(src + 16 * lane + 4 * j) : (f32x4){0.f, 0.f, 0.f, 0.f}; }
#pragma unroll
        for (int t = 0; t < 4; ++t) { const int r = r0 + t; float ss = 0.f, am = 0.f;
#pragma unroll
            for (int j = 0; j < 4; ++j) { ss += v[t][j].x * v[t][j].x + v[t][j].y * v[t][j].y + v[t][j].z * v[t][j].z + v[t][j].w * v[t][j].w;
                am = fmaxf(fmaxf(am, fmaxf(fabsf(v[t][j].x), fabsf(v[t][j].y))), fmaxf(fabsf(v[t][j].z), fabsf(v[t][j].w))); }
            ss = wsum(ss);
            { const u32x2 q_ = __builtin_amdgcn_permlane32_swap(__float_as_uint(am), __float_as_uint(am), false, false); am = fmaxf(__uint_as_float(q_.x), __uint_as_float(q_.y)); }
            { const u32x2 q_ = __builtin_amdgcn_permlane16_swap(__float_as_uint(am), __float_as_uint(am), false, false); am = fmaxf(__uint_as_float(q_.x), __uint_as_float(q_.y)); }
            am = fmaxf(am, dpp_f<0x128>(am)); am = fmaxf(am, dpp_f<0xB1>(am)); am = fmaxf(am, dpp_f<0x4E>(am)); am = fmaxf(am, dpp_f<0x141>(am));
            const float rn = rsqrtf(ss * (1.f / D) + EPS), qs = am > 0.f ? 127.f / am : 0.f;
            if (lane == 0) R1[r] = am * rn * (1.f / 127.f) * SW_IN;
            u32x4 o;
#pragma unroll
            for (int j = 0; j < 4; ++j) { const int a0 = (int)__builtin_rintf(v[t][j].x * qs), a1 = (int)__builtin_rintf(v[t][j].y * qs), a2 = (int)__builtin_rintf(v[t][j].z * qs), a3 = (int)__builtin_rintf(v[t][j].w * qs);
                o[j] = (unsigned)(a0 & 255) | (unsigned)(a1 & 255) << 8 | (unsigned)(a2 & 255) << 16 | (unsigned)(a3 & 255) << 24; }
            *(u32x4*)(XQ + (size_t)r * D + 16 * lane) = o; }
    }
}
struct WDesc { const float* src; int Nsrc, K; bf16_t* dst; int Ndst; const float* gain; int gmod, mode; float qs; };
__device__ __forceinline__ void prep_w_load(const WDesc& W, int it, float (&x)[32], int lane) {
    const int nblk = W.Ndst / 32, kb = it / nblk, nb = it % nblk, k0 = 64 * kb, n0 = 32 * nb, c = map_col(W.mode, n0 + (lane & 31)), cs = c < 0 ? 0 : c;
    const float* sp = W.src + (size_t)(k0 + (lane >> 5)) * W.Nsrc + cs; const size_t st2 = (size_t)2 * W.Nsrc;
#pragma unroll
    for (int i = 0; i < 32; ++i) x[i] = sp[i * st2];
}
__device__ __forceinline__ void prep_w_fin(const WDesc& W, int it, const float (&x)[32], PG8_LAS float* scr, int lane) {
    const int nblk = W.Ndst / 32, kb = it / nblk, nb = it % nblk, k0 = 64 * kb, n0 = 32 * nb, c = map_col(W.mode, n0 + (lane & 31));
    const int cc = lane & 7;
    f32x4 g0 = (f32x4){1.f, 1.f, 1.f, 1.f}, g1 = g0;
    if (W.gain) { const float* gp = W.gain + (k0 + 8 * cc) % W.gmod; g0 = *(const f32x4*)gp; g1 = *(const f32x4*)(gp + 4); }
#pragma unroll
    for (int i = 0; i < 32; ++i) scr[(2 * i + (lane >> 5)) * 33 + (lane & 31)] = c < 0 ? 0.f : x[i];
    asm volatile("s_waitcnt lgkmcnt(0)" ::: "memory");
#pragma unroll
    for (int j = 0; j < 4; ++j) { const int n = (lane >> 3) + 8 * j; const PG8_LAS float* p = scr + (8 * cc) * 33 + n;
        if (W.qs > 0.f) { const float f_[8] = {p[0] * g0.x, p[33] * g0.y, p[66] * g0.z, p[99] * g0.w, p[132] * g1.x, p[165] * g1.y, p[198] * g1.z, p[231] * g1.w}; unsigned w_[2] = {0u, 0u};
#pragma unroll
            for (int e = 0; e < 8; ++e) w_[e >> 2] |= (unsigned)((int)fminf(fmaxf(__builtin_rintf(f_[e] * W.qs), -127.f), 127.f) & 255) << (8 * (e & 3));
            *(u32x2*)((unsigned char*)W.dst + (size_t)(n0 + n) * W.K + k0 + 8 * cc) = (u32x2){w_[0], w_[1]}; }
        else { u32x4 o; o.x = pk2(p[0] * g0.x, p[33] * g0.y); o.y = pk2(p[66] * g0.z, p[99] * g0.w); o.z = pk2(p[132] * g1.x, p[165] * g1.y); o.w = pk2(p[198] * g1.z, p[231] * g1.w);
            *(u32x4*)(W.dst + (size_t)(n0 + n) * W.K + k0 + 8 * cc) = o; } }
    asm volatile("s_waitcnt lgkmcnt(0)" ::: "memory");
}
struct WAll { const float *w_in, *g_in, *w_uq, *g_uq, *w_ukv, *g_ukv, *w_om, *w_og, *g_og, *w_out; bf16_t *WinT, *WuqT, *WukvT, *WomT, *WogT, *WoutT; };
__device__ __forceinline__ WDesc prep_w_pick(const WAll& A, int it, int& r) {
    constexpr int n0 = (D / 64) * (WIN_ROWS / 32), n1 = (QR / 64) * (1536 / 32), n2 = (KVR / 64) * (2048 / 32), n3 = (D / 64) * (D / 32);
    r = it;
    if (r < n0) return WDesc{A.w_in, DIN, D, A.WinT, WIN_ROWS, A.g_in, D, (int)MAP_WIN, 1.f / SW_IN}; r -= n0;
    if (r < n1) return WDesc{A.w_uq, 1536, QR, A.WuqT, 1536, A.g_uq, QR, (int)MAP_ID, 0.f}; r -= n1;
    if (r < n2) return WDesc{A.w_ukv, 2048, KVR, A.WukvT, 2048, A.g_ukv, KVR, (int)MAP_UKV, 0.f}; r -= n2;
    if (r < n3) return WDesc{A.w_om, D, D, A.WomT, D, (const float*)nullptr, 1, (int)MAP_ID, 0.f}; r -= n3;
    if (r < n3) return WDesc{A.w_og, D, D, A.WogT, D, A.g_og, GHV, (int)MAP_ID, 0.f}; r -= n3;
    return WDesc{A.w_out, D, D, A.WoutT, D, (const float*)nullptr, 1, (int)MAP_ID, 0.f};
}
__device__ __forceinline__ void prep_w_all(const WAll& A, PG8_LAS float* scr, int gw, int nw, int lane) {
    asm volatile("" : "+v"(lane));
    constexpr int NIT = (D / 64) * (WIN_ROWS / 32) + (QR / 64) * (1536 / 32) + (KVR / 64) * (2048 / 32) + 3 * (D / 64) * (D / 32);
    float xa[32], xb[32]; int ra, rb;
    if (gw < NIT) { const WDesc W = prep_w_pick(A, gw, ra); prep_w_load(W, ra, xa, lane); }
    for (int it = gw; it < NIT; it += 2 * nw) {
        const int i1 = it + nw, i2 = it + 2 * nw;
        if (i1 < NIT) { const WDesc W = prep_w_pick(A, i1, rb); prep_w_load(W, rb, xb, lane); }
        { const WDesc W = prep_w_pick(A, it, ra); prep_w_fin(W, ra, xa, scr, lane); }
        if (i2 < NIT) { const WDesc W = prep_w_pick(A, i2, ra); prep_w_load(W, ra, xa, lane); }
        if (i1 < NIT) { const WDesc W = prep_w_pick(A, i1, rb); prep_w_fin(W, rb, xb, scr, lane); }
    }
}
typedef float f32x16 __attribute__((ext_vector_type(16)));
__device__ __forceinline__ void prep_ws(const float* __restrict__ wq, const float* __restrict__ keys, const float* __restrict__ gain, bf16_t* __restrict__ WsT, int gw, int nw, int lane) {
    asm volatile("" : "+v"(lane));
    const int r = lane & 31, h = lane >> 5;
    for (int blk = gw; blk < 64 * 32; blk += nw) {
        const int n0 = (blk >> 5) * 32, k0 = (blk & 31) * 32, hp = n0 >> 7;
        const float* ap = wq + (size_t)(k0 + r) * 2048 + hp * 128 + 64 * h;
        const float* bp = keys + (size_t)(hp & 1) * 128 * 128 + (size_t)((n0 & 127) + r) * 128 + 64 * h;
        f32x4 av[16], bv[16];
#pragma unroll
        for (int i = 0; i < 16; ++i) { av[i] = *(const f32x4*)(ap + 4 * i); bv[i] = *(const f32x4*)(bp + 4 * i); }
        f32x16 c;
#pragma unroll
        for (int i = 0; i < 16; ++i) c[i] = 0.f;
#pragma unroll
        for (int i = 0; i < 16; ++i)
#pragma unroll
            for (int e = 0; e < 4; ++e) c = __builtin_amdgcn_mfma_f32_32x32x2f32(av[i][e], bv[i][e], c, 0, 0, 0);
#pragma unroll
        for (int g = 0; g < 4; ++g) {
            const int k = k0 + 8 * g + 4 * h; const f32x4 gq = *(const f32x4*)(gain + k);
            const unsigned long long o = (unsigned long long)pk2(c[4 * g] * gq.x, c[4 * g + 1] * gq.y) | ((unsigned long long)pk2(c[4 * g + 2] * gq.z, c[4 * g + 3] * gq.w) << 32);
            *(unsigned long long*)(WsT + (size_t)(n0 + r) * D + k) = o; }
    }
}
__device__ __forceinline__ void prep_rope(float* __restrict__ RT, int gt, int nt) {
    for (int i = gt; i < 2064 * RH; i += nt) { const int pos = i / RH, f = i % RH; const float inv = powf(10000.f, -(float)f / (float)RH); const float ang = (float)pos * inv; RT[2 * i] = cosf(ang); RT[2 * i + 1] = sinf(ang); }
}
__device__ __forceinline__ void p0stats(const bf16_t* __restrict__ P0, const float* __restrict__ kn_pe, const float* __restrict__ RT, float* __restrict__ RQ, float* __restrict__ RKV, bf16_t* __restrict__ KPE, int gw, int nw, int lane) {
    asm volatile("" : "+v"(lane));
    const bool kl = lane >= 16 && lane < 24, hi = lane & 4; const int ke = 8 * (lane & 7);
    const f32x4 gk0 = *(const f32x4*)(kn_pe + ke), gk1 = *(const f32x4*)(kn_pe + ke + 4);
    for (int r0 = gw * 4; r0 < ME; r0 += nw * 4) {
        u32x4 A[4], B[4]; f32x4 rt[4][4];
#pragma unroll
        for (int t = 0; t < 4; ++t) { const int r = r0 + t; const bf16_t* p = P0 + (size_t)r * P0W; A[t] = *(const u32x4*)(p + 8 * lane); B[t] = *(const u32x4*)(p + 512 + 8 * (lane & 31));
            const int pos = tok_pos(r) < 2064 ? tok_pos(r) : 0; const float* q = RT + ((size_t)pos * RH + 8 * (lane & 3)) * 2;
#pragma unroll
            for (int i = 0; i < 4; ++i) rt[t][i] = *(const f32x4*)(q + 4 * i); }
#pragma unroll
        for (int t = 0; t < 4; ++t) { const int r = r0 + t;
            float fa[8], fb[8]; unpack8(A[t], fa); unpack8(B[t], fb);
            float sa = 0.f, sb = 0.f;
#pragma unroll
            for (int i = 0; i < 8; ++i) { sa += fa[i] * fa[i]; sb += fb[i] * fb[i]; }
            const float sq = wsum(lane < 48 ? sa : 0.f), skv = wsum((lane >= 48 ? sa : 0.f) + (lane < 16 ? sb : 0.f)), sk = wsum(kl ? sb : 0.f);
            if (lane == 0) { RQ[r] = rsqrtf(sq * (1.f / QR) + EPS); RKV[r] = rsqrtf(skv * (1.f / KVR) + EPS); }
            if (kl) {
                const float rn = rsqrtf(sk * (1.f / ROPE) + EPS); float y[8], o[8];
                const float gk[8] = {gk0.x, gk0.y, gk0.z, gk0.w, gk1.x, gk1.y, gk1.z, gk1.w};
                const float cs[16] = {rt[t][0].x, rt[t][0].y, rt[t][0].z, rt[t][0].w, rt[t][1].x, rt[t][1].y, rt[t][1].z, rt[t][1].w, rt[t][2].x, rt[t][2].y, rt[t][2].z, rt[t][2].w, rt[t][3].x, rt[t][3].y, rt[t][3].z, rt[t][3].w};
#pragma unroll
                for (int i = 0; i < 8; ++i) y[i] = fb[i] * rn * gk[i];
#pragma unroll
                for (int i = 0; i < 8; ++i) { const float up = dpp_f<0x114>(y[i]), dn = dpp_f<0x104>(y[i]);
                    o[i] = hi ? y[i] * cs[2 * i] + up * cs[2 * i + 1] : y[i] * cs[2 * i] - dn * cs[2 * i + 1]; }
                *(u32x4*)(KPE + (size_t)r * ROPE + ke) = pack8(o); }
        }
    }
}
__device__ __forceinline__ void meta_kv(const bf16_t* __restrict__ P0, const bf16_t* __restrict__ Wkv, const float* __restrict__ RKV, const float* __restrict__ kn_nope, bf16_t* __restrict__ KN, bf16_t* __restrict__ V, int gw, int nw, int lane) {
    asm volatile("" : "+v"(lane));
    for (int it = gw; it < NMETA * 8; it += nw) {
        const int row = M + (it >> 3), g = it & 7; const bf16_t* a = P0 + (size_t)row * P0W + S_CKV; float acc[2] = {0.f, 0.f};
#pragma unroll
        for (int t = 0; t < 2; ++t) { const bf16_t* w = Wkv + (size_t)(g * 128 + lane + 64 * t) * KVR;
            for (int k = 0; k < KVR; k += 8) { float fa[8], fw[8]; unpack8(*(const u32x4*)(a + k), fa); unpack8(*(const u32x4*)(w + k), fw);
#pragma unroll
                for (int i = 0; i < 8; ++i) acc[t] += fa[i] * fw[i]; } }
        const float sc = RKV[row]; acc[0] *= sc; acc[1] *= sc;
        if (g < 4) { const float rn = rsqrtf(wsum(acc[0] * acc[0] + acc[1] * acc[1]) * (1.f / NOPE) + EPS);
            KN[(size_t)row * 512 + g * 128 + lane] = f2bf(acc[0] * rn * kn_nope[lane]); KN[(size_t)row * 512 + g * 128 + lane + 64] = f2bf(acc[1] * rn * kn_nope[lane + 64]); }
        else { V[(size_t)row * 512 + (g - 4) * 128 + lane] = f2bf(acc[0]); V[(size_t)row * 512 + (g - 4) * 128 + lane + 64] = f2bf(acc[1]); }
    }
}
__device__ __forceinline__ void gla_post(const bf16_t* OG, const bf16_t* __restrict__ GG, bf16_t* OO, int gw, int nw, int lane) {
    asm volatile("" : "+v"(lane));
    for (int r0 = gw * 2; r0 < M; r0 += nw * 2) {
        u32x4 ow[2][2], gwv[2][2];
#pragma unroll
        for (int t = 0; t < 2; ++t) { const size_t off = (size_t)(r0 + t) * D + 16 * lane;
            ow[t][0] = *(const u32x4*)(OG + off); ow[t][1] = *(const u32x4*)(OG + off + 8); gwv[t][0] = *(const u32x4*)(GG + off); gwv[t][1] = *(const u32x4*)(GG + off + 8); }
#pragma unroll
        for (int t = 0; t < 2; ++t) { float o[16], g[16]; unpack8(ow[t][0], o); unpack8(ow[t][1], o + 8); unpack8(gwv[t][0], g); unpack8(gwv[t][1], g + 8);
            float ss = 0.f;
#pragma unroll
            for (int i = 0; i < 16; ++i) ss += o[i] * o[i];
            ss += dpp_f<0xB1>(ss); ss += dpp_f<0x4E>(ss); ss += dpp_f<0x141>(ss); ss += dpp_f<0x128>(ss);
            const float rn = rsqrtf(ss * (1.f / GHV) + EPS);
#pragma unroll
            for (int i = 0; i < 16; ++i) o[i] = o[i] * rn * g[i] * sigmoidf_(g[i]);
            const size_t off = (size_t)(r0 + t) * D + 16 * lane; *(u32x4*)(OO + off) = pack8(o); *(u32x4*)(OO + off + 8) = pack8(o + 8); }
    }
}
struct __attribute__((packed, aligned(4))) U3 { unsigned x, y, z; };
__device__ __forceinline__ unsigned enc_e2m3(float v) {
    const float t = fminf(fabsf(v) * 8.f, 60.f);
    const float m = t < 16.f ? 1.f : t < 32.f ? 0.5f : 0.25f; const unsigned b = t < 16.f ? 0u : t < 32.f ? 8u : 16u;
    return ((unsigned)(int)__builtin_rintf(t * m) + b) | (v < 0.f ? 32u : 0u);
}
__device__ __forceinline__ void conv_f6(const float* __restrict__ a, unsigned char* __restrict__ ao, float scale, const float* __restrict__ gain, int n16, int gt, int nt) {
    for (int i0 = gt; i0 < n16; i0 += 2 * nt) {
        const int i1 = i0 + nt < n16 ? i0 + nt : i0;
        f32x4 x[2][4], g[2][4];
#pragma unroll
        for (int t = 0; t < 2; ++t)
#pragma unroll
            for (int j = 0; j < 4; ++j) { const int i = t ? i1 : i0; x[t][j] = *(const f32x4*)(a + (size_t)i * 16 + 4 * j); g[t][j] = *(const f32x4*)(gain + (i & 63) * 16 + 4 * j); }
#pragma unroll
        for (int t = 0; t < 2; ++t) { const int i = t ? i1 : i0;
            unsigned c[16];
#pragma unroll
            for (int j = 0; j < 4; ++j) { const f32x4 v = x[t][j], q = g[t][j];
                c[4 * j] = enc_e2m3(v.x * q.x * scale); c[4 * j + 1] = enc_e2m3(v.y * q.y * scale); c[4 * j + 2] = enc_e2m3(v.z * q.z * scale); c[4 * j + 3] = enc_e2m3(v.w * q.w * scale); }
            unsigned long long lo = 0ull;
#pragma unroll
            for (int j = 0; j < 10; ++j) lo |= (unsigned long long)c[j] << (6 * j);
            lo |= (unsigned long long)(c[10] & 15u) << 60;
            unsigned hi = c[10] >> 4;
#pragma unroll
            for (int j = 11; j < 16; ++j) hi |= c[j] << (6 * (j - 11) + 2);
            *(U3*)(ao + (size_t)i * 12) = U3{(unsigned)lo, (unsigned)(lo >> 32), hi}; }
    }
}
__device__ __forceinline__ unsigned enc_e2m1(float v) {
    const float t = fabsf(v);
    return (unsigned)((t > 0.25f) + (t > 0.75f) + (t > 1.25f) + (t > 1.75f) + (t > 2.5f) + (t > 3.5f) + (t > 5.f)) | (v < 0.f ? 8u : 0u);
}
__device__ __forceinline__ void conv_f4(const float* __restrict__ a, unsigned char* __restrict__ ao, float scale, int n16, int gt, int nt) {
    for (int i0 = gt; i0 < n16; i0 += 2 * nt) {
        const int i1 = i0 + nt < n16 ? i0 + nt : i0;
        f32x4 x[2][4];
#pragma unroll
        for (int t = 0; t < 2; ++t)
#pragma unroll
            for (int j = 0; j < 4; ++j) x[t][j] = *(const f32x4*)(a + (size_t)(t ? i1 : i0) * 16 + 4 * j);
#pragma unroll
        for (int t = 0; t < 2; ++t) { unsigned w0 = 0u, w1 = 0u;
#pragma unroll
            for (int j = 0; j < 4; ++j) { const f32x4 v = x[t][j];
                const unsigned c = enc_e2m1(v.x * scale) | enc_e2m1(v.y * scale) << 4 | enc_e2m1(v.z * scale) << 8 | enc_e2m1(v.w * scale) << 12;
                if (j < 2) w0 |= c << (16 * j); else w1 |= c << (16 * (j - 2)); }
            *(u32x2*)(ao + (size_t)(t ? i1 : i0) * 8) = (u32x2){w0, w1}; }
    }
}
__device__ __forceinline__ unsigned enc_s4(float v) { return (unsigned)(int)fminf(fmaxf(__builtin_rintf(v), -8.f), 7.f) & 15u; }
__device__ __forceinline__ void conv_s4g(const float* __restrict__ a, unsigned char* __restrict__ ao, float scale, const float* __restrict__ gain, int n16, int gt, int nt) {
    f32x4 g[4];
#pragma unroll
    for (int j = 0; j < 4; ++j) { g[j] = *(const f32x4*)(gain + (gt & 63) * 16 + 4 * j); g[j].x *= scale; g[j].y *= scale; g[j].z *= scale; g[j].w *= scale; }
    for (int i0 = gt; i0 < n16; i0 += 4 * nt) {
        int it[4]; f32x4 x[4][4];
#pragma unroll
        for (int t = 0; t < 4; ++t) { it[t] = i0 + t * nt < n16 ? i0 + t * nt : i0;
#pragma unroll
            for (int j = 0; j < 4; ++j) x[t][j] = *(const f32x4*)(a + (size_t)it[t] * 16 + 4 * j); }
#pragma unroll
        for (int t = 0; t < 4; ++t) { unsigned w0 = 0u, w1 = 0u;
#pragma unroll
            for (int j = 0; j < 4; ++j) { const f32x4 v = x[t][j], q = g[j];
                const unsigned c = enc_s4(v.x * q.x) | enc_s4(v.y * q.y) << 4 | enc_s4(v.z * q.z) << 8 | enc_s4(v.w * q.w) << 12;
                if (j < 2) w0 |= c << (16 * j); else w1 |= c << (16 * (j - 2)); }
            *(u32x2*)(ao + (size_t)it[t] * 8) = (u32x2){w0, w1}; }
    }
}
}

#ifndef REP_G
#define REP_G 1
#endif
#ifndef REP_A
#define REP_A 1
#endif
#ifndef REP_GA
#define REP_GA 1
#endif
#ifndef REP_P
#define REP_P 1
#endif
#ifndef REP_R
#define REP_R 1
#endif
#ifndef REP_SY
#define REP_SY 1
#endif
#ifndef REP_T
#define REP_T 1
#endif
#ifndef REP_U
#define REP_U 1
#endif
#ifndef PREP_VAR
#define PREP_VAR 0
#endif
#ifndef REP_S
#define REP_S 1
#endif
constexpr int MEGA_THREADS = 512, MEGA_LDS = 147456;
struct MegaArgs {
    const float* in[23]; float* out; char* ws; int ph_lo, ph_hi, coop, pad;
};
enum { PH_PREP = 0, PH_PROJ = 1, PH_STATS = 2, PH_UP = 3, PH_ATT = 4, PH_GLAPOST = 7, PH_MIX = 8, PH_OUT = 9, PH_SCORE = 10, PH_GATHER = 11, PH_N = 12 };

constexpr int PROJ_TILES = 129 * 17 + 6 * 129;
struct SchedProj { const char* XB; const char* WinT; int G, c;
    __device__ __forceinline__ bool next(int i, pg8::Unit& u) const {
        const int L = i * G + c; constexpr int NNAT = 129 * 17, NTR = 6 * 129;
        if (L >= NNAT + NTR) return false;
        if (L < NNAT) { pg8::tile_of(L, 129, 17, u.pm, u.pn); u.gid = 0; u.A = XB + (size_t)u.pm * 256 * D; u.B = WinT + (size_t)u.pn * 256 * D; }
        else { pg8::tile_of(L - NNAT, 6, 129, u.pm, u.pn); u.gid = 1; u.A = WinT + (size_t)(WIN_NAT + u.pm * 256) * D; u.B = XB + (size_t)u.pn * 256 * D; }
        return true; }
};
struct EpiProj { static constexpr bool XFORM = false, ROWSTAT = false, PRE = true, AUX = false; EpiProjNat n; EpiProjTr t;
    __device__ __forceinline__ void pre(int gid, int row0, int col0, float (&rs)[2][4], f32x4 (&cs)[2][2]) const {
        if (gid == 0) {
#pragma unroll
            for (int ai = 0; ai < 2; ++ai)
#pragma unroll
                for (int m = 0; m < 4; ++m) rs[ai][m] = n.R1[row0 + ai * 128 + m * 16]; }
        else {
#pragma unroll
            for (int bj = 0; bj < 2; ++bj) { cs[bj][0] = *(const f32x4*)(t.R1 + col0 + bj * 128); cs[bj][1] = *(const f32x4*)(t.R1 + col0 + bj * 128 + 4); } } }
    __device__ __forceinline__ void operator()(int gid, int row, int col, const float* v, float rsv, const f32x4 (&csv)[2]) const { if (gid == 0) n(row, col, v, rsv); else t(row, col, v, csv); } };
struct SchedSimple { const char* A; const char* B; size_t sA, sB; int nM, nN, G, c, gid;
    __device__ __forceinline__ bool next(int i, pg8::Unit& u) const {
        const int L = i * G + c; if (L >= nM * nN) return false;
        pg8::tile_of(L, nM, nN, u.pm, u.pn); u.gid = gid; u.A = A + (size_t)u.pm * sA; u.B = B + (size_t)u.pn * sB; return true; }
};
struct EpiUp { static constexpr bool XFORM = false, ROWSTAT = true, PRE = true, AUX = false; EpiUq q; EpiUkv kv; const float* kn_nope;
    __device__ __forceinline__ bool want_stat(int gid, int pn) const { return gid == 1 && pn < 2; }
    __device__ __forceinline__ void pre(int gid, int row0, int col0, float (&rs)[2][4], f32x4 (&cs)[2][2]) const {
        const float* R = gid == 0 ? q.RQ : kv.RKV;
#pragma unroll
        for (int ai = 0; ai < 2; ++ai)
#pragma unroll
            for (int m = 0; m < 4; ++m) rs[ai][m] = R[row0 + ai * 128 + m * 16];
        cs[0][0] = *(const f32x4*)(kn_nope + (col0 & 127)); cs[0][1] = *(const f32x4*)(kn_nope + (col0 & 127) + 4); cs[1][0] = cs[0][0]; cs[1][1] = cs[0][1]; }
    __device__ __forceinline__ void operator()(int gid, int row, int col, const float* v, float ss, float s, const f32x4 (&g)[2]) const {
        if (gid == 0) { q(row, col, v, s); return; }
        if (col < 512) {
            const float rn = s * rsqrtf(s * s * ss * (1.f / NOPE) + EPS);
            const float o[8] = {v[0] * rn * g[0].x, v[1] * rn * g[0].y, v[2] * rn * g[0].z, v[3] * rn * g[0].w, v[4] * rn * g[1].x, v[5] * rn * g[1].y, v[6] * rn * g[1].z, v[7] * rn * g[1].w};
            *(u32x4*)(kv.KN + (size_t)row * 512 + col) = pack8(o); }
        else kv(row, col, v, s); }
};
template <class E1> struct EpiWrap { static constexpr bool XFORM = false, ROWSTAT = false, PRE = false, AUX = false; E1 e;
    __device__ __forceinline__ void operator()(int, int row, int col, const float* v) const { e(row, col, v); } };
struct SchedMix { const char* YA; const char* YB; const char* W1; const char* W2; int G, c;
    __device__ __forceinline__ bool next(int i, pg8::Unit& u) const {
        const int L = (i >> 1) * G + c; if (L >= 128 * 4) return false;
        pg8::tile_of(L, 128, 4, u.pm, u.pn); u.gid = i & 1;
        u.A = (u.gid ? YB : YA) + (size_t)u.pm * 256 * D * 2; u.B = (u.gid ? W2 : W1) + (size_t)u.pn * 256 * D * 2; return true; }
};
struct EpiMix { static constexpr bool XFORM = false, ROWSTAT = false, PRE = false, AUX = true; const bf16_t* __restrict__ GA; const bf16_t* __restrict__ GB; bf16_t* __restrict__ MIX;
    __device__ __forceinline__ bool keep(int gid) const { return gid == 0; }
    __device__ __forceinline__ void aux(int gid, int row, int col, u32x4 (&ax)[2]) const { ax[1] = *(const u32x4*)(GB + (size_t)row * D + col); if (gid == 0) ax[0] = *(const u32x4*)(GA + (size_t)row * D + col); }
    __device__ __forceinline__ bool apply(int gid, int row, int col, float* v, const u32x4 (&ax)[2]) const {
        float gb[8]; unpack8(ax[1], gb);
        if (gid == 0) { float ga[8]; unpack8(ax[0], ga);
#pragma unroll
            for (int i = 0; i < 8; ++i) v[i] *= (1.f + __expf(-gb[i])) / (1.f + __expf(-ga[i]));
            return true; }
        float o[8];
#pragma unroll
        for (int i = 0; i < 8; ++i) o[i] = v[i] * sigmoidf_(gb[i]);
        *(u32x4*)(MIX + (size_t)row * D + col) = pack8(o); return false; }
};

__global__ void __launch_bounds__(MEGA_THREADS, 2) mega(MegaArgs a) {
    extern __shared__ __attribute__((aligned(16))) unsigned char lds_raw[];
    PG8_LAS unsigned char* lds = (PG8_LAS unsigned char*)lds_raw;
    cg::grid_group grid = cg::this_grid();
    char* ws = a.ws;
    const int G = gridDim.x, bx = blockIdx.x, nw = G * 8, nt = G * MEGA_THREADS;
    const int wid_s = __builtin_amdgcn_readfirstlane((int)threadIdx.x >> 6);
#define TIDS int lane = lane_id(); asm volatile("" : "+v"(lane)); const int wid = wid_s, tid = wid * 64 + lane, gw = bx * 8 + wid, gt = bx * MEGA_THREADS + tid; (void)lane; (void)gw; (void)gt; (void)wid
    bf16_t *WinT = (bf16_t*)(ws + O_WIN), *XB = (bf16_t*)(ws + O_XB), *P0 = (bf16_t*)(ws + O_P0), *GQ = (bf16_t*)(ws + O_GQ), *GKT = (bf16_t*)(ws + O_GKT), *GVT = (bf16_t*)(ws + O_GVT), *GG = (bf16_t*)(ws + O_GG);
    float *R1 = (float*)(ws + O_R1), *RQ = (float*)(ws + O_RQ), *RKV = (float*)(ws + O_RKV), *SC = (float*)(ws + O_S), *RT = (float*)(ws + O_ROPE);
    bf16_t *WuqT = (bf16_t*)(ws + O_WUQ), *WukvT = (bf16_t*)(ws + O_WUKV), *WomT = (bf16_t*)(ws + O_WOM), *WogT = (bf16_t*)(ws + O_WOG), *WoutT = (bf16_t*)(ws + O_WOUT), *WsT = (bf16_t*)(ws + O_WS);
    bf16_t *QC = (bf16_t*)(ws + O_QC), *KN = (bf16_t*)(ws + O_KN), *V = (bf16_t*)(ws + O_V), *YA = (bf16_t*)(ws + O_YA), *YB = (bf16_t*)(ws + O_YB), *MIX = (bf16_t*)(ws + O_MIX), *HN2 = (bf16_t*)(ws + O_HN2);
    bf16_t *GA = (bf16_t*)a.out, *GB = (bf16_t*)a.out + (size_t)M * D; bf16_t* KPE = (bf16_t*)(ws + O_KPE);
#define IN(k) (a.ph_lo <= (k) && (k) < a.ph_hi)
    volatile PG8_LAS unsigned* MISC = (volatile PG8_LAS unsigned*)(lds + 131072 + 320);
    { TIDS; if (tid < 128) ((PG8_LAS unsigned*)(lds + 131072))[tid] = 0u; }
    __syncthreads();
    const XcdBarrier xbar = xcd_barrier_post((unsigned*)(ws + O_BAR), MISC + 8, wid_s);
    if (a.coop == 2) grid.sync();
#define SEAM(k) do { if (a.coop && (k) + 1 < a.ph_hi) xcd_barrier(xbar); } while (0)
    if (IN(PH_PREP)) { for (int rep = 0; rep < REP_P; ++rep) { TIDS;
        sm::prep_x(a.in[0], a.in[1], XB, R1, gw, nw, lane);
        PG8_LAS float* scr = (PG8_LAS float*)(lds + wid * 16384);
        sm::prep_w_all(sm::WAll{a.in[3], a.in[2], a.in[5], a.in[4], a.in[7], a.in[6], a.in[15], a.in[16], a.in[14], a.in[17], WinT, WuqT, WukvT, WomT, WogT, WoutT}, scr, gw, nw, lane);
        sm::prep_ws(a.in[19], a.in[20], a.in[18], WsT, gw, nw, lane);
        sm::prep_rope(RT, gt, nt); __syncthreads(); }
        SEAM(PH_PREP);
    }
    if (IN(PH_PROJ)) {
        SchedProj S{(const char*)XB, (const char*)WinT, G, bx};
        EpiProj E{EpiProjNat{R1, P0, GQ, GG, GA, GB}, EpiProjTr{R1, GKT, GVT}};
        for (int rep = 0; rep < REP_G; ++rep) pg8::gemm_phase<EpiProj, SchedProj, true>(lds, pg8::Fam{D / 2, D / 2, D / 2}, S, E, wid_s);
        { const int nfull = PROJ_TILES % G; if (nfull > 0 && bx >= nfull) { TIDS; sm::conv_s4g(a.in[21], (unsigned char*)(ws + O_UB), peer::PEER_SU, a.in[18], 16384 * D / 16, (bx - nfull) * MEGA_THREADS + tid, (G - nfull) * MEGA_THREADS); } }
        SEAM(PH_PROJ);
    }
    if (IN(PH_STATS)) { TIDS;
        for (int rep = 0; rep < REP_R; ++rep) sm::p0stats(P0, a.in[11], RT, RQ, RKV, KPE, gw, nw, lane);
        for (int i = gt; i < 48 * 512 / 8; i += nt) { *(u32x4*)(KN + (size_t)(M + NMETA) * 512 + (size_t)i * 8) = (u32x4){0u, 0u, 0u, 0u}; *(u32x4*)(V + (size_t)(M + NMETA) * 512 + (size_t)i * 8) = (u32x4){0u, 0u, 0u, 0u}; }
        for (int rep = 0; rep < REP_U; ++rep) { const bool dm = rep + 1 < REP_U; const gla::Tens GT{GQ, GKT, GVT, dm ? QC : GQ, dm ? QC + (size_t)ME * 512 : GKT, dm ? PREP_VAR : 0, P0, a.in[12], a.in[13], (bf16_t*)(ws + O_AG), (float*)(ws + O_DECL), YB};
          gla::prep_phase(lds, GT, G, bx, wid_s); }
        SEAM(PH_STATS);
    }
#define ROUND_BODY(r) do { \
        if (IN(PH_UP + 2 * r)) { TIDS; \
            const int Gh = G >> 1; const bool isq = bx < Gh; \
            SchedSimple S{(const char*)(isq ? P0 : P0 + S_CKV), (const char*)(isq ? WuqT + (size_t)r * 768 * QR : WukvT + (size_t)r * 1024 * KVR), (size_t)256 * P0W * 2, (size_t)256 * (isq ? QR : KVR) * 2, 128, isq ? 3 : 4, isq ? Gh : G - Gh, isq ? bx : bx - Gh, isq ? 0 : 1}; \
            for (int rep = 0; rep < REP_G; ++rep) pg8::gemm_phase(lds, pg8::Fam{P0W, isq ? QR : KVR, isq ? QR : KVR}, S, EpiUp{EpiUq{RQ, QC}, EpiUkv{RKV, KN, V}, a.in[10]}, wid_s); \
            sm::meta_kv(P0, WukvT + (size_t)r * 1024 * KVR, RKV, a.in[10], KN, V, gw, nw, lane); \
            SEAM(PH_UP + 2 * r); \
        } \
        if (IN(PH_ATT + 2 * r)) { \
            if (r == 0) att::attn_phase(lds, att::Tens{QC, KN, KPE, V, YA, a.in[8], a.in[9], RT}, r, G, bx, wid_s); \
            else { \
                if (bx < NB * 4) { const gla::Tens GT{GQ, GKT, GVT, GQ, GKT, 0, P0, a.in[12], a.in[13], (bf16_t*)(ws + O_AG), (float*)(ws + O_DECL), YB}; \
                    for (int u = bx; u < NB * 4; u += G) gla::scan_wg(lds, GT, u >> 2, u & 3, wid_s); } \
                att::attn_phase_dyn(lds, att::Tens{QC, KN, KPE, V, YA, a.in[8], a.in[9], RT}, r, (unsigned*)(ws + O_BAR) + 3584, MISC, wid_s); } \
            SEAM(PH_ATT + 2 * r); } \
    } while (0)
    ROUND_BODY(0);
    ROUND_BODY(1);
#undef ROUND_BODY
    if (IN(PH_GLAPOST)) { TIDS; for (int rep = 0; rep < REP_R; ++rep) { sm::gla_post(YB, GG, rep + 1 < REP_R ? GVT : YB, gw, nw, lane);
        if (PROJ_TILES % G == 0) sm::conv_s4g(a.in[21], (unsigned char*)(ws + O_UB), peer::PEER_SU, a.in[18], 16384 * D / 16, gt, nt);
        sm::conv_f4(a.in[22], (unsigned char*)(ws + O_VB), peer::PEER_SV, 16384 * D / 16, gt, nt); }
        SEAM(PH_GLAPOST); }
    if (IN(PH_MIX)) {
        SchedMix S{(const char*)YA, (const char*)YB, (const char*)WomT, (const char*)WogT, G, bx};
        for (int rep = 0; rep < REP_G; ++rep) pg8::gemm_phase(lds, pg8::Fam{D, D, D}, S, EpiMix{GA, GB, MIX}, wid_s);
        SEAM(PH_MIX);
    }
    if (IN(PH_OUT)) {
        SchedSimple S{(const char*)MIX, (const char*)WoutT, (size_t)256 * D * 2, (size_t)256 * D * 2, 128, 4, G, bx, 0};
        for (int rep = 0; rep < REP_G; ++rep) pg8::gemm_phase(lds, pg8::Fam{D, D, D}, S, EpiOut{a.in[0], a.out, HN2, (float*)(ws + O_SSQ)}, wid_s);
        SEAM(PH_OUT);
    }
    if (IN(PH_SCORE)) {
        SchedSimple S{(const char*)HN2, (const char*)WsT, (size_t)256 * D * 2, (size_t)256 * D * 2, 128, 8, G, bx, 0};
        for (int rep = 0; rep < REP_G; ++rep) pg8::gemm_phase(lds, pg8::Fam{D, D, D}, S, EpiWrap<EpiScore>{EpiScore{(bf16_t*)SC}}, wid_s);
        { TIDS; PG8_LAS float* wl = (PG8_LAS float*)(lds + wid * peer::TK_WAVE_LDS); pg8::Unit u; int nu = 0; while (S.next(nu, u)) ++nu;
          for (int t = wid; t < nu * 4; t += 8) { S.next(t >> 2, u); peer::topk64(wl, (const bf16_t*)SC, (const float*)(ws + O_SSQ), (int*)(ws + O_IDX), (float*)(ws + O_GATE), u.pm * 256 + (t & 3) * 64, u.pn, true, lane); } }
        SEAM(PH_SCORE);
    }
    if (IN(PH_GATHER)) for (int rep = 0; rep < REP_GA; ++rep) peer::gather1s_phase(lds, HN2, (const int*)(ws + O_IDX), (const float*)(ws + O_GATE), (const unsigned char*)(ws + O_UB), (const unsigned char*)(ws + O_VB), (const float*)(ws + O_SSQ), rep + 1 < REP_GA ? SC : a.out, G, bx, wid_s);
}

extern "C" void kernel_launch(void* const* d_in, const int* in_sizes, int n_in, void* d_out, int out_size, void* d_ws, size_t ws_size, hipStream_t st) {
    (void)in_sizes; (void)out_size;
    static int grid = 0;
    if (grid == 0) {
        if (n_in != 23 || ws_size < O_WSEND) { fprintf(stderr, "kernel_launch: unexpected inputs (%d) or workspace %zu < %zu\n", n_in, ws_size, (size_t)O_WSEND); grid = -1; return; }
        int dev = 0, cus = 0, per_cu = 0;
        if (hipGetDevice(&dev) != hipSuccess || hipDeviceGetAttribute(&cus, hipDeviceAttributeMultiprocessorCount, dev) != hipSuccess) cus = 256;
        if (hipFuncSetAttribute((const void*)mega, hipFuncAttributeMaxDynamicSharedMemorySize, MEGA_LDS) != hipSuccess) { fprintf(stderr, "kernel_launch: hipFuncSetAttribute failed\n"); grid = -1; return; }
        if (hipOccupancyMaxActiveBlocksPerMultiprocessor(&per_cu, (const void*)mega, MEGA_THREADS, MEGA_LDS) != hipSuccess || per_cu < 1) { fprintf(stderr, "kernel_launch: occupancy query failed (%d)\n", per_cu); per_cu = 1; }
        (void)hipGetLastError();
        grid = cus * 1;
        if (per_cu < 1) grid = -1;
    }
    if (grid < 0) return;
    MegaArgs ma{};
    for (int i = 0; i < 23; ++i) ma.in[i] = (const float*)d_in[i];
    ma.out = (float*)d_out; ma.ws = (char*)d_ws; ma.ph_lo = 0; ma.ph_hi = PH_N; ma.coop = 1; ma.pad = 0;
    if (hipMemsetAsync((char*)d_ws + O_BAR, 0, BAR_BYTES, st) != hipSuccess) { fprintf(stderr, "kernel_launch: memset failed\n"); return; }
    void* args[] = {&ma};
    hipError_t e = hipLaunchCooperativeKernel((const void*)mega, dim3(grid), dim3(MEGA_THREADS), args, MEGA_LDS, st);
    if (e != hipSuccess) fprintf(stderr, "kernel_launch: cooperative launch failed: %s (grid %d)\n", hipGetErrorString(e), grid);
}
```
